# Optimizing an MI355X kernel written in HIP

```python
import jax, jax.numpy as jnp
from jax import lax
import numpy as np

D_MODEL = 1024
BATCH = 16
SEQ = 4096
DEPTH = 1

MIX_WIDTH = D_MODEL
SB_HEADS = 8
SB_HEAD_DIM = 64
SB_WIDTH = SB_HEADS * SB_HEAD_DIM
SB_SCALE = SB_HEAD_DIM ** -0.5
MLA_HEADS = 4
QK_NOPE = 128
QK_ROPE = 64
V_DIM = 128
Q_LORA = 256
KV_LORA = 128
MLA_WIDTH = MLA_HEADS * V_DIM
MLA_SCALE = (QK_NOPE + QK_ROPE) ** -0.5
ROPE_BASE = 10000.0
IN_COLS = 3 * SB_WIDTH + Q_LORA + KV_LORA + QK_ROPE
D_FF = 4 * D_MODEL
BLOCK_Q = 128
NORM_EPS = 1e-6

kernel_name = 'hymba_stickbreaking_mla_sqrelu_block'


def rmsnorm(x, g):
    xf = x.astype(jnp.float32)
    y = xf * lax.rsqrt(jnp.mean(jnp.square(xf), axis=-1, keepdims=True) + NORM_EPS)
    return (y * g.astype(jnp.float32)).astype(x.dtype)


def rope_tables(positions):
    half = QK_ROPE // 2
    inv_freq = ROPE_BASE ** (-jnp.arange(half, dtype=jnp.float32) / half)
    ang = positions.astype(jnp.float32)[..., None] * inv_freq
    return jnp.cos(ang), jnp.sin(ang)


def apply_rope(x, cos, sin):
    half = QK_ROPE // 2
    xf = x.astype(jnp.float32)
    x1, x2 = xf[..., :half], xf[..., half:]
    out = jnp.concatenate([x1 * cos - x2 * sin, x2 * cos + x1 * sin], axis=-1)
    return out.astype(x.dtype)


def stick_breaking_block(q_blk, k_pre, v_pre, t0):
    n_q, n_k = q_blk.shape[1], k_pre.shape[1]
    z = jnp.einsum('bqhd,bkhd->bhqk', q_blk, k_pre).astype(jnp.float32) * SB_SCALE
    t_idx = t0 + jnp.arange(n_q)
    s_idx = jnp.arange(n_k)
    strict = s_idx[None, :] < t_idx[:, None]
    sp = jnp.where(strict, jax.nn.softplus(z), 0.0)
    excl = lax.cumsum(sp, axis=3, reverse=True) - sp
    log_a = jax.nn.log_sigmoid(z) - excl
    a = jnp.where(strict, jnp.exp(log_a), 0.0)
    return jnp.einsum('bhqk,bkhd->bqhd', a.astype(v_pre.dtype), v_pre)


def mla_block(qn_blk, qr_blk, kn_pre, kr_pre, v_pre, t0):
    n_q, n_k = qn_blk.shape[1], kn_pre.shape[1]
    s = (jnp.einsum('bqhd,bkhd->bhqk', qn_blk, kn_pre)
         + jnp.einsum('bqhr,bkr->bhqk', qr_blk, kr_pre)).astype(jnp.float32) * MLA_SCALE
    t_idx = t0 + jnp.arange(n_q)
    s_idx = jnp.arange(n_k)
    causal = s_idx[None, :] <= t_idx[:, None]
    s = jnp.where(causal, s, jnp.finfo(jnp.float32).min)
    p = jax.nn.softmax(s, axis=-1)
    return jnp.einsum('bhqk,bkhd->bqhd', p.astype(v_pre.dtype), v_pre)


def setup_inputs(seed: int = 0) -> dict:
    key = jax.random.key(seed)
    ks = jax.random.split(key, 16)

    def w(k, shape, fan_in):
        return jax.random.normal(k, shape, jnp.float32) * fan_in ** -0.5

    def g(k, shape):
        return 1.0 + 0.01 * jax.random.normal(k, shape, jnp.float32)

    return {
        'x': jax.random.normal(ks[0], (BATCH, SEQ, D_MODEL), jnp.float32),
        'positions': jnp.broadcast_to(jnp.arange(SEQ, dtype=jnp.int32), (BATCH, SEQ)),
        'attn_norm_g': g(ks[1], (DEPTH, D_MODEL)),
        'w_in': w(ks[2], (DEPTH, D_MODEL, IN_COLS), D_MODEL),
        'q_a_norm_g': g(ks[3], (DEPTH, Q_LORA)),
        'w_q_b': w(ks[4], (DEPTH, Q_LORA, MLA_HEADS * (QK_NOPE + QK_ROPE)), Q_LORA),
        'kv_a_norm_g': g(ks[5], (DEPTH, KV_LORA)),
        'w_kv_b': w(ks[6], (DEPTH, KV_LORA, MLA_HEADS * (QK_NOPE + V_DIM)), KV_LORA),
        'sb_out_norm_g': g(ks[7], (DEPTH, SB_WIDTH)),
        'mla_out_norm_g': g(ks[8], (DEPTH, MLA_WIDTH)),
        'w_o': w(ks[9], (DEPTH, MIX_WIDTH, D_MODEL), MIX_WIDTH),
        'mlp_norm_g': g(ks[10], (DEPTH, D_MODEL)),
        'w_up': w(ks[11], (DEPTH, D_MODEL, D_FF), D_MODEL),
        'w_down': w(ks[12], (DEPTH, D_FF, D_MODEL), D_FF),
        'final_norm_g': g(ks[13], (D_MODEL,)),
    }


def reference(x, positions, attn_norm_g, w_in, q_a_norm_g, w_q_b, kv_a_norm_g, w_kv_b,
              sb_out_norm_g, mla_out_norm_g, w_o, mlp_norm_g, w_up, w_down, final_norm_g):
    bsz, seq = x.shape[0], x.shape[1]
    n_blocks = seq // BLOCK_Q
    cos, sin = rope_tables(positions)
    splits = [SB_WIDTH, 2 * SB_WIDTH, 3 * SB_WIDTH, 3 * SB_WIDTH + Q_LORA,
              3 * SB_WIDTH + Q_LORA + KV_LORA]
    h = x
    for l in range(DEPTH):
        u = rmsnorm(h, attn_norm_g[l])
        proj = jnp.einsum('bsd,de->bse', u, w_in[l])
        q_sb, k_sb, v_sb, c_q, c_kv, k_rope = jnp.split(proj, splits, axis=-1)
        q_sb = q_sb.reshape(bsz, seq, SB_HEADS, SB_HEAD_DIM)
        k_sb = k_sb.reshape(bsz, seq, SB_HEADS, SB_HEAD_DIM)
        v_sb = v_sb.reshape(bsz, seq, SB_HEADS, SB_HEAD_DIM)
        q_m = jnp.einsum('bsr,re->bse', rmsnorm(c_q, q_a_norm_g[l]), w_q_b[l])
        q_m = q_m.reshape(bsz, seq, MLA_HEADS, QK_NOPE + QK_ROPE)
        q_nope = q_m[..., :QK_NOPE]
        q_rope = apply_rope(q_m[..., QK_NOPE:], cos[:, :, None, :], sin[:, :, None, :])
        kv = jnp.einsum('bsr,re->bse', rmsnorm(c_kv, kv_a_norm_g[l]), w_kv_b[l])
        kv = kv.reshape(bsz, seq, MLA_HEADS, QK_NOPE + V_DIM)
        k_nope, v_m = kv[..., :QK_NOPE], kv[..., QK_NOPE:]
        k_rope = apply_rope(k_rope, cos, sin)
        sb_outs, mla_outs = [], []
        for i in range(n_blocks):
            t0 = i * BLOCK_Q
            t1 = t0 + BLOCK_Q
            sb_outs.append(stick_breaking_block(q_sb[:, t0:t1], k_sb[:, :t1], v_sb[:, :t1], t0))
            mla_outs.append(mla_block(q_nope[:, t0:t1], q_rope[:, t0:t1], k_nope[:, :t1],
                                      k_rope[:, :t1], v_m[:, :t1], t0))
        o_sb = jnp.concatenate(sb_outs, axis=1).reshape(bsz, seq, SB_WIDTH)
        o_mla = jnp.concatenate(mla_outs, axis=1).reshape(bsz, seq, MLA_WIDTH)
        mixed = jnp.concatenate([rmsnorm(o_sb, sb_out_norm_g[l]),
                                 rmsnorm(o_mla, mla_out_norm_g[l])], axis=-1)
        h = h + jnp.einsum('bse,ed->bsd', mixed, w_o[l])
        v = rmsnorm(h, mlp_norm_g[l])
        hid = jnp.square(jax.nn.relu(jnp.einsum('bsd,df->bsf', v, w_up[l])))
        h = h + jnp.einsum('bsf,fd->bsd', hid, w_down[l])
    return rmsnorm(h, final_norm_g)
```

```cpp
#include <hip/hip_runtime.h>
#include <hip/hip_cooperative_groups.h>
#include <cstdio>
namespace cg = cooperative_groups;

#define LAS __attribute__((address_space(3)))
#define DI __device__ __forceinline__
typedef unsigned short bf16_t;
typedef short bf16x8 __attribute__((ext_vector_type(8)));
typedef float f32x2 __attribute__((ext_vector_type(2)));
typedef float f32x4 __attribute__((ext_vector_type(4)));
typedef float f32x16 __attribute__((ext_vector_type(16)));
typedef unsigned u32x4 __attribute__((ext_vector_type(4)));
typedef unsigned u32x2 __attribute__((ext_vector_type(2)));
typedef __bf16 bf2_t __attribute__((ext_vector_type(2)));

constexpr int T_ = 65536, S_ = 4096;
constexpr float EPS_ = 1e-6f;
constexpr float LOG2E = 1.4426950408889634f, LN2 = 0.6931471805599453f;
constexpr float MLA_QSCALE = 0.07216878364870322f * 1.4426950408889634f;
constexpr float SB_PTHR = 1e-37f;

constexpr size_t SZ_T = (size_t)T_;
constexpr size_t OFF_PROJ = 0;
constexpr size_t OFF_VST  = OFF_PROJ + SZ_T * 2048 * 2;
constexpr size_t OFF_QN   = OFF_VST + SZ_T * 512 * 2;
constexpr size_t OFF_QR   = OFF_QN + SZ_T * 512 * 2;
constexpr size_t OFF_KN   = OFF_QR + SZ_T * 256 * 2;
constexpr size_t OFF_VMT  = OFF_KN + SZ_T * 512 * 2;
constexpr size_t OFF_REGA_END = OFF_VMT + SZ_T * 512 * 2;
constexpr size_t OFF_HID  = 0;
constexpr size_t OFF_XB   = OFF_REGA_END;
constexpr size_t OFF_MIX  = OFF_XB + SZ_T * 1024 * 2;
constexpr size_t OFF_H1B  = OFF_MIX + SZ_T * 1024 * 2;
constexpr size_t OFF_WIN  = OFF_H1B + SZ_T * 1024 * 2;
constexpr size_t OFF_WQB  = OFF_WIN + (size_t)2048 * 1024 * 2;
constexpr size_t OFF_WKVB = OFF_WQB + (size_t)768 * 256 * 2;
constexpr size_t OFF_WO   = OFF_WKVB + (size_t)1024 * 256 * 2;
constexpr size_t OFF_WUP  = OFF_WO + (size_t)1024 * 1024 * 2;
constexpr size_t OFF_WDN  = OFF_WUP + (size_t)4096 * 1024 * 2;
constexpr size_t OFF_CS   = OFF_WDN + (size_t)4096 * 1024 * 2;
constexpr size_t OFF_RSX  = OFF_CS + SZ_T * 32 * 8;
constexpr size_t OFF_PQ   = OFF_RSX + SZ_T * 4;
constexpr size_t OFF_PKV  = OFF_PQ + SZ_T * 16;
constexpr size_t OFF_HSS  = OFF_PKV + SZ_T * 16;
constexpr size_t OFF_PH   = OFF_HSS + SZ_T * 64;
constexpr size_t OFF_PF   = OFF_PH + SZ_T * 64;
constexpr size_t OFF_BAR  = OFF_PF + SZ_T * 64;
constexpr size_t WS_END   = OFF_BAR + 16384;

struct Params {
    const float* x; const int* pos; const float* g_attn; const float* w_in; const float* g_qa; const float* w_qb;
    const float* g_kva; const float* w_kvb; const float* g_sbo; const float* g_mlao; const float* w_o; const float* g_mlp;
    const float* w_up; const float* w_down; const float* g_final;
    float* out; unsigned char* ws;
};

__device__ const float INV_FREQ[32] = {
    1.000000000e+00f, 7.498942018e-01f, 5.623413324e-01f, 4.216965139e-01f, 3.162277639e-01f, 2.371373773e-01f, 1.778279394e-01f, 1.333521456e-01f,
    1.000000015e-01f, 7.498942316e-02f, 5.623413250e-02f, 4.216964915e-02f, 3.162277490e-02f, 2.371373773e-02f, 1.778279431e-02f, 1.333521400e-02f,
    9.999999776e-03f, 7.498942316e-03f, 5.623413250e-03f, 4.216964822e-03f, 3.162277630e-03f, 2.371373819e-03f, 1.778279431e-03f, 1.333521446e-03f,
    1.000000047e-03f, 7.498941850e-04f, 5.623413017e-04f, 4.216965172e-04f, 3.162277571e-04f, 2.371373703e-04f, 1.778279402e-04f, 1.333521504e-04f};

DI unsigned pk2(float lo, float hi) { f32x2 v = {lo, hi}; bf2_t r = __builtin_convertvector(v, bf2_t); return __builtin_bit_cast(unsigned, r); }
DI u32x4 pack8(f32x4 a, f32x4 b) { u32x4 o; o.x = pk2(a.x, a.y); o.y = pk2(a.z, a.w); o.z = pk2(b.x, b.y); o.w = pk2(b.z, b.w); return o; }
DI void unpack8(u32x4 w, f32x4& a, f32x4& b) {
    a.x = __uint_as_float(w.x << 16); a.y = __uint_as_float(w.x & 0xffff0000u); a.z = __uint_as_float(w.y << 16); a.w = __uint_as_float(w.y & 0xffff0000u);
    b.x = __uint_as_float(w.z << 16); b.y = __uint_as_float(w.z & 0xffff0000u); b.z = __uint_as_float(w.w << 16); b.w = __uint_as_float(w.w & 0xffff0000u);
}
DI float sum4(f32x4 v) { return (v.x + v.y) + (v.z + v.w); }
DI float sq4(f32x4 v) { return (v.x * v.x + v.y * v.y) + (v.z * v.z + v.w * v.w); }
DI float wave_sum(float v) {
#pragma unroll
    for (int o = 1; o < 64; o <<= 1) v += __shfl_xor(v, o);
    return v;
}
DI f32x16 zero16() { f32x16 z; for (int i = 0; i < 16; ++i) z[i] = 0.f; return z; }
DI const char* uptr(const char* p) {
    const unsigned long long u = (unsigned long long)p;
    const unsigned lo = __builtin_amdgcn_readfirstlane((unsigned)u), hi = __builtin_amdgcn_readfirstlane((unsigned)(u >> 32));
    return (const char*)(((unsigned long long)hi << 32) | lo);
}
DI int fresh_tid(int wid_s) {
    int l; asm volatile("v_mbcnt_lo_u32_b32 %0, -1, 0\n\tv_mbcnt_hi_u32_b32 %0, -1, %0" : "=v"(l));
    return wid_s * 64 + l;
}
typedef unsigned u32x2p __attribute__((ext_vector_type(2)));
DI void xhalf(float x, float& lo, float& hi) { const u32x2p r = __builtin_amdgcn_permlane32_swap(__float_as_uint(x), __float_as_uint(x), false, false); lo = __uint_as_float(r.x); hi = __uint_as_float(r.y); }
DI float xhalf_max(float x) { float lo, hi; xhalf(x, lo, hi); return fmaxf(lo, hi); }
DI float xhalf_sum(float x) { float lo, hi; xhalf(x, lo, hi); return lo + hi; }
#define MFMA32(a, b, c) __builtin_amdgcn_mfma_f32_32x32x16_bf16((a), (b), (c), 0, 0, 0)

DI void p0_weight_item(const Params& p, LAS float* scr, int mid, int t, int lane) {
    const float* W; int K, N, Kpad; bf16_t* out;
    switch (mid) {
        case 0:  W = p.w_in;   K = 1024; N = 1984; Kpad = 1024; out = (bf16_t*)(p.ws + OFF_WIN); break;
        case 1:  W = p.w_qb;   K = 256;  N = 768;  Kpad = 256;  out = (bf16_t*)(p.ws + OFF_WQB); break;
        case 2:  W = p.w_kvb;  K = 128;  N = 1024; Kpad = 256;  out = (bf16_t*)(p.ws + OFF_WKVB); break;
        case 3:  W = p.w_o;    K = 1024; N = 1024; Kpad = 1024; out = (bf16_t*)(p.ws + OFF_WO); break;
        case 4:  W = p.w_up;   K = 1024; N = 4096; Kpad = 1024; out = (bf16_t*)(p.ws + OFF_WUP); break;
        default: W = p.w_down; K = 4096; N = 1024; Kpad = 4096; out = (bf16_t*)(p.ws + OFF_WDN); break;
    }
    const int nkt = Kpad / 64, k0 = (t % nkt) * 64, n0 = (t / nkt) * 32;
    const int nn = lane & 31, no = n0 + nn;
    int src = no; float sc = 1.f;
    if (mid == 0) {
        if (no < 512) sc = 0.125f;
        else if (no >= 1920) { if (no < 1984) { const int pp = no - 1920; src = 1920 + ((pp >> 2) & 1) * 32 + 4 * (pp >> 3) + (pp & 3); } else src = -1; }
    } else if (mid == 1) {
        sc = MLA_QSCALE;
        if (no < 512) src = (no >> 7) * 192 + (no & 127);
        else { const int q = no - 512, hd = q >> 6, pp = q & 63; src = hd * 192 + 128 + ((pp >> 2) & 1) * 32 + 4 * (pp >> 3) + (pp & 3); }
    }
#pragma unroll 8
    for (int i = 0; i < 32; ++i) {
        const int kk = 2 * i + (lane >> 5), k = k0 + kk;
        float gv = 1.f; bool ok = src >= 0;
        if (mid == 0) gv = p.g_attn[k];
        else if (mid == 1) gv = p.g_qa[k];
        else if (mid == 2) { if (k >= K) ok = false; else gv = p.g_kva[k]; }
        else if (mid == 3) gv = (k < 512) ? p.g_sbo[k] : p.g_mlao[k - 512];
        else if (mid == 4) gv = p.g_mlp[k];
        float val = 0.f;
        if (ok) val = W[(size_t)k * N + src] * gv * sc;
        scr[kk * 33 + nn] = val;
    }
    asm volatile("s_waitcnt lgkmcnt(0)" ::: "memory");
    {
        const int c = lane & 7;
#pragma unroll
        for (int j = 0; j < 4; ++j) {
            const int n = (lane >> 3) + 8 * j; const LAS float* sp = scr + (8 * c) * 33 + n;
            u32x4 o; o.x = pk2(sp[0], sp[33]); o.y = pk2(sp[2 * 33], sp[3 * 33]); o.z = pk2(sp[4 * 33], sp[5 * 33]); o.w = pk2(sp[6 * 33], sp[7 * 33]);
            *(u32x4*)(out + (size_t)(n0 + n) * Kpad + k0 + 8 * c) = o;
        }
    }
    asm volatile("s_waitcnt lgkmcnt(0)" ::: "memory");
}

DI void phase0(const Params& p, LAS unsigned char* lds, int tid) {
    const int G = gridDim.x, blk = blockIdx.x;
    const int wid = tid >> 6, lane = tid & 63;
    {
        LAS float* scr = (LAS float*)(lds + wid * 8448);
        constexpr int C0 = 1024, C1 = C0 + 96, C2 = C1 + 128, C3 = C2 + 512, C4 = C3 + 2048, C5 = C4 + 2048;
        for (int it = blk * 8 + wid; it < C5; it += G * 8) {
            if (it < C0) p0_weight_item(p, scr, 0, it, lane);
            else if (it < C1) p0_weight_item(p, scr, 1, it - C0, lane);
            else if (it < C2) p0_weight_item(p, scr, 2, it - C1, lane);
            else if (it < C3) p0_weight_item(p, scr, 3, it - C2, lane);
            else if (it < C4) p0_weight_item(p, scr, 4, it - C3, lane);
            else p0_weight_item(p, scr, 5, it - C4, lane);
        }
    }
    float* rsx = (float*)(p.ws + OFF_RSX);
    bf16_t* xb = (bf16_t*)(p.ws + OFF_XB);
    for (int row = blk * 8 + wid; row < T_; row += G * 8) {
        const f32x4* xr = (const f32x4*)(p.x + (size_t)row * 1024) + lane;
        f32x4 v[4]; float s = 0.f;
#pragma unroll
        for (int j = 0; j < 4; ++j) { v[j] = xr[64 * j]; s += sq4(v[j]); }
        s = wave_sum(s);
        if (lane == 0) rsx[row] = rsqrtf(s * (1.f / 1024.f) + EPS_);
        u32x2* o = (u32x2*)(xb + (size_t)row * 1024) + lane;
#pragma unroll
        for (int j = 0; j < 4; ++j) { u32x2 w; w.x = pk2(v[j].x, v[j].y); w.y = pk2(v[j].z, v[j].w); o[64 * j] = w; }
    }
    f32x2* cs = (f32x2*)(p.ws + OFF_CS);
    for (int idx = blk * 512 + tid; idx < T_ * 32; idx += G * 512) {
        const int t = idx >> 5, i = idx & 31;
        const float ang = (float)p.pos[t] * INV_FREQ[i];
        const double rev = (double)ang * 0.15915494309189535;
        const float fr = (float)(rev - __builtin_rint(rev));
        f32x2 v; v.x = __builtin_amdgcn_cosf(fr); v.y = __builtin_amdgcn_sinf(fr);
        cs[idx] = v;
    }
}

namespace g8 {
constexpr int BM = 256, BK = 64, HALF = 128, HTB = HALF * BK * 2, STAGE_BYTES = 8 * HTB, NXCD = 8, WGM = 8;
DI int lds_byte(int r, int c) { const int st = (r >> 4) * 2 + (c >> 5), rr = r & 15, cc = c & 31, ob = rr * 64 + cc * 2; return st * 1024 + (ob ^ (((ob >> 9) & 1) << 5)); }
DI void stage_rc(int b, int& R, int& C) { const int st = b / 1024, sb = b % 1024, swz = sb ^ (((sb >> 9) & 1) << 5); R = (st >> 1) * 16 + swz / 64; C = (st & 1) * 32 + (swz % 64) / 2; }
DI int perm32(int rho) { const int n = rho >> 4, i = rho & 15; return 8 * (i >> 2) + 4 * n + (i & 3); }
struct Unit { int pm, pn, kh; };

template <int NKH, int ROT = 0>
DI bool next_unit(int i, int nM, int nN, Unit& u) {
    const int ti = i / NKH; u.kh = i % NKH;
    const int nwg = nM * nN;
    const long L = (long)ti * gridDim.x + blockIdx.x; if (L >= nwg) return false;
    int wgid = (int)L; { const int q = nwg / NXCD, r = nwg % NXCD, xcd = wgid % NXCD, off = wgid / NXCD; wgid = (xcd < r ? xcd * (q + 1) : r * (q + 1) + (xcd - r) * q) + off; }
    const int nig = WGM * nN, gid = wgid / nig, fm = gid * WGM, gsz = (nM - fm) < WGM ? (nM - fm) : WGM;
    u.pm = fm + ((wgid % nig) % gsz); u.pn = (wgid % nig) / gsz;
    if (ROT) u.pn = (u.pn & 4) | ((u.pn + (ti >> 1)) & 3);
    return true;
}

template <int NKH, int ROT = 0, class Epi>
DI void gemm_phase(LAS unsigned char* lds, int wid_s, const bf16_t* A, int lda, const bf16_t* Bt, int ldb, int M, int N, int Kc, const Epi& E) {
    const int tid = fresh_tid(wid_s);
    const int wid = __builtin_amdgcn_readfirstlane(tid >> 6), lane = tid & 63, wr = wid >> 2, wc = wid & 3, fr = lane & 15, fq = lane >> 4;
    const int nt = Kc / BK, nM = M / BM, nN = N / BM;
    unsigned voffA[2], voffB[2];
#pragma unroll
    for (int i = 0; i < 2; ++i) { int R, C; stage_rc(tid * 16 + i * 8192, R, C); const int Rb = (R & ~31) + perm32(R & 31);
        voffA[i] = (unsigned)(R * lda + C) * 2u; voffB[i] = (unsigned)(Rb * ldb + C) * 2u; }
    const size_t kstep = (size_t)(BK * 2);
    const size_t hstepA = (size_t)HALF * lda * 2, hstepB = (size_t)HALF * ldb * 2;
    const size_t tstepA = 2 * hstepA, tstepB = 2 * hstepB, kchunk = (size_t)Kc * 2;
    const unsigned ldsw = (unsigned)wid * 1024u;
    const int aoff = lds_byte(wr * 64 + fr, fq * 8), boff = lds_byte(wc * 32 + fr, fq * 8);
#define G8_SA(b, h) (((b) * 2 + (h)) * HTB)
#define G8_SB(b, h) ((4 + (b) * 2 + (h)) * HTB)
#define G8_STAGE(bufoff, gbase, voff) do { const char* _gb = uptr((const char*)(gbase)); _Pragma("unroll") for (int _i = 0; _i < 2; ++_i) \
        __builtin_amdgcn_global_load_lds((const unsigned*)(_gb + (voff)[_i]), (LAS unsigned*)(lds + (bufoff) + ldsw + _i * 8192), 16, 0, 0); } while (0)
#define G8_LDA(dst, b, h) do { _Pragma("unroll") for (int m = 0; m < 4; ++m) _Pragma("unroll") for (int k = 0; k < 2; ++k) dst[m][k] = *(const LAS bf16x8*)(lds + G8_SA(b, h) + aoff + m * 2048 + k * 1024); } while (0)
#define G8_LDB(dst, b, h) do { _Pragma("unroll") for (int n = 0; n < 2; ++n) _Pragma("unroll") for (int k = 0; k < 2; ++k) dst[n][k] = *(const LAS bf16x8*)(lds + G8_SB(b, h) + boff + n * 2048 + k * 1024); } while (0)
#define G8_MMA(ai, bj, At, Bt_) do { __builtin_amdgcn_s_setprio(1); _Pragma("unroll") for (int m = 0; m < 4; ++m) _Pragma("unroll") for (int n = 0; n < 2; ++n) _Pragma("unroll") for (int k = 0; k < 2; ++k) \
        acc[ai][bj][m][n] = __builtin_amdgcn_mfma_f32_16x16x32_bf16(Bt_[n][k], At[m][k], acc[ai][bj][m][n], 0, 0, 0); __builtin_amdgcn_s_setprio(0); } while (0)
#define G8_WAIT_V(n) asm volatile("s_waitcnt vmcnt(" #n ")" ::: "memory")
#define G8_WAIT_L(n) asm volatile("s_waitcnt lgkmcnt(" #n ")" ::: "memory")
#define G8_BAR __builtin_amdgcn_s_barrier()
#define G8_SCHED __builtin_amdgcn_sched_barrier(0)
    Unit cur, nxt; int ui = 0;
    if (!next_unit<NKH, ROT>(0, nM, nN, cur)) return;
    f32x4 acc[2][2][4][2];
#pragma unroll
    for (int a = 0; a < 2; ++a)
#pragma unroll
        for (int b = 0; b < 2; ++b)
#pragma unroll
            for (int m = 0; m < 4; ++m)
#pragma unroll
                for (int n = 0; n < 2; ++n) acc[a][b][m][n] = (f32x4){0.f, 0.f, 0.f, 0.f};
    bf16x8 At[4][2], B0[2][2], B1[2][2];
    const char* cA = uptr((const char*)A + (size_t)cur.pm * tstepA + (size_t)cur.kh * kchunk + E.a_off(cur.pn));
    const char* cB = uptr((const char*)Bt + (size_t)cur.pn * tstepB + (size_t)cur.kh * kchunk);
    G8_STAGE(G8_SB(0, 0), cB, voffB); G8_STAGE(G8_SA(0, 0), cA, voffA); G8_STAGE(G8_SB(0, 1), cB + hstepB, voffB); G8_STAGE(G8_SA(0, 1), cA + hstepA, voffA);
    if (wr == 1) G8_BAR;
    G8_WAIT_V(4); G8_BAR;
    G8_STAGE(G8_SB(1, 0), cB + kstep, voffB); G8_STAGE(G8_SA(1, 0), cA + kstep, voffA); G8_STAGE(G8_SB(1, 1), cB + hstepB + kstep, voffB);
    G8_WAIT_V(6); G8_BAR;
    for (;;) {
        const bool has_next = next_unit<NKH, ROT>(ui + 1, nM, nN, nxt);
        const char* nA = uptr(has_next ? (const char*)A + (size_t)nxt.pm * tstepA + (size_t)nxt.kh * kchunk + E.a_off(nxt.pn) : cA);
        const char* nB = uptr(has_next ? (const char*)Bt + (size_t)nxt.pn * tstepB + (size_t)nxt.kh * kchunk : cB);
        for (int t = 0; t < nt; t += 2) {
            const bool last = (t == nt - 2);
            const char* a1 = cA + (size_t)(t + 1) * kstep;
            const char* a2 = last ? nA : cA + (size_t)(t + 2) * kstep; const char* b2 = last ? nB : cB + (size_t)(t + 2) * kstep;
            const char* a3 = a2 + kstep; const char* b3 = b2 + kstep;
            G8_LDB(B0, 0, 0); G8_SCHED; G8_LDA(At, 0, 0); G8_STAGE(G8_SA(1, 1), a1 + hstepA, voffA);
            G8_WAIT_L(8); G8_BAR; G8_WAIT_L(0); G8_MMA(0, 0, At, B0); G8_BAR; G8_SCHED;
            G8_LDB(B1, 0, 1); G8_STAGE(G8_SB(0, 0), b2, voffB);
            G8_BAR; G8_WAIT_L(0); G8_MMA(0, 1, At, B1); G8_BAR;
            G8_LDA(At, 0, 1); G8_STAGE(G8_SA(0, 0), a2, voffA);
            G8_BAR; G8_WAIT_L(0); G8_MMA(1, 0, At, B0); G8_BAR; G8_SCHED;
            G8_STAGE(G8_SB(0, 1), b2 + hstepB, voffB);
            G8_WAIT_V(6); G8_BAR; G8_MMA(1, 1, At, B1); G8_BAR;
            G8_LDB(B0, 1, 0); G8_SCHED; G8_LDA(At, 1, 0); G8_STAGE(G8_SA(0, 1), a2 + hstepA, voffA);
            G8_WAIT_L(8); G8_BAR; G8_WAIT_L(0); G8_MMA(0, 0, At, B0); G8_BAR; G8_SCHED;
            G8_LDB(B1, 1, 1); G8_STAGE(G8_SB(1, 0), b3, voffB);
            G8_BAR; G8_WAIT_L(0); G8_MMA(0, 1, At, B1); G8_BAR;
            G8_LDA(At, 1, 1); G8_STAGE(G8_SA(1, 0), a3, voffA);
            G8_BAR; G8_WAIT_L(0); G8_MMA(1, 0, At, B0); G8_BAR; G8_SCHED;
            G8_STAGE(G8_SB(1, 1), b3 + hstepB, voffB);
            G8_WAIT_V(6); G8_BAR; G8_MMA(1, 1, At, B1); G8_BAR;
        }
        { int l2 = lane; asm volatile("" : "+v"(l2)); E(acc, cur, wr, wc, l2 & 15, l2 >> 4); }
        if (!has_next) break;
        if (cur.kh == NKH - 1) {
#pragma unroll
            for (int a = 0; a < 2; ++a)
#pragma unroll
                for (int b = 0; b < 2; ++b)
#pragma unroll
                    for (int m = 0; m < 4; ++m)
#pragma unroll
                        for (int n = 0; n < 2; ++n) acc[a][b][m][n] = (f32x4){0.f, 0.f, 0.f, 0.f};
        }
        cur = nxt; cA = nA; cB = nB; ++ui;
    }
    G8_WAIT_V(0);
    if (wr == 0) G8_BAR;
    G8_BAR;
#undef G8_SA
#undef G8_SB
#undef G8_STAGE
#undef G8_LDA
#undef G8_LDB
#undef G8_MMA
#undef G8_WAIT_V
#undef G8_WAIT_L
#undef G8_BAR
#undef G8_SCHED
}
}
using g8::Unit;
typedef f32x4 AccT[2][2][4][2];

DI void rope8(f32x4& v0, f32x4& v1, const f32x4 ca, const f32x4 cb) {
    f32x4 o1, o2;
    o1.x = v0.x * ca.x - v1.x * ca.y; o2.x = v1.x * ca.x + v0.x * ca.y;
    o1.y = v0.y * ca.z - v1.y * ca.w; o2.y = v1.y * ca.z + v0.y * ca.w;
    o1.z = v0.z * cb.x - v1.z * cb.y; o2.z = v1.z * cb.x + v0.z * cb.y;
    o1.w = v0.w * cb.z - v1.w * cb.w; o2.w = v1.w * cb.z + v0.w * cb.w;
    v0 = o1; v1 = o2;
}
DI void store_tr8(bf16_t* base, f32x4 v0, f32x4 v1) {
    base[0 * S_] = (bf16_t)pk2(v0.x, 0.f); base[1 * S_] = (bf16_t)pk2(v0.y, 0.f); base[2 * S_] = (bf16_t)pk2(v0.z, 0.f); base[3 * S_] = (bf16_t)pk2(v0.w, 0.f);
    base[4 * S_] = (bf16_t)pk2(v1.x, 0.f); base[5 * S_] = (bf16_t)pk2(v1.y, 0.f); base[6 * S_] = (bf16_t)pk2(v1.z, 0.f); base[7 * S_] = (bf16_t)pk2(v1.w, 0.f);
}

template <class F>
DI void fill_row_tables(LAS float* tab, int wid_s, const F& f) {
    const int t2 = fresh_tid(wid_s), bx = blockIdx.x & 7, bj8 = (blockIdx.x >> 3) & 7;
    for (int idx = t2; idx < 1024; idx += 512) {
        const int row = (8 * (4 * bx + (idx >> 8)) + bj8) * 256 + (idx & 255);
        const f32x2 v = f(row); tab[idx] = v.x; tab[1024 + idx] = v.y;
    }
    __syncthreads();
}
struct RowRsx { const float* rsx; DI f32x2 operator()(int row) const { f32x2 v; v.x = rsx[row]; v.y = 0.f; return v; } };
struct RowQKV { const float* pq; const float* pkv; DI f32x2 operator()(int row) const { f32x2 v;
    v.x = rsqrtf(sum4(*(const f32x4*)(pq + (size_t)row * 4)) * (1.f / 256.f) + EPS_); v.y = rsqrtf(sum4(*(const f32x4*)(pkv + (size_t)row * 4)) * (1.f / 128.f) + EPS_); return v; } };
struct RowOut { const float* hss; DI f32x2 operator()(int row) const { const float* hp = hss + (size_t)row * 16; f32x2 v;
    const float rml = rsqrtf(sum4(*(const f32x4*)(hp + 8)) * (1.f / 512.f) + EPS_), rsb = rsqrtf((sum4(*(const f32x4*)hp) + sum4(*(const f32x4*)(hp + 4))) * (1.f / 512.f) + EPS_);
    v.x = rsb / rml; v.y = rml; return v; } };
struct RowUp { const float* ph; DI f32x2 operator()(int row) const { const f32x4* pp = (const f32x4*)(ph + (size_t)row * 16); f32x2 v;
    v.x = rsqrtf(((sum4(pp[0]) + sum4(pp[1])) + (sum4(pp[2]) + sum4(pp[3]))) * (1.f / 1024.f) + EPS_); v.y = 0.f; return v; } };
#define EPI_TAB(tab, which, i) ((tab)[(which) * 1024 + ((u.pm >> 3) & 3) * 256 + wr * 64 + fr + ((i) >> 2) * 128 + ((i) & 3) * 16])
#define EPI_ROW(ai, m) (u.pm * 256 + (ai) * 128 + wr * 64 + (m) * 16 + fr)
struct EpiProj {
    DI int a_off(int) const { return 0; }
    const LAS float* tab; const float* cs; bf16_t* proj; bf16_t* vst; float* pq; float* pkv;
    DI void operator()(AccT& acc, const Unit& u, int wr, int wc, int fr, int fq) const {
        const int pn = u.pn;
        float rsv[8];
#pragma unroll
        for (int i = 0; i < 8; ++i) rsv[i] = EPI_TAB(tab, 0, i);
        const bool do_rope = (pn == 7 && wc < 2);
        f32x4 rca[8], rcb[8];
        if (do_rope) {
#pragma unroll
            for (int i = 0; i < 8; ++i) { const float* cr = cs + (size_t)EPI_ROW(i >> 2, i & 3) * 64 + 2 * (16 * wc + 4 * fq); rca[i] = *(const f32x4*)cr; rcb[i] = *(const f32x4*)(cr + 4); }
        }
#pragma unroll
        for (int ai = 0; ai < 2; ++ai)
#pragma unroll
            for (int m = 0; m < 4; ++m) {
                const int row = EPI_ROW(ai, m);
                const float rs = rsv[ai * 4 + m]; float ss = 0.f;
#pragma unroll
                for (int bj = 0; bj < 2; ++bj) {
                    f32x4 v0 = acc[ai][bj][m][0] * rs, v1 = acc[ai][bj][m][1] * rs;
                    const int cl = bj * 128 + wc * 32 + fq * 8;
                    if (do_rope && bj == 1) rope8(v0, v1, rca[ai * 4 + m], rcb[ai * 4 + m]);
                    if (pn == 6 || (pn == 7 && bj == 0)) ss += sq4(v0) + sq4(v1);
                    if (pn == 4 || pn == 5) {
                        const int dg = (pn - 4) * 256 + cl, hd = dg >> 6, d = dg & 63, b = row >> 12, s = row & 4095;
                        store_tr8(vst + ((size_t)(b * 8 + hd) * 64 + d) * S_ + s, v0, v1);
                    } else {
                        *(u32x4*)(proj + (size_t)row * 2048 + pn * 256 + cl) = pack8(v0, v1);
                    }
                }
                if (pn >= 6) { ss += __shfl_xor(ss, 16); ss = xhalf_sum(ss); if (fq == 0) (pn == 6 ? pq : pkv)[(size_t)row * 4 + wc] = ss; }
            }
    }
};
struct EpiQKV {
    const LAS float* tab; const float* cs; bf16_t* qn; bf16_t* qr; bf16_t* kn; bf16_t* vmt;
    DI int a_off(int pn) const { return pn >= 3 ? 512 : 0; }
    DI void operator()(AccT& acc, const Unit& u, int wr, int wc, int fr, int fq) const {
        const int pn = u.pn;
        const int wh = pn < 3 ? 0 : 1;
        float rsv[8];
#pragma unroll
        for (int i = 0; i < 8; ++i) rsv[i] = EPI_TAB(tab, wh, i);
        f32x4 rca[8], rcb[8];
        if (pn == 2) {
#pragma unroll
            for (int i = 0; i < 8; ++i) { const float* cr = cs + (size_t)EPI_ROW(i >> 2, i & 3) * 64 + 2 * (4 * ((((wc & 1) * 32 + fq * 8)) >> 3)); rca[i] = *(const f32x4*)cr; rcb[i] = *(const f32x4*)(cr + 4); }
        }
#pragma unroll
        for (int ai = 0; ai < 2; ++ai)
#pragma unroll
            for (int m = 0; m < 4; ++m) {
                const int row = EPI_ROW(ai, m);
                const float rs = rsv[ai * 4 + m];
                if (pn < 3) {
#pragma unroll
                    for (int bj = 0; bj < 2; ++bj) {
                        f32x4 v0 = acc[ai][bj][m][0] * rs, v1 = acc[ai][bj][m][1] * rs;
                        const int cl = bj * 128 + wc * 32 + fq * 8;
                        if (pn < 2) *(u32x4*)(qn + (size_t)row * 512 + pn * 256 + cl) = pack8(v0, v1);
                        else { rope8(v0, v1, rca[ai * 4 + m], rcb[ai * 4 + m]); *(u32x4*)(qr + (size_t)row * 256 + cl) = pack8(v0, v1); }
                    }
                } else {
                    const int hd = pn - 3;
                    const int cl = wc * 32 + fq * 8, b = row >> 12, s = row & 4095;
                    { f32x4 v0 = acc[ai][0][m][0] * rs, v1 = acc[ai][0][m][1] * rs; *(u32x4*)(kn + (size_t)row * 512 + hd * 128 + cl) = pack8(v0, v1); }
                    { f32x4 v0 = acc[ai][1][m][0] * rs, v1 = acc[ai][1][m][1] * rs; store_tr8(vmt + ((size_t)(b * 4 + hd) * 128 + cl) * S_ + s, v0, v1); }
                }
            }
    }
};
struct EpiOut {
    DI int a_off(int) const { return 0; }
    const LAS float* tab; const bf16_t* xb; bf16_t* h1b; float* ph;
    DI void operator()(AccT& acc, const Unit& u, int wr, int wc, int fr, int fq) const {
        float rsv[8];
        const int wh = u.kh == 0 ? 0 : 1;
#pragma unroll
        for (int i = 0; i < 8; ++i) rsv[i] = EPI_TAB(tab, wh, i);
        if (u.kh == 0) {
#pragma unroll
            for (int ai = 0; ai < 2; ++ai)
#pragma unroll
                for (int m = 0; m < 4; ++m)
#pragma unroll
                    for (int bj = 0; bj < 2; ++bj) { acc[ai][bj][m][0] *= rsv[ai * 4 + m]; acc[ai][bj][m][1] *= rsv[ai * 4 + m]; }
            return;
        }
        u32x4 res[8][2];
#pragma unroll
        for (int i = 0; i < 8; ++i)
#pragma unroll
            for (int bj = 0; bj < 2; ++bj) res[i][bj] = *(const u32x4*)(xb + (size_t)EPI_ROW(i >> 2, i & 3) * 1024 + u.pn * 256 + bj * 128 + wc * 32 + fq * 8);
#pragma unroll
        for (int ai = 0; ai < 2; ++ai)
#pragma unroll
            for (int m = 0; m < 4; ++m) {
                const int row = EPI_ROW(ai, m);
                const float rml = rsv[ai * 4 + m];
                float ss = 0.f;
#pragma unroll
                for (int bj = 0; bj < 2; ++bj) {
                    const size_t off = (size_t)row * 1024 + u.pn * 256 + bj * 128 + wc * 32 + fq * 8;
                    f32x4 r0, r1; unpack8(res[ai * 4 + m][bj], r0, r1);
                    const f32x4 v0 = acc[ai][bj][m][0] * rml + r0, v1 = acc[ai][bj][m][1] * rml + r1;
                    *(u32x4*)(h1b + off) = pack8(v0, v1);
                    ss += sq4(v0) + sq4(v1);
                }
                ss += __shfl_xor(ss, 16); ss = xhalf_sum(ss);
                if (fq == 0) ph[(size_t)row * 16 + u.pn * 4 + wc] = ss;
            }
    }
};
struct EpiUp {
    DI int a_off(int) const { return 0; }
    const LAS float* rst; bf16_t* hid;
    DI void operator()(AccT& acc, const Unit& u, int wr, int wc, int fr, int fq) const {
        __attribute__((address_space(1))) char* hb = (__attribute__((address_space(1))) char*)(unsigned long long)uptr((const char*)hid);
        float rsv[8];
#pragma unroll
        for (int i = 0; i < 8; ++i) rsv[i] = EPI_TAB(rst, 0, i);
#pragma unroll
        for (int ai = 0; ai < 2; ++ai)
#pragma unroll
            for (int m = 0; m < 4; ++m) {
                const int row = EPI_ROW(ai, m);
                const float rs = rsv[ai * 4 + m];
#pragma unroll
                for (int bj = 0; bj < 2; ++bj) {
                    f32x4 v0 = acc[ai][bj][m][0] * rs, v1 = acc[ai][bj][m][1] * rs;
#pragma unroll
                    for (int e = 0; e < 4; ++e) { const float a = fmaxf(v0[e], 0.f), b = fmaxf(v1[e], 0.f); v0[e] = a * a; v1[e] = b * b; }
                    *(__attribute__((address_space(1))) u32x4*)(hb + ((unsigned)row * 8192u + (unsigned)(u.pn * 256 + bj * 128 + wc * 32 + fq * 8) * 2u)) = pack8(v0, v1);
                }
            }
    }
};
struct EpiDown {
    DI int a_off(int) const { return 0; }
    const bf16_t* h1b; bf16_t* h2b; float* pf;
    DI void operator()(AccT& acc, const Unit& u, int wr, int wc, int fr, int fq) const {
        u32x4 res[8][2];
#pragma unroll
        for (int i = 0; i < 8; ++i)
#pragma unroll
            for (int bj = 0; bj < 2; ++bj) res[i][bj] = *(const u32x4*)(h1b + (size_t)EPI_ROW(i >> 2, i & 3) * 1024 + u.pn * 256 + bj * 128 + wc * 32 + fq * 8);
#pragma unroll
        for (int ai = 0; ai < 2; ++ai)
#pragma unroll
            for (int m = 0; m < 4; ++m) {
                const int row = EPI_ROW(ai, m);
                float ss = 0.f;
#pragma unroll
                for (int bj = 0; bj < 2; ++bj) {
                    const size_t off = (size_t)row * 1024 + u.pn * 256 + bj * 128 + wc * 32 + fq * 8;
                    f32x4 r0, r1; unpack8(res[ai * 4 + m][bj], r0, r1);
                    const f32x4 v0 = acc[ai][bj][m][0] + r0, v1 = acc[ai][bj][m][1] + r1;
                    *(u32x4*)(h2b + off) = pack8(v0, v1);
                    ss += sq4(v0) + sq4(v1);
                }
                ss += __shfl_xor(ss, 16); ss = xhalf_sum(ss);
                if (fq == 0) pf[(size_t)row * 16 + u.pn * 4 + wc] = ss;
            }
    }
};

constexpr int MLA_KROW = 400, MLA_VROW = 144, MLA_KBYTES = 64 * MLA_KROW, MLA_BUF = MLA_KBYTES + 128 * MLA_VROW;

DI void mla_s_softmax(const LAS unsigned char* base, int r, int h, bool is_diag, int lim, const bf16x8 (&qf)[12], f32x16 (&o)[4], float& m_run, float& l_run,
                      bf16x8 (&pf0)[2], bf16x8 (&pf1)[2]) {
    f32x16 s0 = zero16(), s1 = zero16();
    const LAS unsigned char* kp = base + r * MLA_KROW + h * 16;
#pragma unroll
    for (int g = 0; g < 3; ++g) {
        bf16x8 fa[4], fb[4];
#pragma unroll
        for (int j = 0; j < 4; ++j) { fa[j] = *(const LAS bf16x8*)(kp + (4 * g + j) * 32); fb[j] = *(const LAS bf16x8*)(kp + 32 * MLA_KROW + (4 * g + j) * 32); }
        __builtin_amdgcn_sched_barrier(0);
#pragma unroll
        for (int j = 0; j < 4; ++j) { s0 = MFMA32(fa[j], qf[4 * g + j], s0); s1 = MFMA32(fb[j], qf[4 * g + j], s1); }
        __builtin_amdgcn_sched_barrier(0);
    }
    if (is_diag) {
#pragma unroll
        for (int i = 0; i < 16; ++i) { if (16 * h + i > lim) s0[i] = -1e30f; if (32 + 16 * h + i > lim) s1[i] = -1e30f; }
    }
    float mx = fmaxf(s0[0], s1[0]);
#pragma unroll
    for (int i = 1; i < 16; ++i) mx = fmaxf(mx, fmaxf(s0[i], s1[i]));
    mx = xhalf_max(mx);
    const float mnew = fmaxf(m_run, mx);
    if (__builtin_amdgcn_ballot_w64(mnew > m_run + 8.0f) != 0ull) {
        const float alpha = __builtin_amdgcn_exp2f(m_run - mnew);
        l_run *= alpha;
#pragma unroll
        for (int dt = 0; dt < 4; ++dt) o[dt] *= alpha;
        m_run = mnew;
    }
    float ls = 0.f;
#pragma unroll
    for (int i = 0; i < 16; ++i) { s0[i] = __builtin_amdgcn_exp2f(s0[i] - m_run); s1[i] = __builtin_amdgcn_exp2f(s1[i] - m_run); ls += s0[i] + s1[i]; }
    l_run += ls;
#pragma unroll
    for (int s = 0; s < 2; ++s) {
        u32x4 a, c;
        a.x = pk2(s0[8 * s + 0], s0[8 * s + 1]); a.y = pk2(s0[8 * s + 2], s0[8 * s + 3]); a.z = pk2(s0[8 * s + 4], s0[8 * s + 5]); a.w = pk2(s0[8 * s + 6], s0[8 * s + 7]);
        c.x = pk2(s1[8 * s + 0], s1[8 * s + 1]); c.y = pk2(s1[8 * s + 2], s1[8 * s + 3]); c.z = pk2(s1[8 * s + 4], s1[8 * s + 5]); c.w = pk2(s1[8 * s + 6], s1[8 * s + 7]);
        pf0[s] = __builtin_bit_cast(bf16x8, a); pf1[s] = __builtin_bit_cast(bf16x8, c);
    }
}
DI void mla_pv(const LAS unsigned char* base, int r, int h, const bf16x8 (&pf0)[2], const bf16x8 (&pf1)[2], f32x16 (&o)[4]) {
    const LAS unsigned char* vp = base + MLA_KBYTES + r * MLA_VROW + h * 32;
#pragma unroll
    for (int s = 0; s < 2; ++s) {
        bf16x8 va[4], vb[4];
#pragma unroll
        for (int dt = 0; dt < 4; ++dt) { va[dt] = *(const LAS bf16x8*)(vp + dt * 32 * MLA_VROW + s * 16); vb[dt] = *(const LAS bf16x8*)(vp + dt * 32 * MLA_VROW + 64 + s * 16); }
        __builtin_amdgcn_sched_barrier(0);
#pragma unroll
        for (int dt = 0; dt < 4; ++dt) o[dt] = MFMA32(va[dt], pf0[s], o[dt]);
#pragma unroll
        for (int dt = 0; dt < 4; ++dt) o[dt] = MFMA32(vb[dt], pf1[s], o[dt]);
        __builtin_amdgcn_sched_barrier(0);
    }
}

DI void mla_block(const Params& p, LAS unsigned char* lds, int b, int hd, int qb, int tid) {
    asm volatile("" : "+v"(tid));
    const int wu = __builtin_amdgcn_readfirstlane(tid >> 6), lane = tid & 63, r = lane & 31, h = lane >> 5;
    const int q0 = qb * 256 + wu * 32;
    const bf16_t* QN = (const bf16_t*)(p.ws + OFF_QN); const bf16_t* QR = (const bf16_t*)(p.ws + OFF_QR);
    const size_t tok0 = (size_t)b * S_;
    bf16x8 qf[12];
    {
        const size_t qrow = tok0 + q0 + r;
#pragma unroll
        for (int ks = 0; ks < 8; ++ks) qf[ks] = *(const bf16x8*)(QN + qrow * 512 + hd * 128 + ks * 16 + h * 8);
#pragma unroll
        for (int ks = 0; ks < 4; ++ks) qf[8 + ks] = *(const bf16x8*)(QR + qrow * 256 + hd * 64 + ks * 16 + h * 8);
    }
    unsigned goff[6];
#pragma unroll
    for (int j = 0; j < 6; ++j) {
        const int pc = wu + 8 * j; goff[j] = 0;
        if (pc < 25) {
            const int c = pc * 64 + lane, lr = c / 25; int cc = c - lr * 25; if (cc == 24) cc = 0;
            const int k32 = lr & 31, key = (lr & 32) + 16 * ((k32 >> 2) & 1) + (k32 & 3) + 4 * (k32 >> 3);
            const unsigned tok = (unsigned)(b * S_ + key);
            goff[j] = (cc < 16) ? (unsigned)OFF_KN + (tok * 512u + hd * 128 + cc * 8) * 2u : (unsigned)OFF_PROJ + (tok * 2048u + 1920 + (cc - 16) * 8) * 2u;
        } else if (pc < 43) {
            const int c = (pc - 25) * 64 + lane, d = c / 9; int cc = c - d * 9; if (cc == 8) cc = 0;
            goff[j] = (unsigned)OFF_VMT + ((unsigned)((b * 4 + hd) * 128 + d) * (unsigned)S_ + cc * 8) * 2u;
        }
    }
    const char* wsb = uptr((const char*)p.ws);
#define MLA_STAGE(KT, BUF) do { _Pragma("unroll") for (int _j = 0; _j < 6; ++_j) { const int _pc = wu + 8 * _j; if (_pc < 43) { \
        const unsigned _inc = goff[_j] >= (unsigned)OFF_VMT ? 128u : (goff[_j] < (unsigned)OFF_VST ? 262144u : 65536u); \
        __builtin_amdgcn_global_load_lds((const unsigned*)(wsb + (goff[_j] + (unsigned)(KT) * _inc)), (LAS unsigned*)(lds + (BUF) * MLA_BUF + _pc * 1024), 16, 0, 0); } } } while (0)
    f32x16 o[4]; for (int dt = 0; dt < 4; ++dt) o[dt] = zero16();
    float m_run = -1e30f, l_run = 0.f;
    const int ntiles = 4 * qb + 4, wlast = q0 >> 6;
    __syncthreads();
    MLA_STAGE(0, 0);
    const bool late = wu >= 4;
    bf16x8 pf0[2], pf1[2];
    int bcur = 0;
    for (int kt = 0; kt < ntiles; ++kt) {
        asm volatile("s_waitcnt vmcnt(0)" ::: "memory");
        __builtin_amdgcn_s_barrier();
        asm volatile("" ::: "memory");
        const int bprev = bcur == 0 ? 2 : bcur - 1, bnext = bcur == 2 ? 0 : bcur + 1;
        if (kt + 1 < ntiles) MLA_STAGE(kt + 1, bnext);
        if (late && kt >= 1 && kt - 1 <= wlast) mla_pv(lds + bprev * MLA_BUF, r, h, pf0, pf1, o);
        if (kt <= wlast) {
            mla_s_softmax(lds + bcur * MLA_BUF, r, h, kt == wlast, q0 + r - kt * 64, qf, o, m_run, l_run, pf0, pf1);
            if (!late) mla_pv(lds + bcur * MLA_BUF, r, h, pf0, pf1, o);
        }
        bcur = bnext;
    }
    if (late && wlast == ntiles - 1) { const int bprev = bcur == 0 ? 2 : bcur - 1; mla_pv(lds + bprev * MLA_BUF, r, h, pf0, pf1, o); }
#undef MLA_STAGE
    const float lt = xhalf_sum(l_run), inv = 1.f / lt;
    bf16_t* mix = (bf16_t*)(p.ws + OFF_MIX) + (tok0 + q0 + r) * 1024 + 512 + hd * 128 + 4 * h;
    float ss = 0.f;
#pragma unroll
    for (int dt = 0; dt < 4; ++dt)
#pragma unroll
        for (int g = 0; g < 4; ++g) {
            const float a0 = o[dt][4 * g] * inv, a1 = o[dt][4 * g + 1] * inv, a2 = o[dt][4 * g + 2] * inv, a3 = o[dt][4 * g + 3] * inv;
            ss += (a0 * a0 + a1 * a1) + (a2 * a2 + a3 * a3);
            u32x2 w; w.x = pk2(a0, a1); w.y = pk2(a2, a3);
            *(u32x2*)(mix + dt * 32 + 8 * g) = w;
        }
    ss = xhalf_sum(ss);
    if (h == 0) ((float*)(p.ws + OFF_HSS))[(tok0 + q0 + r) * 16 + 8 + hd] = ss;
}

DI void sb_item(const Params& p, int bh, int qb32, int lane) {
    asm volatile("" : "+v"(lane));
    const int r = lane & 31, h = lane >> 5, b = bh >> 3, hd = bh & 7, q0 = qb32 * 32;
    const bf16_t* PROJ = (const bf16_t*)(p.ws + OFF_PROJ);
    const bf16_t* VST = (const bf16_t*)(p.ws + OFF_VST);
    const size_t tok0 = (size_t)b * S_;
    bf16x8 qf[4];
#pragma unroll
    for (int ks = 0; ks < 4; ++ks) qf[ks] = *(const bf16x8*)(PROJ + (tok0 + q0 + r) * 2048 + hd * 64 + ks * 16 + h * 8);
    const int pr = 16 * ((r >> 2) & 1) + (r & 3) + 4 * (r >> 3);
    const bf16_t* kbase = PROJ + (tok0 + pr) * 2048 + 512 + hd * 64 + h * 8;
    const bf16_t* vbase = VST + ((size_t)(b * 8 + hd) * 64 + r) * S_ + 16 * h;
    bf16x8 kc[4], kn[4], vf[4];
#pragma unroll
    for (int ks = 0; ks < 4; ++ks) kc[ks] = *(const bf16x8*)(kbase + (size_t)q0 * 2048 + ks * 16);
    f32x16 o0 = zero16(), o1 = zero16();
    float carry = 1.f;
    for (int kb = q0; kb >= 0; kb -= 32) {
#pragma unroll
        for (int dt = 0; dt < 2; ++dt)
#pragma unroll
            for (int s = 0; s < 2; ++s) vf[dt * 2 + s] = *(const bf16x8*)(vbase + (size_t)dt * 32 * S_ + kb + 8 * s);
        if (kb >= 32) {
#pragma unroll
            for (int ks = 0; ks < 4; ++ks) kn[ks] = *(const bf16x8*)(kbase + (size_t)(kb - 32) * 2048 + ks * 16);
        }
        f32x16 z = zero16();
#pragma unroll
        for (int ks = 0; ks < 4; ++ks) z = MFMA32(kc[ks], qf[ks], z);
        const bool diag = (kb == q0);
        f32x16 a;
        float tot = 1.f;
#pragma unroll
        for (int i = 15; i >= 0; --i) {
            const float w = __builtin_amdgcn_exp2f(fmaxf(z[i], -60.f) * -LOG2E);
            float be = __builtin_amdgcn_rcpf(1.f + w);
            float om = w * be;
            if (diag) { const bool valid = (16 * h + i < r); be = valid ? be : 0.f; om = valid ? om : 1.f; }
            a[i] = be * tot;
            tot *= om;
        }
        const float other = __shfl_xor(tot, 32);
        const float base = carry * (h == 0 ? other : 1.f);
        carry *= tot * other;
#pragma unroll
        for (int i = 0; i < 16; ++i) a[i] *= base;
        bf16x8 pf[2];
#pragma unroll
        for (int s = 0; s < 2; ++s) {
            u32x4 w; w.x = pk2(a[8 * s + 0], a[8 * s + 1]); w.y = pk2(a[8 * s + 2], a[8 * s + 3]); w.z = pk2(a[8 * s + 4], a[8 * s + 5]); w.w = pk2(a[8 * s + 6], a[8 * s + 7]);
            pf[s] = __builtin_bit_cast(bf16x8, w);
        }
#pragma unroll
        for (int s = 0; s < 2; ++s) { o0 = MFMA32(vf[s], pf[s], o0); o1 = MFMA32(vf[2 + s], pf[s], o1); }
        if (kb >= 32) {
#pragma unroll
            for (int ks = 0; ks < 4; ++ks) kc[ks] = kn[ks];
        }
        if (__all(carry < SB_PTHR)) break;
    }
    bf16_t* mix = (bf16_t*)(p.ws + OFF_MIX) + (tok0 + q0 + r) * 1024 + hd * 64 + 4 * h;
    float ss = 0.f;
#pragma unroll
    for (int g = 0; g < 4; ++g) {
        { const float a0 = o0[4 * g], a1 = o0[4 * g + 1], a2 = o0[4 * g + 2], a3 = o0[4 * g + 3];
          ss += (a0 * a0 + a1 * a1) + (a2 * a2 + a3 * a3); u32x2 w; w.x = pk2(a0, a1); w.y = pk2(a2, a3); *(u32x2*)(mix + 8 * g) = w; }
        { const float a0 = o1[4 * g], a1 = o1[4 * g + 1], a2 = o1[4 * g + 2], a3 = o1[4 * g + 3];
          ss += (a0 * a0 + a1 * a1) + (a2 * a2 + a3 * a3); u32x2 w; w.x = pk2(a0, a1); w.y = pk2(a2, a3); *(u32x2*)(mix + 32 + 8 * g) = w; }
    }
    ss = xhalf_sum(ss);
    if (h == 0) ((float*)(p.ws + OFF_HSS))[(tok0 + q0 + r) * 16 + hd] = ss;
}

constexpr int SB_ROW = 144, SB_KBYTES = 64 * SB_ROW, SB_BUF = 2 * SB_KBYTES  , SB_NB = 7, SB_FLAGS = SB_NB * SB_BUF;
DI void sb_block(const Params& p, LAS unsigned char* lds, int bh, int qb, int tid) {
    asm volatile("" : "+v"(tid));
    const int wu = __builtin_amdgcn_readfirstlane(tid >> 6), lane = tid & 63, r = lane & 31, h = lane >> 5;
    const int b = bh >> 3, hd = bh & 7, q0 = qb * 256 + wu * 32;
    const bf16_t* PROJ = (const bf16_t*)(p.ws + OFF_PROJ);
    const size_t tok0 = (size_t)b * S_;
    bf16x8 qf[4];
#pragma unroll
    for (int ks = 0; ks < 4; ++ks) qf[ks] = *(const bf16x8*)(PROJ + (tok0 + q0 + r) * 2048 + hd * 64 + ks * 16 + h * 8);
    unsigned goff[3];
#pragma unroll
    for (int j = 0; j < 3; ++j) {
        const int pc = wu + 8 * j; goff[j] = 0;
        if (pc < 18) {
            const int c = (pc < 9 ? pc : pc - 9) * 64 + lane, lr = c / 9; int cc = c - lr * 9; if (cc == 8) cc = 0;
            if (pc < 9) { const int k32 = lr & 31, key = (lr & 32) + 16 * ((k32 >> 2) & 1) + (k32 & 3) + 4 * (k32 >> 3);
                goff[j] = (unsigned)OFF_PROJ + ((unsigned)(b * S_ + key) * 2048u + 512 + hd * 64 + cc * 8) * 2u; }
            else goff[j] = (unsigned)OFF_VST + ((unsigned)((b * 8 + hd) * 64 + lr) * (unsigned)S_ + cc * 8) * 2u;
        }
    }
    const char* wsb = uptr((const char*)p.ws);
#define SB_STAGE(KT, BUF) do { _Pragma("unroll") for (int _j = 0; _j < 3; ++_j) { const int _pc = wu + 8 * _j; if (_pc < 18) { \
        const unsigned _inc = goff[_j] >= (unsigned)OFF_VST ? 128u : 262144u; \
        __builtin_amdgcn_global_load_lds((const unsigned*)(wsb + (goff[_j] + (unsigned)(KT) * _inc)), (LAS unsigned*)(lds + (BUF) * SB_BUF + _pc * 1024), 16, 0, 0); } } } while (0)
    f32x16 o0 = zero16(), o1 = zero16();
    float carry = 1.f;
    bool done = false;
    const int ktop = 4 * qb + 3;
    LAS int* flags = (LAS int*)(lds + SB_FLAGS);
    asm volatile("s_waitcnt vmcnt(0)" ::: "memory");
    __syncthreads();
    const int nstaged = ktop + 1 < SB_NB ? ktop + 1 : SB_NB;
    for (int i = 0; i < nstaged; ++i) SB_STAGE(ktop - i, i);
#define SB_WAITV(n) asm volatile("s_waitcnt vmcnt(" #n ") lgkmcnt(0)" ::: "memory")
    int cur = 0, it = 0;
    for (int kt = ktop; ; --kt, ++it) {
        if (lane == 0) flags[(it & 1) * 8 + wu] = done ? 1 : 0;
        if (it >= SB_NB && kt >= 0) SB_STAGE(kt, cur);
        const int ahead = it < nstaged ? nstaged - 1 - it : 0;
        if (wu < 2) { switch (ahead) { case 0: SB_WAITV(0); break; case 1: SB_WAITV(3); break; case 2: SB_WAITV(6); break; case 3: SB_WAITV(9); break; case 4: SB_WAITV(12); break; case 5: SB_WAITV(15); break; default: SB_WAITV(18); break; } }
        else { switch (ahead) { case 0: SB_WAITV(0); break; case 1: SB_WAITV(2); break; case 2: SB_WAITV(4); break; case 3: SB_WAITV(6); break; case 4: SB_WAITV(8); break; case 5: SB_WAITV(10); break; default: SB_WAITV(12); break; } }
        __builtin_amdgcn_s_barrier();
        asm volatile("" ::: "memory");
        {
            const LAS int* f = flags + (it & 1) * 8;
            const int all = f[0] & f[1] & f[2] & f[3] & f[4] & f[5] & f[6] & f[7];
            if (__builtin_amdgcn_readfirstlane(all)) break;
        }
        if (!done && kt * 64 <= q0) {
            const LAS unsigned char* base = lds + cur * SB_BUF;
#pragma unroll
            for (int sub = 1; sub >= 0; --sub) {
                const int kb = kt * 64 + sub * 32;
                if (kb <= q0 && !done) {
                    const LAS unsigned char* kp = base + (sub * 32 + r) * SB_ROW + h * 16;
                    bf16x8 kf[4], vf[4];
#pragma unroll
                    for (int ks = 0; ks < 4; ++ks) kf[ks] = *(const LAS bf16x8*)(kp + ks * 32);
#pragma unroll
                    for (int dt = 0; dt < 2; ++dt)
#pragma unroll
                        for (int s2 = 0; s2 < 2; ++s2) vf[dt * 2 + s2] = *(const LAS bf16x8*)(base + SB_KBYTES + (dt * 32 + r) * SB_ROW + (sub * 32 + 16 * h + 8 * s2) * 2);
                    f32x16 z = zero16();
#pragma unroll
                    for (int ks = 0; ks < 4; ++ks) z = MFMA32(kf[ks], qf[ks], z);
                    const bool diag = (kb == q0);
                    f32x16 a;
                    float tot = 1.f;
#pragma unroll
                    for (int i = 15; i >= 0; --i) {
                        const float w = __builtin_amdgcn_exp2f(fmaxf(z[i], -60.f) * -LOG2E);
                        float be = __builtin_amdgcn_rcpf(1.f + w);
                        float om = w * be;
                        if (diag) { const bool valid = (16 * h + i < r); be = valid ? be : 0.f; om = valid ? om : 1.f; }
                        a[i] = be * tot;
                        tot *= om;
                    }
                    const float other = __shfl_xor(tot, 32);
                    const float bs = carry * (h == 0 ? other : 1.f);
                    carry *= tot * other;
#pragma unroll
                    for (int i = 0; i < 16; ++i) a[i] *= bs;
                    bf16x8 pf[2];
#pragma unroll
                    for (int s2 = 0; s2 < 2; ++s2) {
                        u32x4 w; w.x = pk2(a[8 * s2 + 0], a[8 * s2 + 1]); w.y = pk2(a[8 * s2 + 2], a[8 * s2 + 3]); w.z = pk2(a[8 * s2 + 4], a[8 * s2 + 5]); w.w = pk2(a[8 * s2 + 6], a[8 * s2 + 7]);
                        pf[s2] = __builtin_bit_cast(bf16x8, w);
                    }
#pragma unroll
                    for (int s2 = 0; s2 < 2; ++s2) { o0 = MFMA32(vf[s2], pf[s2], o0); o1 = MFMA32(vf[2 + s2], pf[s2], o1); }
                    if (__all(carry < SB_PTHR)) done = true;
                }
            }
            if (kt == 0) done = true;
        }
        cur = cur == SB_NB - 1 ? 0 : cur + 1;
    }
    asm volatile("s_waitcnt vmcnt(0)" ::: "memory");
#undef SB_WAITV
#undef SB_STAGE
    bf16_t* mix = (bf16_t*)(p.ws + OFF_MIX) + (tok0 + q0 + r) * 1024 + hd * 64 + 4 * h;
    float ss = 0.f;
#pragma unroll
    for (int g = 0; g < 4; ++g) {
        { const float a0 = o0[4 * g], a1 = o0[4 * g + 1], a2 = o0[4 * g + 2], a3 = o0[4 * g + 3];
          ss += (a0 * a0 + a1 * a1) + (a2 * a2 + a3 * a3); u32x2 w; w.x = pk2(a0, a1); w.y = pk2(a2, a3); *(u32x2*)(mix + 8 * g) = w; }
        { const float a0 = o1[4 * g], a1 = o1[4 * g + 1], a2 = o1[4 * g + 2], a3 = o1[4 * g + 3];
          ss += (a0 * a0 + a1 * a1) + (a2 * a2 + a3 * a3); u32x2 w; w.x = pk2(a0, a1); w.y = pk2(a2, a3); *(u32x2*)(mix + 32 + 8 * g) = w; }
    }
    ss = xhalf_sum(ss);
    if (h == 0) ((float*)(p.ws + OFF_HSS))[(tok0 + q0 + r) * 16 + hd] = ss;
}

DI void sb_block2(const Params& p, LAS unsigned char* lds, int bh, int qb2, int tid) {
    asm volatile("" : "+v"(tid));
    const int wu = __builtin_amdgcn_readfirstlane(tid >> 6), lane = tid & 63, r = lane & 31, h = lane >> 5;
    const int b = bh >> 3, hd = bh & 7;
    int q0[2]; q0[0] = qb2 * 512 + wu * 32; q0[1] = q0[0] + 256;
    const bf16_t* PROJ = (const bf16_t*)(p.ws + OFF_PROJ);
    const size_t tok0 = (size_t)b * S_;
    bf16x8 qf[2][4];
#pragma unroll
    for (int g = 0; g < 2; ++g)
#pragma unroll
        for (int ks = 0; ks < 4; ++ks) qf[g][ks] = *(const bf16x8*)(PROJ + (tok0 + q0[g] + r) * 2048 + hd * 64 + ks * 16 + h * 8);
    unsigned goff[3];
#pragma unroll
    for (int j = 0; j < 3; ++j) {
        const int pc = wu + 8 * j; goff[j] = 0;
        if (pc < 18) {
            const int c = (pc < 9 ? pc : pc - 9) * 64 + lane, lr = c / 9; int cc = c - lr * 9; if (cc == 8) cc = 0;
            if (pc < 9) { const int k32 = lr & 31, key = (lr & 32) + 16 * ((k32 >> 2) & 1) + (k32 & 3) + 4 * (k32 >> 3);
                goff[j] = (unsigned)OFF_PROJ + ((unsigned)(b * S_ + key) * 2048u + 512 + hd * 64 + cc * 8) * 2u; }
            else goff[j] = (unsigned)OFF_VST + ((unsigned)((b * 8 + hd) * 64 + lr) * (unsigned)S_ + cc * 8) * 2u;
        }
    }
    const char* wsb = uptr((const char*)p.ws);
#define SB_STAGE(KT, BUF) do { _Pragma("unroll") for (int _j = 0; _j < 3; ++_j) { const int _pc = wu + 8 * _j; if (_pc < 18) { \
        const unsigned _inc = goff[_j] >= (unsigned)OFF_VST ? 128u : 262144u; \
        __builtin_amdgcn_global_load_lds((const unsigned*)(wsb + (goff[_j] + (unsigned)(KT) * _inc)), (LAS unsigned*)(lds + (BUF) * SB_BUF + _pc * 1024), 16, 0, 0); } } } while (0)
    f32x16 o0[2], o1[2]; float carry[2]; bool done[2];
#pragma unroll
    for (int g = 0; g < 2; ++g) { o0[g] = zero16(); o1[g] = zero16(); carry[g] = 1.f; done[g] = false; }
    const int ktop = 8 * qb2 + 7;
    LAS int* flags = (LAS int*)(lds + SB_FLAGS);
    asm volatile("s_waitcnt vmcnt(0)" ::: "memory");
    __syncthreads();
    const int nstaged = ktop + 1 < SB_NB ? ktop + 1 : SB_NB;
    for (int i = 0; i < nstaged; ++i) SB_STAGE(ktop - i, i);
#define SB_WAITV(n) asm volatile("s_waitcnt vmcnt(" #n ") lgkmcnt(0)" ::: "memory")
    int cur = 0, it = 0;
    for (int kt = ktop; ; --kt, ++it) {
        if (lane == 0) flags[(it & 1) * 8 + wu] = (done[0] && done[1]) ? 1 : 0;
        int lowest = ktop - (SB_NB - 1) - (it > 0 ? it - 1 : 0); if (lowest < 0) lowest = 0;
        int ahead = kt - lowest; if (ahead < 0) ahead = 0;
        if (wu < 2) { switch (ahead) { case 0: SB_WAITV(0); break; case 1: SB_WAITV(3); break; case 2: SB_WAITV(6); break; case 3: SB_WAITV(9); break; case 4: SB_WAITV(12); break; case 5: SB_WAITV(15); break; default: SB_WAITV(18); break; } }
        else { switch (ahead) { case 0: SB_WAITV(0); break; case 1: SB_WAITV(2); break; case 2: SB_WAITV(4); break; case 3: SB_WAITV(6); break; case 4: SB_WAITV(8); break; case 5: SB_WAITV(10); break; default: SB_WAITV(12); break; } }
        __builtin_amdgcn_s_barrier();
        asm volatile("" ::: "memory");
        {
            const LAS int* f = flags + (it & 1) * 8;
            const int all = f[0] & f[1] & f[2] & f[3] & f[4] & f[5] & f[6] & f[7];
            if (__builtin_amdgcn_readfirstlane(all)) break;
        }
        if (it >= 1 && kt - (SB_NB - 1) >= 0) SB_STAGE(kt - (SB_NB - 1), cur == 0 ? SB_NB - 1 : cur - 1);
        {
            const LAS unsigned char* base = lds + cur * SB_BUF;
#pragma unroll
            for (int sub = 1; sub >= 0; --sub) {
                const int kb = kt * 64 + sub * 32;
                const LAS unsigned char* kp = base + (sub * 32 + r) * SB_ROW + h * 16;
                const bool act0 = !done[0] && kb <= q0[0], act1 = !done[1] && kb <= q0[1];
                if (act0 || act1) {
                    bf16x8 kf[4], vf[4];
#pragma unroll
                    for (int ks = 0; ks < 4; ++ks) kf[ks] = *(const LAS bf16x8*)(kp + ks * 32);
#pragma unroll
                    for (int dt = 0; dt < 2; ++dt)
#pragma unroll
                        for (int s2 = 0; s2 < 2; ++s2) vf[dt * 2 + s2] = *(const LAS bf16x8*)(base + SB_KBYTES + (dt * 32 + r) * SB_ROW + (sub * 32 + 16 * h + 8 * s2) * 2);
#pragma unroll
                    for (int g = 0; g < 2; ++g) {
                        if (g == 0 ? act0 : act1) {
                            f32x16 z = zero16();
#pragma unroll
                            for (int ks = 0; ks < 4; ++ks) z = MFMA32(kf[ks], qf[g][ks], z);
                            const bool diag = (kb == q0[g]);
                            f32x16 a;
                            float tot = 1.f;
#pragma unroll
                            for (int i = 15; i >= 0; --i) {
                                const float w = __builtin_amdgcn_exp2f(fmaxf(z[i], -60.f) * -LOG2E);
                                float be = __builtin_amdgcn_rcpf(1.f + w);
                                float om = w * be;
                                if (diag) { const bool valid = (16 * h + i < r); be = valid ? be : 0.f; om = valid ? om : 1.f; }
                                a[i] = be * tot;
                                tot *= om;
                            }
                            float tlo, thi; xhalf(tot, tlo, thi);
                            const float bs = carry[g] * (h == 0 ? thi : 1.f);
                            carry[g] *= tlo * thi;
#pragma unroll
                            for (int i = 0; i < 16; ++i) a[i] *= bs;
                            bf16x8 pf[2];
#pragma unroll
                            for (int s2 = 0; s2 < 2; ++s2) {
                                u32x4 w; w.x = pk2(a[8 * s2 + 0], a[8 * s2 + 1]); w.y = pk2(a[8 * s2 + 2], a[8 * s2 + 3]); w.z = pk2(a[8 * s2 + 4], a[8 * s2 + 5]); w.w = pk2(a[8 * s2 + 6], a[8 * s2 + 7]);
                                pf[s2] = __builtin_bit_cast(bf16x8, w);
                            }
#pragma unroll
                            for (int s2 = 0; s2 < 2; ++s2) { o0[g] = MFMA32(vf[s2], pf[s2], o0[g]); o1[g] = MFMA32(vf[2 + s2], pf[s2], o1[g]); }
                            if (__all(carry[g] < SB_PTHR)) done[g] = true;
                        }
                    }
                }
            }
            if (kt == 0) { done[0] = true; done[1] = true; }
        }
        cur = cur == SB_NB - 1 ? 0 : cur + 1;
    }
    asm volatile("s_waitcnt vmcnt(0)" ::: "memory");
#undef SB_WAITV
#undef SB_STAGE
#pragma unroll
    for (int g = 0; g < 2; ++g) {
        bf16_t* mix = (bf16_t*)(p.ws + OFF_MIX) + (tok0 + q0[g] + r) * 1024 + hd * 64 + 4 * h;
        float ss = 0.f;
#pragma unroll
        for (int gg = 0; gg < 4; ++gg) {
            { const float a0 = o0[g][4 * gg], a1 = o0[g][4 * gg + 1], a2 = o0[g][4 * gg + 2], a3 = o0[g][4 * gg + 3];
              ss += (a0 * a0 + a1 * a1) + (a2 * a2 + a3 * a3); u32x2 w; w.x = pk2(a0, a1); w.y = pk2(a2, a3); *(u32x2*)(mix + 8 * gg) = w; }
            { const float a0 = o1[g][4 * gg], a1 = o1[g][4 * gg + 1], a2 = o1[g][4 * gg + 2], a3 = o1[g][4 * gg + 3];
              ss += (a0 * a0 + a1 * a1) + (a2 * a2 + a3 * a3); u32x2 w; w.x = pk2(a0, a1); w.y = pk2(a2, a3); *(u32x2*)(mix + 32 + 8 * gg) = w; }
        }
        ss = xhalf_sum(ss);
        if (h == 0) ((float*)(p.ws + OFF_HSS))[(tok0 + q0[g] + r) * 16 + hd] = ss;
    }
}

DI void phase_attention(const Params& p, LAS unsigned char* lds, int tid, int which = 3) {
    const int blk = blockIdx.x, G = gridDim.x;
#ifndef NO_MLA
    if (which & 1) for (int it = blk; it < 512; it += G) {
        const int xcd = it & 7, local = (it >> 3) & 63;
        const int bh = xcd * 8 + (local >> 3), pr = local & 7;
        mla_block(p, lds, bh >> 2, bh & 3, pr, tid);
        mla_block(p, lds, bh >> 2, bh & 3, 15 - pr, tid);
    }
#endif
#ifndef NO_SB
    if (which & 2) for (int it = blk; it < 1024; it += G) {
        const int xcd = it & 7, local = (it >> 3) & 127;
        sb_block2(p, lds, xcd * 16 + (local >> 3), local & 7, tid);
    }
#endif
}

DI void phase_final(const Params& p, int tid) {
    const int wid = tid >> 6, lane = tid & 63;
    const float* pf = (const float*)(p.ws + OFF_PF);
    const bf16_t* h2b = (const bf16_t*)(p.ws + OFF_MIX);
    f32x4 ga[2], gb[2];
#pragma unroll
    for (int j = 0; j < 2; ++j) { ga[j] = *(const f32x4*)(p.g_final + j * 512 + lane * 8); gb[j] = *(const f32x4*)(p.g_final + j * 512 + lane * 8 + 4); }
    for (int row = blockIdx.x * 8 + wid; row < T_; row += gridDim.x * 8) {
        const f32x4* pp = (const f32x4*)(pf + (size_t)row * 16);
        u32x4 w[2];
#pragma unroll
        for (int j = 0; j < 2; ++j) w[j] = *(const u32x4*)(h2b + (size_t)row * 1024 + j * 512 + lane * 8);
        const float rs = rsqrtf(((sum4(pp[0]) + sum4(pp[1])) + (sum4(pp[2]) + sum4(pp[3]))) * (1.f / 1024.f) + EPS_);
        float* orow = p.out + (size_t)row * 1024 + lane * 8;
#pragma unroll
        for (int j = 0; j < 2; ++j) { f32x4 a, b; unpack8(w[j], a, b); *(f32x4*)(orow + j * 512) = a * rs * ga[j]; *(f32x4*)(orow + j * 512 + 4) = b * rs * gb[j]; }
    }
}

#define XB_TMO      128
#define XB_XCNT(j)  (256  + 64 * (j))
#define XB_XSUB(j)  (1280 + 64 * (j))
#define XB_XGEN(j)  (2304 + 64 * (j))
#define XB_TOP      3328
#define XB_TOPGEN   3392
#define XCD_BAR_WORDS 3456
#define XB_SPIN_CAP (1u << 18)
DI unsigned xb_ld(unsigned* p)              { return __hip_atomic_load(p, __ATOMIC_RELAXED, __HIP_MEMORY_SCOPE_AGENT); }
DI unsigned xb_add(unsigned* p, unsigned v) { return __hip_atomic_fetch_add(p, v, __ATOMIC_RELAXED, __HIP_MEMORY_SCOPE_AGENT); }
DI unsigned xb_xcc_id() { return (unsigned)__builtin_amdgcn_s_getreg((3 << 11) | 20) & 0xFu; }
#define XB_SPIN(cond, bar) do { unsigned _sp = 0; while (cond) { __builtin_amdgcn_s_sleep(1); \
    if ((++_sp & 255u) == 0u) { if (xb_ld(&(bar)[XB_TMO])) break; if (_sp > XB_SPIN_CAP) { atomicAdd(&(bar)[XB_TMO], 1u); break; } } } } while (0)
struct XcdBarrier { unsigned* bar; unsigned x; volatile LAS unsigned* st; };
DI XcdBarrier xcd_barrier_post(unsigned* bar, volatile LAS unsigned* st) {
    XcdBarrier b; b.bar = bar; b.x = xb_xcc_id(); b.st = st;
    if (threadIdx.x == 0) (void)xb_add(&bar[XB_XCNT(b.x)], 1u);
    return b;
}
DI void xcd_barrier_complete(unsigned* bar, unsigned x, unsigned& nloc, unsigned& nx) {
    const unsigned G = gridDim.x * gridDim.y * gridDim.z;
    unsigned sum, cnt, mine, sp = 0u;
    for (;;) {
        sum = 0u; cnt = 0u; mine = 0u;
#pragma unroll
        for (unsigned j = 0; j < 16; ++j) { const unsigned c = xb_ld(&bar[XB_XCNT(j)]); sum += c; cnt += (c > 0u) ? 1u : 0u; mine = (j == x) ? c : mine; }
        if (sum == G) break;
        __builtin_amdgcn_s_sleep(1);
        if ((++sp & 255u) == 0u) { if (xb_ld(&bar[XB_TMO])) break; if (sp > XB_SPIN_CAP) { atomicAdd(&bar[XB_TMO], 1u); break; } }
    }
    nloc = mine > 0u ? mine : 1u; nx = cnt > 0u ? cnt : 1u;
}
DI void xcd_barrier(const XcdBarrier& b) {
    asm volatile("s_waitcnt vmcnt(0)" ::: "memory");
    __syncthreads();
    if (threadIdx.x == 0) {
        unsigned* bar = b.bar;
        __builtin_amdgcn_s_waitcnt(0);
        unsigned nloc = b.st[0], nx = b.st[1];
        if (nloc == 0u) { xcd_barrier_complete(bar, b.x, nloc, nx); b.st[0] = nloc; b.st[1] = nx; }
        const unsigned old = xb_add(&bar[XB_XSUB(b.x)], 1u);
        const unsigned gen = old / nloc;
        if (old + 1u == (gen + 1u) * nloc) {
            __builtin_amdgcn_fence(__ATOMIC_RELEASE, "agent");
            asm volatile("s_waitcnt vmcnt(0)" ::: "memory");
            const unsigned og = xb_add(&bar[XB_TOP], 1u);
            const unsigned tg = og / nx;
            if (og + 1u == (tg + 1u) * nx) xb_add(&bar[XB_TOPGEN], 1u);
            else XB_SPIN(xb_ld(&bar[XB_TOPGEN]) == tg, bar);
            __builtin_amdgcn_fence(__ATOMIC_ACQUIRE, "agent");
            xb_add(&bar[XB_XGEN(b.x)], 1u);
            asm volatile("s_waitcnt vmcnt(0)" ::: "memory");
        } else {
            XB_SPIN(xb_ld(&bar[XB_XGEN(b.x)]) == gen, bar);
            __builtin_amdgcn_fence(__ATOMIC_ACQUIRE, "agent");
            asm volatile("s_waitcnt vmcnt(0)" ::: "memory");
        }
    }
    __syncthreads();
}

#ifndef PH_MASK
#define PH_MASK 255
#endif
#ifndef DUP_MASK
#define DUP_MASK 0
#endif
#ifndef DUP_WHICH
#define DUP_WHICH 3
#endif
constexpr int LDS_XB = g8::STAGE_BYTES + 8192;
constexpr int LDS_BYTES = g8::STAGE_BYTES + 8192 + 64;

__global__ void __launch_bounds__(512, 2) hymba_fwd(Params p) {
    extern __shared__ __attribute__((aligned(16))) unsigned char lds_raw[];
    LAS unsigned char* lds = (LAS unsigned char*)lds_raw;
    cg::grid_group grid = cg::this_grid();
    const int wid_s = __builtin_amdgcn_readfirstlane((int)threadIdx.x >> 6);
    unsigned char* ws = p.ws;

    volatile LAS unsigned* xst = (volatile LAS unsigned*)(lds + LDS_XB);
    if (threadIdx.x == 0) { xst[0] = 0u; xst[1] = 0u; }
    __syncthreads();
    const XcdBarrier xb = xcd_barrier_post((unsigned*)(ws + OFF_BAR), xst);
    if (p.out == nullptr) grid.sync();
    if (PH_MASK & 1) phase0(p, lds, fresh_tid(wid_s));
    xcd_barrier(xb);
    if (DUP_MASK & 1) { phase0(p, lds, fresh_tid(wid_s)); xcd_barrier(xb); }
    if (PH_MASK & 2) {
        LAS float* tab = (LAS float*)(lds + g8::STAGE_BYTES);
        fill_row_tables(tab, wid_s, RowRsx{(const float*)(ws + OFF_RSX)});
        EpiProj E{tab, (const float*)(ws + OFF_CS), (bf16_t*)(ws + OFF_PROJ), (bf16_t*)(ws + OFF_VST), (float*)(ws + OFF_PQ), (float*)(ws + OFF_PKV)};
        g8::gemm_phase<1, 1>(lds, wid_s, (const bf16_t*)(ws + OFF_XB), 1024, (const bf16_t*)(ws + OFF_WIN), 1024, T_, 2048, 1024, E);
    }
    xcd_barrier(xb);
    if (PH_MASK & 4) {
        LAS float* tab = (LAS float*)(lds + g8::STAGE_BYTES);
        fill_row_tables(tab, wid_s, RowQKV{(const float*)(ws + OFF_PQ), (const float*)(ws + OFF_PKV)});
        EpiQKV E{tab, (const float*)(ws + OFF_CS), (bf16_t*)(ws + OFF_QN), (bf16_t*)(ws + OFF_QR), (bf16_t*)(ws + OFF_KN), (bf16_t*)(ws + OFF_VMT)};
        g8::gemm_phase<1>(lds, wid_s, (const bf16_t*)(ws + OFF_PROJ) + 1536, 2048, (const bf16_t*)(ws + OFF_WQB), 256, T_, 1792, 256, E);
    }
    xcd_barrier(xb);
    if (PH_MASK & 8) phase_attention(p, lds, fresh_tid(wid_s));
    xcd_barrier(xb);
    if (DUP_MASK & 8) { phase_attention(p, lds, fresh_tid(wid_s), DUP_WHICH); xcd_barrier(xb); }
    if (PH_MASK & 16) {
        LAS float* tab = (LAS float*)(lds + g8::STAGE_BYTES);
        fill_row_tables(tab, wid_s, RowOut{(const float*)(ws + OFF_HSS)});
        EpiOut E{tab, (const bf16_t*)(ws + OFF_XB), (bf16_t*)(ws + OFF_H1B), (float*)(ws + OFF_PH)};
        g8::gemm_phase<2>(lds, wid_s, (const bf16_t*)(ws + OFF_MIX), 1024, (const bf16_t*)(ws + OFF_WO), 1024, T_, 1024, 512, E);
    }
    xcd_barrier(xb);
    for (int rep = 0; rep < ((DUP_MASK & 32) ? 2 : 1); ++rep) {
    if (rep) xcd_barrier(xb);
    if (PH_MASK & 32) {
        LAS float* rst = (LAS float*)(lds + g8::STAGE_BYTES);
        fill_row_tables(rst, wid_s, RowUp{(const float*)(ws + OFF_PH)});
        EpiUp E{rst, (bf16_t*)(ws + OFF_HID)};
        g8::gemm_phase<1>(lds, wid_s, (const bf16_t*)(ws + OFF_H1B), 1024, (const bf16_t*)(ws + OFF_WUP), 1024, T_, 4096, 1024, E);
    }
    }
    xcd_barrier(xb);
    if (PH_MASK & 64) {
        EpiDown E{(const bf16_t*)(ws + OFF_H1B), (bf16_t*)(ws + OFF_MIX), (float*)(ws + OFF_PF)};
        g8::gemm_phase<1>(lds, wid_s, (const bf16_t*)(ws + OFF_HID), 4096, (const bf16_t*)(ws + OFF_WDN), 4096, T_, 1024, 4096, E);
    }
    xcd_barrier(xb);
    if (PH_MASK & 128) phase_final(p, fresh_tid(wid_s));
}

extern "C" void kernel_launch(void* const* d_in, const int* in_sizes, int n_in, void* d_out, int out_size, void* d_ws, size_t ws_size, hipStream_t stream) {
    static int grid_blocks = 0;
    if (grid_blocks == 0) {
        if (n_in != 15 || in_sizes[0] != T_ * 1024 || out_size != T_ * 1024 || ws_size < WS_END) {
            fprintf(stderr, "kernel_launch: unexpected shapes (n_in %d, in0 %d, out %d, ws %zu < %zu)\n", n_in, n_in > 0 ? in_sizes[0] : -1, out_size, ws_size, (size_t)WS_END);
            grid_blocks = -1; return;
        }
        int dev = 0, cus = 0, per_cu = 0;
        hipGetDevice(&dev);
        hipDeviceGetAttribute(&cus, hipDeviceAttributeMultiprocessorCount, dev);
        if (hipFuncSetAttribute((const void*)hymba_fwd, hipFuncAttributeMaxDynamicSharedMemorySize, LDS_BYTES) != hipSuccess) fprintf(stderr, "kernel_launch: hipFuncSetAttribute failed\n");
        if (hipOccupancyMaxActiveBlocksPerMultiprocessor(&per_cu, (const void*)hymba_fwd, 512, LDS_BYTES) != hipSuccess || per_cu < 1) { fprintf(stderr, "kernel_launch: occupancy query gave %d\n", per_cu); per_cu = 1; }
        (void)hipGetLastError();
        grid_blocks = cus;
        if (grid_blocks != 256) fprintf(stderr, "kernel_launch: note: %d CUs (work maps assume 256)\n", grid_blocks);
    }
    if (grid_blocks < 0) return;
    Params p{};
    p.x = (const float*)d_in[0]; p.pos = (const int*)d_in[1]; p.g_attn = (const float*)d_in[2]; p.w_in = (const float*)d_in[3];
    p.g_qa = (const float*)d_in[4]; p.w_qb = (const float*)d_in[5]; p.g_kva = (const float*)d_in[6]; p.w_kvb = (const float*)d_in[7];
    p.g_sbo = (const float*)d_in[8]; p.g_mlao = (const float*)d_in[9]; p.w_o = (const float*)d_in[10]; p.g_mlp = (const float*)d_in[11];
    p.w_up = (const float*)d_in[12]; p.w_down = (const float*)d_in[13]; p.g_final = (const float*)d_in[14];
    p.out = (float*)d_out; p.ws = (unsigned char*)d_ws;
    (void)hipMemsetAsync((unsigned char*)d_ws + OFF_BAR, 0, XCD_BAR_WORDS * 4, stream);
    void* args[] = {&p};
    hipError_t e = hipLaunchCooperativeKernel((const void*)hymba_fwd, dim3(grid_blocks), dim3(512), args, LDS_BYTES, stream);
    if (e != hipSuccess) fprintf(stderr, "kernel_launch: cooperative launch failed: %s (grid %d)\n", hipGetErrorString(e), grid_blocks);
}
```

```cpp
#include <hip/hip_runtime.h>
#include <hip/hip_cooperative_groups.h>
#include <cstdio>
namespace cg = cooperative_groups;

#define LAS __attribute__((address_space(3)))
#define DI __device__ __forceinline__
typedef unsigned short bf16_t;
typedef short bf16x8 __attribute__((ext_vector_type(8)));
typedef float f32x2 __attribute__((ext_vector_type(2)));
typedef float f32x4 __attribute__((ext_vector_type(4)));
typedef float f32x16 __attribute__((ext_vector_type(16)));
typedef unsigned u32x4 __attribute__((ext_vector_type(4)));
typedef unsigned u32x2 __attribute__((ext_vector_type(2)));
typedef __bf16 bf2_t __attribute__((ext_vector_type(2)));

constexpr int T_ = 65536, S_ = 4096;
constexpr float EPS_ = 1e-6f;
constexpr float LOG2E = 1.4426950408889634f, LN2 = 0.6931471805599453f;
constexpr float MLA_QSCALE = 0.07216878364870322f * 1.4426950408889634f;
constexpr float SB_PTHR = 1e-37f;

constexpr size_t SZ_T = (size_t)T_;
constexpr size_t OFF_PROJ = 0;
constexpr size_t OFF_VST  = OFF_PROJ + SZ_T * 2048 * 2;
constexpr size_t OFF_QN   = OFF_VST + SZ_T * 512 * 2;
constexpr size_t OFF_QR   = OFF_QN + SZ_T * 512 * 2;
constexpr size_t OFF_KN   = OFF_QR + SZ_T * 256 * 2;
constexpr size_t OFF_VMT  = OFF_KN + SZ_T * 512 * 2;
constexpr size_t OFF_REGA_END = OFF_VMT + SZ_T * 512 * 2;
constexpr size_t OFF_HID  = 0;
constexpr size_t OFF_XB   = OFF_REGA_END;
constexpr size_t OFF_MIX  = OFF_XB + SZ_T * 1024 * 2;
constexpr size_t OFF_H1B  = OFF_MIX + SZ_T * 1024 * 2;
constexpr size_t OFF_WIN  = OFF_H1B + SZ_T * 1024 * 2;
constexpr size_t OFF_WQB  = OFF_WIN + (size_t)2048 * 1024 * 2;
constexpr size_t OFF_WKVB = OFF_WQB + (size_t)768 * 256 * 2;
constexpr size_t OFF_WO   = OFF_WKVB + (size_t)1024 * 256 * 2;
constexpr size_t OFF_WUP  = OFF_WO + (size_t)1024 * 1024 * 2;
constexpr size_t OFF_WDN  = OFF_WUP + (size_t)4096 * 1024 * 2;
constexpr size_t OFF_CS   = OFF_WDN + (size_t)4096 * 1024 * 2;
constexpr size_t OFF_RSX  = OFF_CS + SZ_T * 32 * 8;
constexpr size_t OFF_PQ   = OFF_RSX + SZ_T * 4;
constexpr size_t OFF_PKV  = OFF_PQ + SZ_T * 16;
constexpr size_t OFF_HSS  = OFF_PKV + SZ_T * 16;
constexpr size_t OFF_PH   = OFF_HSS + SZ_T * 64;
constexpr size_t OFF_PF   = OFF_PH + SZ_T * 64;
constexpr size_t OFF_BAR  = OFF_PF + SZ_T * 64;
constexpr size_t WS_END   = OFF_BAR + 16384;

struct Params {
    const float* x; const int* pos; const float* g_attn; const float* w_in; const float* g_qa; const float* w_qb;
    const float* g_kva; const float* w_kvb; const float* g_sbo; const float* g_mlao; const float* w_o; const float* g_mlp;
    const float* w_up; const float* w_down; const float* g_final;
    float* out; unsigned char* ws;
};

__device__ const float INV_FREQ[32] = {
    1.000000000e+00f, 7.498942018e-01f, 5.623413324e-01f, 4.216965139e-01f, 3.162277639e-01f, 2.371373773e-01f, 1.778279394e-01f, 1.333521456e-01f,
    1.000000015e-01f, 7.498942316e-02f, 5.623413250e-02f, 4.216964915e-02f, 3.162277490e-02f, 2.371373773e-02f, 1.778279431e-02f, 1.333521400e-02f,
    9.999999776e-03f, 7.498942316e-03f, 5.623413250e-03f, 4.216964822e-03f, 3.162277630e-03f, 2.371373819e-03f, 1.778279431e-03f, 1.333521446e-03f,
    1.000000047e-03f, 7.498941850e-04f, 5.623413017e-04f, 4.216965172e-04f, 3.162277571e-04f, 2.371373703e-04f, 1.778279402e-04f, 1.333521504e-04f};

DI unsigned pk2(float lo, float hi) { f32x2 v = {lo, hi}; bf2_t r = __builtin_convertvector(v, bf2_t); return __builtin_bit_cast(unsigned, r); }
DI u32x4 pack8(f32x4 a, f32x4 b) { u32x4 o; o.x = pk2(a.x, a.y); o.y = pk2(a.z, a.w); o.z = pk2(b.x, b.y); o.w = pk2(b.z, b.w); return o; }
DI void unpack8(u32x4 w, f32x4& a, f32x4& b) {
    a.x = __uint_as_float(w.x << 16); a.y = __uint_as_float(w.x & 0xffff0000u); a.z = __uint_as_float(w.y << 16); a.w = __uint_as_float(w.y & 0xffff0000u);
    b.x = __uint_as_float(w.z << 16); b.y = __uint_as_float(w.z & 0xffff0000u); b.z = __uint_as_float(w.w << 16); b.w = __uint_as_float(w.w & 0xffff0000u);
}
DI float sum4(f32x4 v) { return (v.x + v.y) + (v.z + v.w); }
DI float sq4(f32x4 v) { return (v.x * v.x + v.y * v.y) + (v.z * v.z + v.w * v.w); }
DI float wave_sum(float v) {
#pragma unroll
    for (int o = 1; o < 64; o <<= 1) v += __shfl_xor(v, o);
    return v;
}
DI f32x16 zero16() { f32x16 z; for (int i = 0; i < 16; ++i) z[i] = 0.f; return z; }
DI const char* uptr(const char* p) {
    const unsigned long long u = (unsigned long long)p;
    const unsigned lo = __builtin_amdgcn_readfirstlane((unsigned)u), hi = __builtin_amdgcn_readfirstlane((unsigned)(u >> 32));
    return (const char*)(((unsigned long long)hi << 32) | lo);
}
DI int fresh_tid(int wid_s) {
    int l; asm volatile("v_mbcnt_lo_u32_b32 %0, -1, 0\n\tv_mbcnt_hi_u32_b32 %0, -1, %0" : "=v"(l));
    return wid_s * 64 + l;
}
typedef unsigned u32x2p __attribute__((ext_vector_type(2)));
DI void xhalf(float x, float& lo, float& hi) { const u32x2p r = __builtin_amdgcn_permlane32_swap(__float_as_uint(x), __float_as_uint(x), false, false); lo = __uint_as_float(r.x); hi = __uint_as_float(r.y); }
DI float xhalf_max(float x) { float lo, hi; xhalf(x, lo, hi); return fmaxf(lo, hi); }
DI float xhalf_sum(float x) { float lo, hi; xhalf(x, lo, hi); return lo + hi; }
#define MFMA32(a, b, c) __builtin_amdgcn_mfma_f32_32x32x16_bf16((a), (b), (c), 0, 0, 0)

DI void p0_weight_item(const Params& p, LAS float* scr, int mid, int t, int lane) {
    const float* W; int K, N, Kpad; bf16_t* out;
    switch (mid) {
        case 0:  W = p.w_in;   K = 1024; N = 1984; Kpad = 1024; out = (bf16_t*)(p.ws + OFF_WIN); break;
        case 1:  W = p.w_qb;   K = 256;  N = 768;  Kpad = 256;  out = (bf16_t*)(p.ws + OFF_WQB); break;
        case 2:  W = p.w_kvb;  K = 128;  N = 1024; Kpad = 256;  out = (bf16_t*)(p.ws + OFF_WKVB); break;
        case 3:  W = p.w_o;    K = 1024; N = 1024; Kpad = 1024; out = (bf16_t*)(p.ws + OFF_WO); break;
        case 4:  W = p.w_up;   K = 1024; N = 4096; Kpad = 1024; out = (bf16_t*)(p.ws + OFF_WUP); break;
        default: W = p.w_down; K = 4096; N = 1024; Kpad = 4096; out = (bf16_t*)(p.ws + OFF_WDN); break;
    }
    const int nkt = Kpad / 64, k0 = (t % nkt) * 64, n0 = (t / nkt) * 32;
    const int nn = lane & 31, no = n0 + nn;
    int src = no; float sc = 1.f;
    if (mid == 0) {
        if (no < 512) sc = -0.125f * LOG2E;
        else if (no >= 1920) { if (no < 1984) { const int pp = no - 1920; src = 1920 + ((pp >> 2) & 1) * 32 + 4 * (pp >> 3) + (pp & 3); } else src = -1; }
    } else if (mid == 1) {
        sc = MLA_QSCALE;
        if (no < 512) src = (no >> 7) * 192 + (no & 127);
        else { const int q = no - 512, hd = q >> 6, pp = q & 63; src = hd * 192 + 128 + ((pp >> 2) & 1) * 32 + 4 * (pp >> 3) + (pp & 3); }
    }
#pragma unroll 8
    for (int i = 0; i < 32; ++i) {
        const int kk = 2 * i + (lane >> 5), k = k0 + kk;
        float gv = 1.f; bool ok = src >= 0;
        if (mid == 0) gv = p.g_attn[k];
        else if (mid == 1) gv = p.g_qa[k];
        else if (mid == 2) { if (k >= K) ok = false; else gv = p.g_kva[k]; }
        else if (mid == 3) gv = (k < 512) ? p.g_sbo[k] : p.g_mlao[k - 512];
        else if (mid == 4) gv = p.g_mlp[k];
        float val = 0.f;
        if (ok) val = W[(size_t)k * N + src] * gv * sc;
        scr[kk * 33 + nn] = val;
    }
    asm volatile("s_waitcnt lgkmcnt(0)" ::: "memory");
    {
        const int c = lane & 7;
#pragma unroll
        for (int j = 0; j < 4; ++j) {
            const int n = (lane >> 3) + 8 * j; const LAS float* sp = scr + (8 * c) * 33 + n;
            u32x4 o; o.x = pk2(sp[0], sp[33]); o.y = pk2(sp[2 * 33], sp[3 * 33]); o.z = pk2(sp[4 * 33], sp[5 * 33]); o.w = pk2(sp[6 * 33], sp[7 * 33]);
            *(u32x4*)(out + (size_t)(n0 + n) * Kpad + k0 + 8 * c) = o;
        }
    }
    asm volatile("s_waitcnt lgkmcnt(0)" ::: "memory");
}

DI void phase0(const Params& p, LAS unsigned char* lds, int tid) {
    const int G = gridDim.x, blk = blockIdx.x;
    const int wid = tid >> 6, lane = tid & 63;
    {
        LAS float* scr = (LAS float*)(lds + wid * 8448);
        constexpr int C0 = 1024, C1 = C0 + 96, C2 = C1 + 128, C3 = C2 + 512, C4 = C3 + 2048, C5 = C4 + 2048;
        for (int it = blk * 8 + wid; it < C5; it += G * 8) {
            if (it < C0) p0_weight_item(p, scr, 0, it, lane);
            else if (it < C1) p0_weight_item(p, scr, 1, it - C0, lane);
            else if (it < C2) p0_weight_item(p, scr, 2, it - C1, lane);
            else if (it < C3) p0_weight_item(p, scr, 3, it - C2, lane);
            else if (it < C4) p0_weight_item(p, scr, 4, it - C3, lane);
            else p0_weight_item(p, scr, 5, it - C4, lane);
        }
    }
    float* rsx = (float*)(p.ws + OFF_RSX);
    bf16_t* xb = (bf16_t*)(p.ws + OFF_XB);
    for (int row = blk * 8 + wid; row < T_; row += G * 8) {
        const f32x4* xr = (const f32x4*)(p.x + (size_t)row * 1024) + lane;
        f32x4 v[4]; float s = 0.f;
#pragma unroll
        for (int j = 0; j < 4; ++j) { v[j] = xr[64 * j]; s += sq4(v[j]); }
        s = wave_sum(s);
        if (lane == 0) rsx[row] = rsqrtf(s * (1.f / 1024.f) + EPS_);
        u32x2* o = (u32x2*)(xb + (size_t)row * 1024) + lane;
#pragma unroll
        for (int j = 0; j < 4; ++j) { u32x2 w; w.x = pk2(v[j].x, v[j].y); w.y = pk2(v[j].z, v[j].w); o[64 * j] = w; }
    }
    f32x2* cs = (f32x2*)(p.ws + OFF_CS);
    for (int idx = blk * 512 + tid; idx < T_ * 32; idx += G * 512) {
        const int t = idx >> 5, i = idx & 31;
        const float ang = (float)p.pos[t] * INV_FREQ[i];
        const double rev = (double)ang * 0.15915494309189535;
        const float fr = (float)(rev - __builtin_rint(rev));
        f32x2 v; v.x = __builtin_amdgcn_cosf(fr); v.y = __builtin_amdgcn_sinf(fr);
        cs[idx] = v;
    }
}

namespace g8 {
constexpr int BM = 256, BK = 64, HALF = 128, HTB = HALF * BK * 2, STAGE_BYTES = 8 * HTB, NXCD = 8, WGM = 8;
DI int lds_byte(int r, int c) { const int st = (r >> 4) * 2 + (c >> 5), rr = r & 15, cc = c & 31, ob = rr * 64 + cc * 2; return st * 1024 + (ob ^ (((ob >> 9) & 1) << 5)); }
DI void stage_rc(int b, int& R, int& C) { const int st = b / 1024, sb = b % 1024, swz = sb ^ (((sb >> 9) & 1) << 5); R = (st >> 1) * 16 + swz / 64; C = (st & 1) * 32 + (swz % 64) / 2; }
DI int perm32(int rho) { const int n = rho >> 4, i = rho & 15; return 8 * (i >> 2) + 4 * n + (i & 3); }
struct Unit { int pm, pn, kh; };

template <int NKH, int ROT = 0>
DI bool next_unit(int i, int nM, int nN, Unit& u) {
    const int ti = i / NKH; u.kh = i % NKH;
    const int nwg = nM * nN;
    const long L = (long)ti * gridDim.x + blockIdx.x; if (L >= nwg) return false;
    int wgid = (int)L; { const int q = nwg / NXCD, r = nwg % NXCD, xcd = wgid % NXCD, off = wgid / NXCD; wgid = (xcd < r ? xcd * (q + 1) : r * (q + 1) + (xcd - r) * q) + off; }
    const int nig = WGM * nN, gid = wgid / nig, fm = gid * WGM, gsz = (nM - fm) < WGM ? (nM - fm) : WGM;
    u.pm = fm + ((wgid % nig) % gsz); u.pn = (wgid % nig) / gsz;
    if (ROT) u.pn = (u.pn & 4) | ((u.pn + (ti >> 1)) & 3);
    return true;
}

template <int NKH, int ROT = 0, class Epi>
DI void gemm_phase(LAS unsigned char* lds, int wid_s, const bf16_t* A, int lda, const bf16_t* Bt, int ldb, int M, int N, int Kc, const Epi& E) {
    const int tid = fresh_tid(wid_s);
    const int wid = __builtin_amdgcn_readfirstlane(tid >> 6), lane = tid & 63, wr = wid >> 2, wc = wid & 3, fr = lane & 15, fq = lane >> 4;
    const int nt = Kc / BK, nM = M / BM, nN = N / BM;
    unsigned voffA[2], voffB[2];
#pragma unroll
    for (int i = 0; i < 2; ++i) { int R, C; stage_rc(tid * 16 + i * 8192, R, C); const int Rb = (R & ~31) + perm32(R & 31);
        voffA[i] = (unsigned)(R * lda + C) * 2u; voffB[i] = (unsigned)(Rb * ldb + C) * 2u; }
    const size_t kstep = (size_t)(BK * 2);
    const size_t hstepA = (size_t)HALF * lda * 2, hstepB = (size_t)HALF * ldb * 2;
    const size_t tstepA = 2 * hstepA, tstepB = 2 * hstepB, kchunk = (size_t)Kc * 2;
    const unsigned ldsw = (unsigned)wid * 1024u;
    const int aoff = lds_byte(wr * 64 + fr, fq * 8), boff = lds_byte(wc * 32 + fr, fq * 8);
#define G8_SA(b, h) (((b) * 2 + (h)) * HTB)
#define G8_SB(b, h) ((4 + (b) * 2 + (h)) * HTB)
#define G8_STAGE(bufoff, gbase, voff) do { const char* _gb = uptr((const char*)(gbase)); _Pragma("unroll") for (int _i = 0; _i < 2; ++_i) \
        __builtin_amdgcn_global_load_lds((const unsigned*)(_gb + (voff)[_i]), (LAS unsigned*)(lds + (bufoff) + ldsw + _i * 8192), 16, 0, 0); } while (0)
#define G8_LDA(dst, b, h) do { _Pragma("unroll") for (int m = 0; m < 4; ++m) _Pragma("unroll") for (int k = 0; k < 2; ++k) dst[m][k] = *(const LAS bf16x8*)(lds + G8_SA(b, h) + aoff + m * 2048 + k * 1024); } while (0)
#define G8_LDB(dst, b, h) do { _Pragma("unroll") for (int n = 0; n < 2; ++n) _Pragma("unroll") for (int k = 0; k < 2; ++k) dst[n][k] = *(const LAS bf16x8*)(lds + G8_SB(b, h) + boff + n * 2048 + k * 1024); } while (0)
#define G8_MMA(ai, bj, At, Bt_) do { __builtin_amdgcn_s_setprio(1); _Pragma("unroll") for (int m = 0; m < 4; ++m) _Pragma("unroll") for (int n = 0; n < 2; ++n) _Pragma("unroll") for (int k = 0; k < 2; ++k) \
        acc[ai][bj][m][n] = __builtin_amdgcn_mfma_f32_16x16x32_bf16(Bt_[n][k], At[m][k], acc[ai][bj][m][n], 0, 0, 0); __builtin_amdgcn_s_setprio(0); } while (0)
#define G8_WAIT_V(n) asm volatile("s_waitcnt vmcnt(" #n ")" ::: "memory")
#define G8_WAIT_L(n) asm volatile("s_waitcnt lgkmcnt(" #n ")" ::: "memory")
#define G8_BAR __builtin_amdgcn_s_barrier()
#define G8_SCHED __builtin_amdgcn_sched_barrier(0)
    Unit cur, nxt; int ui = 0;
    if (!next_unit<NKH, ROT>(0, nM, nN, cur)) return;
    f32x4 acc[2][2][4][2];
#pragma unroll
    for (int a = 0; a < 2; ++a)
#pragma unroll
        for (int b = 0; b < 2; ++b)
#pragma unroll
            for (int m = 0; m < 4; ++m)
#pragma unroll
                for (int n = 0; n < 2; ++n) acc[a][b][m][n] = (f32x4){0.f, 0.f, 0.f, 0.f};
    bf16x8 At[4][2], B0[2][2], B1[2][2];
    const char* cA = uptr((const char*)A + (size_t)cur.pm * tstepA + (size_t)cur.kh * kchunk + E.a_off(cur.pn));
    const char* cB = uptr((const char*)Bt + (size_t)cur.pn * tstepB + (size_t)cur.kh * kchunk);
    G8_STAGE(G8_SB(0, 0), cB, voffB); G8_STAGE(G8_SA(0, 0), cA, voffA); G8_STAGE(G8_SB(0, 1), cB + hstepB, voffB); G8_STAGE(G8_SA(0, 1), cA + hstepA, voffA);
    if (wr == 1) G8_BAR;
    G8_WAIT_V(4); G8_BAR;
    G8_STAGE(G8_SB(1, 0), cB + kstep, voffB); G8_STAGE(G8_SA(1, 0), cA + kstep, voffA); G8_STAGE(G8_SB(1, 1), cB + hstepB + kstep, voffB);
    G8_WAIT_V(6); G8_BAR;
    for (;;) {
        const bool has_next = next_unit<NKH, ROT>(ui + 1, nM, nN, nxt);
        const char* nA = uptr(has_next ? (const char*)A + (size_t)nxt.pm * tstepA + (size_t)nxt.kh * kchunk + E.a_off(nxt.pn) : cA);
        const char* nB = uptr(has_next ? (const char*)Bt + (size_t)nxt.pn * tstepB + (size_t)nxt.kh * kchunk : cB);
        for (int t = 0; t < nt; t += 2) {
            const bool last = (t == nt - 2);
            const char* a1 = cA + (size_t)(t + 1) * kstep;
            const char* a2 = last ? nA : cA + (size_t)(t + 2) * kstep; const char* b2 = last ? nB : cB + (size_t)(t + 2) * kstep;
            const char* a3 = a2 + kstep; const char* b3 = b2 + kstep;
            G8_LDB(B0, 0, 0); G8_SCHED; G8_LDA(At, 0, 0); G8_STAGE(G8_SA(1, 1), a1 + hstepA, voffA);
            G8_WAIT_L(8); G8_BAR; G8_WAIT_L(0); G8_MMA(0, 0, At, B0); G8_BAR; G8_SCHED;
            G8_LDB(B1, 0, 1); G8_STAGE(G8_SB(0, 0), b2, voffB);
            G8_BAR; G8_WAIT_L(0); G8_MMA(0, 1, At, B1); G8_BAR;
            G8_LDA(At, 0, 1); G8_STAGE(G8_SA(0, 0), a2, voffA);
            G8_BAR; G8_WAIT_L(0); G8_MMA(1, 0, At, B0); G8_BAR; G8_SCHED;
            G8_STAGE(G8_SB(0, 1), b2 + hstepB, voffB);
            G8_WAIT_V(6); G8_BAR; G8_MMA(1, 1, At, B1); G8_BAR;
            G8_LDB(B0, 1, 0); G8_SCHED; G8_LDA(At, 1, 0); G8_STAGE(G8_SA(0, 1), a2 + hstepA, voffA);
            G8_WAIT_L(8); G8_BAR; G8_WAIT_L(0); G8_MMA(0, 0, At, B0); G8_BAR; G8_SCHED;
            G8_LDB(B1, 1, 1); G8_STAGE(G8_SB(1, 0), b3, voffB);
            G8_BAR; G8_WAIT_L(0); G8_MMA(0, 1, At, B1); G8_BAR;
            G8_LDA(At, 1, 1); G8_STAGE(G8_SA(1, 0), a3, voffA);
            G8_BAR; G8_WAIT_L(0); G8_MMA(1, 0, At, B0); G8_BAR; G8_SCHED;
            G8_STAGE(G8_SB(1, 1), b3 + hstepB, voffB);
            G8_WAIT_V(6); G8_BAR; G8_MMA(1, 1, At, B1); G8_BAR;
        }
        { int l2 = lane; asm volatile("" : "+v"(l2)); E(acc, cur, wr, wc, l2 & 15, l2 >> 4); }
        if (!has_next) break;
        if (cur.kh == NKH - 1) {
#pragma unroll
            for (int a = 0; a < 2; ++a)
#pragma unroll
                for (int b = 0; b < 2; ++b)
#pragma unroll
                    for (int m = 0; m < 4; ++m)
#pragma unroll
                        for (int n = 0; n < 2; ++n) acc[a][b][m][n] = (f32x4){0.f, 0.f, 0.f, 0.f};
        }
        cur = nxt; cA = nA; cB = nB; ++ui;
    }
    G8_WAIT_V(0);
    if (wr == 0) G8_BAR;
    G8_BAR;
#undef G8_SA
#undef G8_SB
#undef G8_STAGE
#undef G8_LDA
#undef G8_LDB
#undef G8_MMA
#undef G8_WAIT_V
#undef G8_WAIT_L
#undef G8_BAR
#undef G8_SCHED
}
}
using g8::Unit;
typedef f32x4 AccT[2][2][4][2];

DI void rope8(f32x4& v0, f32x4& v1, const f32x4 ca, const f32x4 cb) {
    f32x4 o1, o2;
    o1.x = v0.x * ca.x - v1.x * ca.y; o2.x = v1.x * ca.x + v0.x * ca.y;
    o1.y = v0.y * ca.z - v1.y * ca.w; o2.y = v1.y * ca.z + v0.y * ca.w;
    o1.z = v0.z * cb.x - v1.z * cb.y; o2.z = v1.z * cb.x + v0.z * cb.y;
    o1.w = v0.w * cb.z - v1.w * cb.w; o2.w = v1.w * cb.z + v0.w * cb.w;
    v0 = o1; v1 = o2;
}
DI void store_tr8(bf16_t* base, f32x4 v0, f32x4 v1) {
    base[0 * S_] = (bf16_t)pk2(v0.x, 0.f); base[1 * S_] = (bf16_t)pk2(v0.y, 0.f); base[2 * S_] = (bf16_t)pk2(v0.z, 0.f); base[3 * S_] = (bf16_t)pk2(v0.w, 0.f);
    base[4 * S_] = (bf16_t)pk2(v1.x, 0.f); base[5 * S_] = (bf16_t)pk2(v1.y, 0.f); base[6 * S_] = (bf16_t)pk2(v1.z, 0.f); base[7 * S_] = (bf16_t)pk2(v1.w, 0.f);
}

template <class F>
DI void fill_row_tables(LAS float* tab, int wid_s, const F& f) {
    const int t2 = fresh_tid(wid_s), bx = blockIdx.x & 7, bj8 = (blockIdx.x >> 3) & 7;
    for (int idx = t2; idx < 1024; idx += 512) {
        const int row = (8 * (4 * bx + (idx >> 8)) + bj8) * 256 + (idx & 255);
        const f32x2 v = f(row); tab[idx] = v.x; tab[1024 + idx] = v.y;
    }
    __syncthreads();
}
struct RowRsx { const float* rsx; DI f32x2 operator()(int row) const { f32x2 v; v.x = rsx[row]; v.y = 0.f; return v; } };
struct RowQKV { const float* pq; const float* pkv; DI f32x2 operator()(int row) const { f32x2 v;
    v.x = rsqrtf(sum4(*(const f32x4*)(pq + (size_t)row * 4)) * (1.f / 256.f) + EPS_); v.y = rsqrtf(sum4(*(const f32x4*)(pkv + (size_t)row * 4)) * (1.f / 128.f) + EPS_); return v; } };
struct RowOut { const float* hss; DI f32x2 operator()(int row) const { const float* hp = hss + (size_t)row * 16; f32x2 v;
    const float rml = rsqrtf(sum4(*(const f32x4*)(hp + 8)) * (1.f / 512.f) + EPS_), rsb = rsqrtf((sum4(*(const f32x4*)hp) + sum4(*(const f32x4*)(hp + 4))) * (1.f / 512.f) + EPS_);
    v.x = rsb / rml; v.y = rml; return v; } };
struct RowUp { const float* ph; DI f32x2 operator()(int row) const { const f32x4* pp = (const f32x4*)(ph + (size_t)row * 16); f32x2 v;
    v.x = rsqrtf(((sum4(pp[0]) + sum4(pp[1])) + (sum4(pp[2]) + sum4(pp[3]))) * (1.f / 1024.f) + EPS_); v.y = 0.f; return v; } };
#define EPI_TAB(tab, which, i) ((tab)[(which) * 1024 + ((u.pm >> 3) & 3) * 256 + wr * 64 + fr + ((i) >> 2) * 128 + ((i) & 3) * 16])
#define EPI_ROW(ai, m) (u.pm * 256 + (ai) * 128 + wr * 64 + (m) * 16 + fr)
struct EpiProj {
    DI int a_off(int) const { return 0; }
    const LAS float* tab; const float* cs; bf16_t* proj; bf16_t* vst; float* pq; float* pkv;
    DI void operator()(AccT& acc, const Unit& u, int wr, int wc, int fr, int fq) const {
        const int pn = u.pn;
        float rsv[8];
#pragma unroll
        for (int i = 0; i < 8; ++i) rsv[i] = EPI_TAB(tab, 0, i);
        const bool do_rope = (pn == 7 && wc < 2);
        f32x4 rca[8], rcb[8];
        if (do_rope) {
#pragma unroll
            for (int i = 0; i < 8; ++i) { const float* cr = cs + (size_t)EPI_ROW(i >> 2, i & 3) * 64 + 2 * (16 * wc + 4 * fq); rca[i] = *(const f32x4*)cr; rcb[i] = *(const f32x4*)(cr + 4); }
        }
#pragma unroll
        for (int ai = 0; ai < 2; ++ai)
#pragma unroll
            for (int m = 0; m < 4; ++m) {
                const int row = EPI_ROW(ai, m);
                const float rs = rsv[ai * 4 + m]; float ss = 0.f;
#pragma unroll
                for (int bj = 0; bj < 2; ++bj) {
                    f32x4 v0 = acc[ai][bj][m][0] * rs, v1 = acc[ai][bj][m][1] * rs;
                    const int cl = bj * 128 + wc * 32 + fq * 8;
                    if (do_rope && bj == 1) rope8(v0, v1, rca[ai * 4 + m], rcb[ai * 4 + m]);
                    if (pn == 6 || (pn == 7 && bj == 0)) ss += sq4(v0) + sq4(v1);
                    if (pn == 4 || pn == 5) {
                        const int dg = (pn - 4) * 256 + cl, hd = dg >> 6, d = dg & 63, b = row >> 12, s = row & 4095;
                        store_tr8(vst + ((size_t)(b * 8 + hd) * 64 + d) * S_ + s, v0, v1);
                    } else {
                        *(u32x4*)(proj + (size_t)row * 2048 + pn * 256 + cl) = pack8(v0, v1);
                    }
                }
                if (pn >= 6) { ss += __shfl_xor(ss, 16); ss = xhalf_sum(ss); if (fq == 0) (pn == 6 ? pq : pkv)[(size_t)row * 4 + wc] = ss; }
            }
    }
};
struct EpiQKV {
    const LAS float* tab; const float* cs; bf16_t* qn; bf16_t* qr; bf16_t* kn; bf16_t* vmt;
    DI int a_off(int pn) const { return pn >= 3 ? 512 : 0; }
    DI void operator()(AccT& acc, const Unit& u, int wr, int wc, int fr, int fq) const {
        const int pn = u.pn;
        const int wh = pn < 3 ? 0 : 1;
        float rsv[8];
#pragma unroll
        for (int i = 0; i < 8; ++i) rsv[i] = EPI_TAB(tab, wh, i);
        f32x4 rca[8], rcb[8];
        if (pn == 2) {
#pragma unroll
            for (int i = 0; i < 8; ++i) { const float* cr = cs + (size_t)EPI_ROW(i >> 2, i & 3) * 64 + 2 * (4 * ((((wc & 1) * 32 + fq * 8)) >> 3)); rca[i] = *(const f32x4*)cr; rcb[i] = *(const f32x4*)(cr + 4); }
        }
#pragma unroll
        for (int ai = 0; ai < 2; ++ai)
#pragma unroll
            for (int m = 0; m < 4; ++m) {
                const int row = EPI_ROW(ai, m);
                const float rs = rsv[ai * 4 + m];
                if (pn < 3) {
#pragma unroll
                    for (int bj = 0; bj < 2; ++bj) {
                        f32x4 v0 = acc[ai][bj][m][0] * rs, v1 = acc[ai][bj][m][1] * rs;
                        const int cl = bj * 128 + wc * 32 + fq * 8;
                        if (pn < 2) *(u32x4*)(qn + (size_t)row * 512 + pn * 256 + cl) = pack8(v0, v1);
                        else { rope8(v0, v1, rca[ai * 4 + m], rcb[ai * 4 + m]); *(u32x4*)(qr + (size_t)row * 256 + cl) = pack8(v0, v1); }
                    }
                } else {
                    const int hd = pn - 3;
                    const int cl = wc * 32 + fq * 8, b = row >> 12, s = row & 4095;
                    { f32x4 v0 = acc[ai][0][m][0] * rs, v1 = acc[ai][0][m][1] * rs; *(u32x4*)(kn + (size_t)row * 512 + hd * 128 + cl) = pack8(v0, v1); }
                    { f32x4 v0 = acc[ai][1][m][0] * rs, v1 = acc[ai][1][m][1] * rs; store_tr8(vmt + ((size_t)(b * 4 + hd) * 128 + cl) * S_ + s, v0, v1); }
                }
            }
    }
};
struct EpiOut {
    DI int a_off(int) const { return 0; }
    const LAS float* tab; const bf16_t* xb; bf16_t* h1b; float* ph;
    DI void operator()(AccT& acc, const Unit& u, int wr, int wc, int fr, int fq) const {
        float rsv[8];
        const int wh = u.kh == 0 ? 0 : 1;
#pragma unroll
        for (int i = 0; i < 8; ++i) rsv[i] = EPI_TAB(tab, wh, i);
        if (u.kh == 0) {
#pragma unroll
            for (int ai = 0; ai < 2; ++ai)
#pragma unroll
                for (int m = 0; m < 4; ++m)
#pragma unroll
                    for (int bj = 0; bj < 2; ++bj) { acc[ai][bj][m][0] *= rsv[ai * 4 + m]; acc[ai][bj][m][1] *= rsv[ai * 4 + m]; }
            return;
        }
        u32x4 res[8][2];
#pragma unroll
        for (int i = 0; i < 8; ++i)
#pragma unroll
            for (int bj = 0; bj < 2; ++bj) res[i][bj] = *(const u32x4*)(xb + (size_t)EPI_ROW(i >> 2, i & 3) * 1024 + u.pn * 256 + bj * 128 + wc * 32 + fq * 8);
#pragma unroll
        for (int ai = 0; ai < 2; ++ai)
#pragma unroll
            for (int m = 0; m < 4; ++m) {
                const int row = EPI_ROW(ai, m);
                const float rml = rsv[ai * 4 + m];
                float ss = 0.f;
#pragma unroll
                for (int bj = 0; bj < 2; ++bj) {
                    const size_t off = (size_t)row * 1024 + u.pn * 256 + bj * 128 + wc * 32 + fq * 8;
                    f32x4 r0, r1; unpack8(res[ai * 4 + m][bj], r0, r1);
                    const f32x4 v0 = acc[ai][bj][m][0] * rml + r0, v1 = acc[ai][bj][m][1] * rml + r1;
                    *(u32x4*)(h1b + off) = pack8(v0, v1);
                    ss += sq4(v0) + sq4(v1);
                }
                ss += __shfl_xor(ss, 16); ss = xhalf_sum(ss);
                if (fq == 0) ph[(size_t)row * 16 + u.pn * 4 + wc] = ss;
            }
    }
};
struct EpiUp {
    DI int a_off(int) const { return 0; }
    const LAS float* rst; bf16_t* hid;
    DI void operator()(AccT& acc, const Unit& u, int wr, int wc, int fr, int fq) const {
        float rsv[8];
#pragma unroll
        for (int i = 0; i < 8; ++i) rsv[i] = EPI_TAB(rst, 0, i);
#pragma unroll
        for (int ai = 0; ai < 2; ++ai)
#pragma unroll
            for (int m = 0; m < 4; ++m) {
                const int row = EPI_ROW(ai, m);
                const float rs = rsv[ai * 4 + m];
#pragma unroll
                for (int bj = 0; bj < 2; ++bj) {
                    f32x4 v0 = acc[ai][bj][m][0] * rs, v1 = acc[ai][bj][m][1] * rs;
#pragma unroll
                    for (int e = 0; e < 4; ++e) { const float a = fmaxf(v0[e], 0.f), b = fmaxf(v1[e], 0.f); v0[e] = a * a; v1[e] = b * b; }
                    *(u32x4*)(hid + (size_t)row * 4096 + u.pn * 256 + bj * 128 + wc * 32 + fq * 8) = pack8(v0, v1);
                }
            }
    }
};
struct EpiDown {
    DI int a_off(int) const { return 0; }
    const bf16_t* h1b; bf16_t* h2b; float* pf;
    DI void operator()(AccT& acc, const Unit& u, int wr, int wc, int fr, int fq) const {
        u32x4 res[8][2];
#pragma unroll
        for (int i = 0; i < 8; ++i)
#pragma unroll
            for (int bj = 0; bj < 2; ++bj) res[i][bj] = *(const u32x4*)(h1b + (size_t)EPI_ROW(i >> 2, i & 3) * 1024 + u.pn * 256 + bj * 128 + wc * 32 + fq * 8);
#pragma unroll
        for (int ai = 0; ai < 2; ++ai)
#pragma unroll
            for (int m = 0; m < 4; ++m) {
                const int row = EPI_ROW(ai, m);
                float ss = 0.f;
#pragma unroll
                for (int bj = 0; bj < 2; ++bj) {
                    const size_t off = (size_t)row * 1024 + u.pn * 256 + bj * 128 + wc * 32 + fq * 8;
                    f32x4 r0, r1; unpack8(res[ai * 4 + m][bj], r0, r1);
                    const f32x4 v0 = acc[ai][bj][m][0] + r0, v1 = acc[ai][bj][m][1] + r1;
                    *(u32x4*)(h2b + off) = pack8(v0, v1);
                    ss += sq4(v0) + sq4(v1);
                }
                ss += __shfl_xor(ss, 16); ss = xhalf_sum(ss);
                if (fq == 0) pf[(size_t)row * 16 + u.pn * 4 + wc] = ss;
            }
    }
};

constexpr int MLA_KROW = 400, MLA_VROW = 144, MLA_KBYTES = 64 * MLA_KROW, MLA_BUF = MLA_KBYTES + 128 * MLA_VROW;

DI void mla_s_softmax(const LAS unsigned char* base, int r, int h, bool is_diag, int lim, const bf16x8 (&qf)[12], f32x16 (&o)[4], float& m_run, float& l_run,
                      bf16x8 (&pf0)[2], bf16x8 (&pf1)[2]) {
    f32x16 s0 = zero16(), s1 = zero16();
    const LAS unsigned char* kp = base + r * MLA_KROW + h * 16;
#pragma unroll
    for (int g = 0; g < 3; ++g) {
        bf16x8 fa[4], fb[4];
#pragma unroll
        for (int j = 0; j < 4; ++j) { fa[j] = *(const LAS bf16x8*)(kp + (4 * g + j) * 32); fb[j] = *(const LAS bf16x8*)(kp + 32 * MLA_KROW + (4 * g + j) * 32); }
        __builtin_amdgcn_sched_barrier(0);
#pragma unroll
        for (int j = 0; j < 4; ++j) { s0 = MFMA32(fa[j], qf[4 * g + j], s0); s1 = MFMA32(fb[j], qf[4 * g + j], s1); }
        __builtin_amdgcn_sched_barrier(0);
    }
    if (is_diag) {
#pragma unroll
        for (int i = 0; i < 16; ++i) { if (16 * h + i > lim) s0[i] = -1e30f; if (32 + 16 * h + i > lim) s1[i] = -1e30f; }
    }
    float mx = fmaxf(s0[0], s1[0]);
#pragma unroll
    for (int i = 1; i < 16; ++i) mx = fmaxf(mx, fmaxf(s0[i], s1[i]));
    mx = xhalf_max(mx);
    const float mnew = fmaxf(m_run, mx);
    if (__builtin_amdgcn_ballot_w64(mnew > m_run + 8.0f) != 0ull) {
        const float alpha = __builtin_amdgcn_exp2f(m_run - mnew);
        l_run *= alpha;
#pragma unroll
        for (int dt = 0; dt < 4; ++dt) o[dt] *= alpha;
        m_run = mnew;
    }
    float ls = 0.f;
#pragma unroll
    for (int i = 0; i < 16; ++i) { s0[i] = __builtin_amdgcn_exp2f(s0[i] - m_run); s1[i] = __builtin_amdgcn_exp2f(s1[i] - m_run); ls += s0[i] + s1[i]; }
    l_run += ls;
#pragma unroll
    for (int s = 0; s < 2; ++s) {
        u32x4 a, c;
        a.x = pk2(s0[8 * s + 0], s0[8 * s + 1]); a.y = pk2(s0[8 * s + 2], s0[8 * s + 3]); a.z = pk2(s0[8 * s + 4], s0[8 * s + 5]); a.w = pk2(s0[8 * s + 6], s0[8 * s + 7]);
        c.x = pk2(s1[8 * s + 0], s1[8 * s + 1]); c.y = pk2(s1[8 * s + 2], s1[8 * s + 3]); c.z = pk2(s1[8 * s + 4], s1[8 * s + 5]); c.w = pk2(s1[8 * s + 6], s1[8 * s + 7]);
        pf0[s] = __builtin_bit_cast(bf16x8, a); pf1[s] = __builtin_bit_cast(bf16x8, c);
    }
}
DI void mla_pv(const LAS unsigned char* base, int r, int h, const bf16x8 (&pf0)[2], const bf16x8 (&pf1)[2], f32x16 (&o)[4]) {
    const LAS unsigned char* vp = base + MLA_KBYTES + r * MLA_VROW + h * 32;
#pragma unroll
    for (int s = 0; s < 2; ++s) {
        bf16x8 va[4], vb[4];
#pragma unroll
        for (int dt = 0; dt < 4; ++dt) { va[dt] = *(const LAS bf16x8*)(vp + dt * 32 * MLA_VROW + s * 16); vb[dt] = *(const LAS bf16x8*)(vp + dt * 32 * MLA_VROW + 64 + s * 16); }
        __builtin_amdgcn_sched_barrier(0);
#pragma unroll
        for (int dt = 0; dt < 4; ++dt) o[dt] = MFMA32(va[dt], pf0[s], o[dt]);
#pragma unroll
        for (int dt = 0; dt < 4; ++dt) o[dt] = MFMA32(vb[dt], pf1[s], o[dt]);
        __builtin_amdgcn_sched_barrier(0);
    }
}

DI void mla_block(const Params& p, LAS unsigned char* lds, int b, int hd, int qb, int tid) {
    asm volatile("" : "+v"(tid));
    const int wu = __builtin_amdgcn_readfirstlane(tid >> 6), lane = tid & 63, r = lane & 31, h = lane >> 5;
    const int q0 = qb * 256 + wu * 32;
    const bf16_t* QN = (const bf16_t*)(p.ws + OFF_QN); const bf16_t* QR = (const bf16_t*)(p.ws + OFF_QR);
    const size_t tok0 = (size_t)b * S_;
    bf16x8 qf[12];
    {
        const size_t qrow = tok0 + q0 + r;
#pragma unroll
        for (int ks = 0; ks < 8; ++ks) qf[ks] = *(const bf16x8*)(QN + qrow * 512 + hd * 128 + ks * 16 + h * 8);
#pragma unroll
        for (int ks = 0; ks < 4; ++ks) qf[8 + ks] = *(const bf16x8*)(QR + qrow * 256 + hd * 64 + ks * 16 + h * 8);
    }
    unsigned goff[6];
#pragma unroll
    for (int j = 0; j < 6; ++j) {
        const int pc = wu + 8 * j; goff[j] = 0;
        if (pc < 25) {
            const int c = pc * 64 + lane, lr = c / 25; int cc = c - lr * 25; if (cc == 24) cc = 0;
            const int k32 = lr & 31, key = (lr & 32) + 16 * ((k32 >> 2) & 1) + (k32 & 3) + 4 * (k32 >> 3);
            const unsigned tok = (unsigned)(b * S_ + key);
            goff[j] = (cc < 16) ? (unsigned)OFF_KN + (tok * 512u + hd * 128 + cc * 8) * 2u : (unsigned)OFF_PROJ + (tok * 2048u + 1920 + (cc - 16) * 8) * 2u;
        } else if (pc < 43) {
            const int c = (pc - 25) * 64 + lane, d = c / 9; int cc = c - d * 9; if (cc == 8) cc = 0;
            goff[j] = (unsigned)OFF_VMT + ((unsigned)((b * 4 + hd) * 128 + d) * (unsigned)S_ + cc * 8) * 2u;
        }
    }
    const char* wsb = uptr((const char*)p.ws);
#define MLA_STAGE(KT, BUF) do { _Pragma("unroll") for (int _j = 0; _j < 6; ++_j) { const int _pc = wu + 8 * _j; if (_pc < 43) { \
        const unsigned _inc = goff[_j] >= (unsigned)OFF_VMT ? 128u : (goff[_j] < (unsigned)OFF_VST ? 262144u : 65536u); \
        __builtin_amdgcn_global_load_lds((const unsigned*)(wsb + (goff[_j] + (unsigned)(KT) * _inc)), (LAS unsigned*)(lds + (BUF) * MLA_BUF + _pc * 1024), 16, 0, 0); } } } while (0)
    f32x16 o[4]; for (int dt = 0; dt < 4; ++dt) o[dt] = zero16();
    float m_run = -1e30f, l_run = 0.f;
    const int ntiles = 4 * qb + 4, wlast = q0 >> 6;
    __syncthreads();
    MLA_STAGE(0, 0);
    const bool late = wu >= 4;
    bf16x8 pf0[2], pf1[2];
    int bcur = 0;
    for (int kt = 0; kt < ntiles; ++kt) {
        asm volatile("s_waitcnt vmcnt(0)" ::: "memory");
        __builtin_amdgcn_s_barrier();
        asm volatile("" ::: "memory");
        const int bprev = bcur == 0 ? 2 : bcur - 1, bnext = bcur == 2 ? 0 : bcur + 1;
        if (kt + 1 < ntiles) MLA_STAGE(kt + 1, bnext);
        if (late && kt >= 1 && kt - 1 <= wlast) mla_pv(lds + bprev * MLA_BUF, r, h, pf0, pf1, o);
        if (kt <= wlast) {
            mla_s_softmax(lds + bcur * MLA_BUF, r, h, kt == wlast, q0 + r - kt * 64, qf, o, m_run, l_run, pf0, pf1);
            if (!late) mla_pv(lds + bcur * MLA_BUF, r, h, pf0, pf1, o);
        }
        bcur = bnext;
    }
    if (late && wlast == ntiles - 1) { const int bprev = bcur == 0 ? 2 : bcur - 1; mla_pv(lds + bprev * MLA_BUF, r, h, pf0, pf1, o); }
#undef MLA_STAGE
    const float lt = xhalf_sum(l_run), inv = 1.f / lt;
    bf16_t* mix = (bf16_t*)(p.ws + OFF_MIX) + (tok0 + q0 + r) * 1024 + 512 + hd * 128 + 4 * h;
    float ss = 0.f;
#pragma unroll
    for (int dt = 0; dt < 4; ++dt)
#pragma unroll
        for (int g = 0; g < 4; ++g) {
            const float a0 = o[dt][4 * g] * inv, a1 = o[dt][4 * g + 1] * inv, a2 = o[dt][4 * g + 2] * inv, a3 = o[dt][4 * g + 3] * inv;
            ss += (a0 * a0 + a1 * a1) + (a2 * a2 + a3 * a3);
            u32x2 w; w.x = pk2(a0, a1); w.y = pk2(a2, a3);
            *(u32x2*)(mix + dt * 32 + 8 * g) = w;
        }
    ss = xhalf_sum(ss);
    if (h == 0) ((float*)(p.ws + OFF_HSS))[(tok0 + q0 + r) * 16 + 8 + hd] = ss;
}

DI void sb_item(const Params& p, int bh, int qb32, int lane) {
    asm volatile("" : "+v"(lane));
    const int r = lane & 31, h = lane >> 5, b = bh >> 3, hd = bh & 7, q0 = qb32 * 32;
    const bf16_t* PROJ = (const bf16_t*)(p.ws + OFF_PROJ);
    const bf16_t* VST = (const bf16_t*)(p.ws + OFF_VST);
    const size_t tok0 = (size_t)b * S_;
    bf16x8 qf[4];
#pragma unroll
    for (int ks = 0; ks < 4; ++ks) qf[ks] = *(const bf16x8*)(PROJ + (tok0 + q0 + r) * 2048 + hd * 64 + ks * 16 + h * 8);
    const int pr = 16 * ((r >> 2) & 1) + (r & 3) + 4 * (r >> 3);
    const bf16_t* kbase = PROJ + (tok0 + pr) * 2048 + 512 + hd * 64 + h * 8;
    const bf16_t* vbase = VST + ((size_t)(b * 8 + hd) * 64 + r) * S_ + 16 * h;
    bf16x8 kc[4], kn[4], vf[4];
#pragma unroll
    for (int ks = 0; ks < 4; ++ks) kc[ks] = *(const bf16x8*)(kbase + (size_t)q0 * 2048 + ks * 16);
    f32x16 o0 = zero16(), o1 = zero16();
    float carry = 1.f;
    for (int kb = q0; kb >= 0; kb -= 32) {
#pragma unroll
        for (int dt = 0; dt < 2; ++dt)
#pragma unroll
            for (int s = 0; s < 2; ++s) vf[dt * 2 + s] = *(const bf16x8*)(vbase + (size_t)dt * 32 * S_ + kb + 8 * s);
        if (kb >= 32) {
#pragma unroll
            for (int ks = 0; ks < 4; ++ks) kn[ks] = *(const bf16x8*)(kbase + (size_t)(kb - 32) * 2048 + ks * 16);
        }
        f32x16 z = zero16();
#pragma unroll
        for (int ks = 0; ks < 4; ++ks) z = MFMA32(kc[ks], qf[ks], z);
        const bool diag = (kb == q0);
        f32x16 a;
        float tot = 1.f;
#pragma unroll
        for (int i = 15; i >= 0; --i) {
            const float w = __builtin_amdgcn_exp2f(fminf(z[i], 86.f));
            float be = __builtin_amdgcn_rcpf(1.f + w);
            float om = w * be;
            if (diag) { const bool valid = (16 * h + i < r); be = valid ? be : 0.f; om = valid ? om : 1.f; }
            a[i] = be * tot;
            tot *= om;
        }
        const float other = __shfl_xor(tot, 32);
        const float base = carry * (h == 0 ? other : 1.f);
        carry *= tot * other;
#pragma unroll
        for (int i = 0; i < 16; ++i) a[i] *= base;
        bf16x8 pf[2];
#pragma unroll
        for (int s = 0; s < 2; ++s) {
            u32x4 w; w.x = pk2(a[8 * s + 0], a[8 * s + 1]); w.y = pk2(a[8 * s + 2], a[8 * s + 3]); w.z = pk2(a[8 * s + 4], a[8 * s + 5]); w.w = pk2(a[8 * s + 6], a[8 * s + 7]);
            pf[s] = __builtin_bit_cast(bf16x8, w);
        }
#pragma unroll
        for (int s = 0; s < 2; ++s) { o0 = MFMA32(vf[s], pf[s], o0); o1 = MFMA32(vf[2 + s], pf[s], o1); }
        if (kb >= 32) {
#pragma unroll
            for (int ks = 0; ks < 4; ++ks) kc[ks] = kn[ks];
        }
        if (__all(carry < SB_PTHR)) break;
    }
    bf16_t* mix = (bf16_t*)(p.ws + OFF_MIX) + (tok0 + q0 + r) * 1024 + hd * 64 + 4 * h;
    float ss = 0.f;
#pragma unroll
    for (int g = 0; g < 4; ++g) {
        { const float a0 = o0[4 * g], a1 = o0[4 * g + 1], a2 = o0[4 * g + 2], a3 = o0[4 * g + 3];
          ss += (a0 * a0 + a1 * a1) + (a2 * a2 + a3 * a3); u32x2 w; w.x = pk2(a0, a1); w.y = pk2(a2, a3); *(u32x2*)(mix + 8 * g) = w; }
        { const float a0 = o1[4 * g], a1 = o1[4 * g + 1], a2 = o1[4 * g + 2], a3 = o1[4 * g + 3];
          ss += (a0 * a0 + a1 * a1) + (a2 * a2 + a3 * a3); u32x2 w; w.x = pk2(a0, a1); w.y = pk2(a2, a3); *(u32x2*)(mix + 32 + 8 * g) = w; }
    }
    ss = xhalf_sum(ss);
    if (h == 0) ((float*)(p.ws + OFF_HSS))[(tok0 + q0 + r) * 16 + hd] = ss;
}

constexpr int SB_ROW = 144, SB_KBYTES = 64 * SB_ROW, SB_BUF = 2 * SB_KBYTES  , SB_NB = 7, SB_FLAGS = SB_NB * SB_BUF;
DI void sb_block(const Params& p, LAS unsigned char* lds, int bh, int qb, int tid) {
    asm volatile("" : "+v"(tid));
    const int wu = __builtin_amdgcn_readfirstlane(tid >> 6), lane = tid & 63, r = lane & 31, h = lane >> 5;
    const int b = bh >> 3, hd = bh & 7, q0 = qb * 256 + wu * 32;
    const bf16_t* PROJ = (const bf16_t*)(p.ws + OFF_PROJ);
    const size_t tok0 = (size_t)b * S_;
    bf16x8 qf[4];
#pragma unroll
    for (int ks = 0; ks < 4; ++ks) qf[ks] = *(const bf16x8*)(PROJ + (tok0 + q0 + r) * 2048 + hd * 64 + ks * 16 + h * 8);
    unsigned goff[3];
#pragma unroll
    for (int j = 0; j < 3; ++j) {
        const int pc = wu + 8 * j; goff[j] = 0;
        if (pc < 18) {
            const int c = (pc < 9 ? pc : pc - 9) * 64 + lane, lr = c / 9; int cc = c - lr * 9; if (cc == 8) cc = 0;
            if (pc < 9) { const int k32 = lr & 31, key = (lr & 32) + 16 * ((k32 >> 2) & 1) + (k32 & 3) + 4 * (k32 >> 3);
                goff[j] = (unsigned)OFF_PROJ + ((unsigned)(b * S_ + key) * 2048u + 512 + hd * 64 + cc * 8) * 2u; }
            else goff[j] = (unsigned)OFF_VST + ((unsigned)((b * 8 + hd) * 64 + lr) * (unsigned)S_ + cc * 8) * 2u;
        }
    }
    const char* wsb = uptr((const char*)p.ws);
#define SB_STAGE(KT, BUF) do { _Pragma("unroll") for (int _j = 0; _j < 3; ++_j) { const int _pc = wu + 8 * _j; if (_pc < 18) { \
        const unsigned _inc = goff[_j] >= (unsigned)OFF_VST ? 128u : 262144u; \
        __builtin_amdgcn_global_load_lds((const unsigned*)(wsb + (goff[_j] + (unsigned)(KT) * _inc)), (LAS unsigned*)(lds + (BUF) * SB_BUF + _pc * 1024), 16, 0, 0); } } } while (0)
    f32x16 o0 = zero16(), o1 = zero16();
    float carry = 1.f;
    bool done = false;
    const int ktop = 4 * qb + 3;
    LAS int* flags = (LAS int*)(lds + SB_FLAGS);
    asm volatile("s_waitcnt vmcnt(0)" ::: "memory");
    __syncthreads();
    const int nstaged = ktop + 1 < SB_NB ? ktop + 1 : SB_NB;
    for (int i = 0; i < nstaged; ++i) SB_STAGE(ktop - i, i);
#define SB_WAITV(n) asm volatile("s_waitcnt vmcnt(" #n ") lgkmcnt(0)" ::: "memory")
    int cur = 0, it = 0;
    for (int kt = ktop; ; --kt, ++it) {
        if (lane == 0) flags[(it & 1) * 8 + wu] = done ? 1 : 0;
        if (it >= SB_NB && kt >= 0) SB_STAGE(kt, cur);
        const int ahead = it < nstaged ? nstaged - 1 - it : 0;
        if (wu < 2) { switch (ahead) { case 0: SB_WAITV(0); break; case 1: SB_WAITV(3); break; case 2: SB_WAITV(6); break; case 3: SB_WAITV(9); break; case 4: SB_WAITV(12); break; case 5: SB_WAITV(15); break; default: SB_WAITV(18); break; } }
        else { switch (ahead) { case 0: SB_WAITV(0); break; case 1: SB_WAITV(2); break; case 2: SB_WAITV(4); break; case 3: SB_WAITV(6); break; case 4: SB_WAITV(8); break; case 5: SB_WAITV(10); break; default: SB_WAITV(12); break; } }
        __builtin_amdgcn_s_barrier();
        asm volatile("" ::: "memory");
        {
            const LAS int* f = flags + (it & 1) * 8;
            const int all = f[0] & f[1] & f[2] & f[3] & f[4] & f[5] & f[6] & f[7];
            if (__builtin_amdgcn_readfirstlane(all)) break;
        }
        if (!done && kt * 64 <= q0) {
            const LAS unsigned char* base = lds + cur * SB_BUF;
#pragma unroll
            for (int sub = 1; sub >= 0; --sub) {
                const int kb = kt * 64 + sub * 32;
                if (kb <= q0 && !done) {
                    const LAS unsigned char* kp = base + (sub * 32 + r) * SB_ROW + h * 16;
                    bf16x8 kf[4], vf[4];
#pragma unroll
                    for (int ks = 0; ks < 4; ++ks) kf[ks] = *(const LAS bf16x8*)(kp + ks * 32);
#pragma unroll
                    for (int dt = 0; dt < 2; ++dt)
#pragma unroll
                        for (int s2 = 0; s2 < 2; ++s2) vf[dt * 2 + s2] = *(const LAS bf16x8*)(base + SB_KBYTES + (dt * 32 + r) * SB_ROW + (sub * 32 + 16 * h + 8 * s2) * 2);
                    f32x16 z = zero16();
#pragma unroll
                    for (int ks = 0; ks < 4; ++ks) z = MFMA32(kf[ks], qf[ks], z);
                    const bool diag = (kb == q0);
                    f32x16 a;
                    float tot = 1.f;
#pragma unroll
                    for (int i = 15; i >= 0; --i) {
                        const float w = __builtin_amdgcn_exp2f(fminf(z[i], 86.f));
                        float be = __builtin_amdgcn_rcpf(1.f + w);
                        float om = w * be;
                        if (diag) { const bool valid = (16 * h + i < r); be = valid ? be : 0.f; om = valid ? om : 1.f; }
                        a[i] = be * tot;
                        tot *= om;
                    }
                    const float other = __shfl_xor(tot, 32);
                    const float bs = carry * (h == 0 ? other : 1.f);
                    carry *= tot * other;
#pragma unroll
                    for (int i = 0; i < 16; ++i) a[i] *= bs;
                    bf16x8 pf[2];
#pragma unroll
                    for (int s2 = 0; s2 < 2; ++s2) {
                        u32x4 w; w.x = pk2(a[8 * s2 + 0], a[8 * s2 + 1]); w.y = pk2(a[8 * s2 + 2], a[8 * s2 + 3]); w.z = pk2(a[8 * s2 + 4], a[8 * s2 + 5]); w.w = pk2(a[8 * s2 + 6], a[8 * s2 + 7]);
                        pf[s2] = __builtin_bit_cast(bf16x8, w);
                    }
#pragma unroll
                    for (int s2 = 0; s2 < 2; ++s2) { o0 = MFMA32(vf[s2], pf[s2], o0); o1 = MFMA32(vf[2 + s2], pf[s2], o1); }
                    if (__all(carry < SB_PTHR)) done = true;
                }
            }
            if (kt == 0) done = true;
        }
        cur = cur == SB_NB - 1 ? 0 : cur + 1;
    }
    asm volatile("s_waitcnt vmcnt(0)" ::: "memory");
#undef SB_WAITV
#undef SB_STAGE
    bf16_t* mix = (bf16_t*)(p.ws + OFF_MIX) + (tok0 + q0 + r) * 1024 + hd * 64 + 4 * h;
    float ss = 0.f;
#pragma unroll
    for (int g = 0; g < 4; ++g) {
        { const float a0 = o0[4 * g], a1 = o0[4 * g + 1], a2 = o0[4 * g + 2], a3 = o0[4 * g + 3];
          ss += (a0 * a0 + a1 * a1) + (a2 * a2 + a3 * a3); u32x2 w; w.x = pk2(a0, a1); w.y = pk2(a2, a3); *(u32x2*)(mix + 8 * g) = w; }
        { const float a0 = o1[4 * g], a1 = o1[4 * g + 1], a2 = o1[4 * g + 2], a3 = o1[4 * g + 3];
          ss += (a0 * a0 + a1 * a1) + (a2 * a2 + a3 * a3); u32x2 w; w.x = pk2(a0, a1); w.y = pk2(a2, a3); *(u32x2*)(mix + 32 + 8 * g) = w; }
    }
    ss = xhalf_sum(ss);
    if (h == 0) ((float*)(p.ws + OFF_HSS))[(tok0 + q0 + r) * 16 + hd] = ss;
}

DI void sb_block2(const Params& p, LAS unsigned char* lds, int bh, int qb2, int tid) {
    asm volatile("" : "+v"(tid));
    const int wu = __builtin_amdgcn_readfirstlane(tid >> 6), lane = tid & 63, r = lane & 31, h = lane >> 5;
    const int b = bh >> 3, hd = bh & 7;
    int q0[2]; q0[0] = qb2 * 512 + wu * 32; q0[1] = q0[0] + 256;
    const bf16_t* PROJ = (const bf16_t*)(p.ws + OFF_PROJ);
    const size_t tok0 = (size_t)b * S_;
    bf16x8 qf[2][4];
#pragma unroll
    for (int g = 0; g < 2; ++g)
#pragma unroll
        for (int ks = 0; ks < 4; ++ks) qf[g][ks] = *(const bf16x8*)(PROJ + (tok0 + q0[g] + r) * 2048 + hd * 64 + ks * 16 + h * 8);
    unsigned goff[3];
#pragma unroll
    for (int j = 0; j < 3; ++j) {
        const int pc = wu + 8 * j; goff[j] = 0;
        if (pc < 18) {
            const int c = (pc < 9 ? pc : pc - 9) * 64 + lane, lr = c / 9; int cc = c - lr * 9; if (cc == 8) cc = 0;
            if (pc < 9) { const int k32 = lr & 31, key = (lr & 32) + 16 * ((k32 >> 2) & 1) + (k32 & 3) + 4 * (k32 >> 3);
                goff[j] = (unsigned)OFF_PROJ + ((unsigned)(b * S_ + key) * 2048u + 512 + hd * 64 + cc * 8) * 2u; }
            else goff[j] = (unsigned)OFF_VST + ((unsigned)((b * 8 + hd) * 64 + lr) * (unsigned)S_ + cc * 8) * 2u;
        }
    }
    const char* wsb = uptr((const char*)p.ws);
#define SB_STAGE(KT, BUF) do { _Pragma("unroll") for (int _j = 0; _j < 3; ++_j) { const int _pc = wu + 8 * _j; if (_pc < 18) { \
        const unsigned _inc = goff[_j] >= (unsigned)OFF_VST ? 128u : 262144u; \
        __builtin_amdgcn_global_load_lds((const unsigned*)(wsb + (goff[_j] + (unsigned)(KT) * _inc)), (LAS unsigned*)(lds + (BUF) * SB_BUF + _pc * 1024), 16, 0, 0); } } } while (0)
    f32x16 o0[2], o1[2]; float carry[2]; bool done[2];
#pragma unroll
    for (int g = 0; g < 2; ++g) { o0[g] = zero16(); o1[g] = zero16(); carry[g] = 1.f; done[g] = false; }
    const int ktop = 8 * qb2 + 7;
    LAS int* flags = (LAS int*)(lds + SB_FLAGS);
    asm volatile("s_waitcnt vmcnt(0)" ::: "memory");
    __syncthreads();
    const int nstaged = ktop + 1 < SB_NB ? ktop + 1 : SB_NB;
    for (int i = 0; i < nstaged; ++i) SB_STAGE(ktop - i, i);
#define SB_WAITV(n) asm volatile("s_waitcnt vmcnt(" #n ") lgkmcnt(0)" ::: "memory")
    int cur = 0, it = 0;
    for (int kt = ktop; ; --kt, ++it) {
        if (lane == 0) flags[(it & 1) * 8 + wu] = (done[0] && done[1]) ? 1 : 0;
        int lowest = ktop - (SB_NB - 1) - (it > 0 ? it - 1 : 0); if (lowest < 0) lowest = 0;
        int ahead = kt - lowest; if (ahead < 0) ahead = 0;
        if (wu < 2) { switch (ahead) { case 0: SB_WAITV(0); break; case 1: SB_WAITV(3); break; case 2: SB_WAITV(6); break; case 3: SB_WAITV(9); break; case 4: SB_WAITV(12); break; case 5: SB_WAITV(15); break; default: SB_WAITV(18); break; } }
        else { switch (ahead) { case 0: SB_WAITV(0); break; case 1: SB_WAITV(2); break; case 2: SB_WAITV(4); break; case 3: SB_WAITV(6); break; case 4: SB_WAITV(8); break; case 5: SB_WAITV(10); break; default: SB_WAITV(12); break; } }
        __builtin_amdgcn_s_barrier();
        asm volatile("" ::: "memory");
        {
            const LAS int* f = flags + (it & 1) * 8;
            const int all = f[0] & f[1] & f[2] & f[3] & f[4] & f[5] & f[6] & f[7];
            if (__builtin_amdgcn_readfirstlane(all)) break;
        }
        if (it >= 1 && kt - (SB_NB - 1) >= 0) SB_STAGE(kt - (SB_NB - 1), cur == 0 ? SB_NB - 1 : cur - 1);
        {
            const LAS unsigned char* base = lds + cur * SB_BUF;
#pragma unroll
            for (int sub = 1; sub >= 0; --sub) {
                const int kb = kt * 64 + sub * 32;
                const LAS unsigned char* kp = base + (sub * 32 + r) * SB_ROW + h * 16;
                const bool act0 = !done[0] && kb <= q0[0], act1 = !done[1] && kb <= q0[1];
                if (act0 || act1) {
                    bf16x8 kf[4], vf[4];
#pragma unroll
                    for (int ks = 0; ks < 4; ++ks) kf[ks] = *(const LAS bf16x8*)(kp + ks * 32);
#pragma unroll
                    for (int dt = 0; dt < 2; ++dt)
#pragma unroll
                        for (int s2 = 0; s2 < 2; ++s2) vf[dt * 2 + s2] = *(const LAS bf16x8*)(base + SB_KBYTES + (dt * 32 + r) * SB_ROW + (sub * 32 + 16 * h + 8 * s2) * 2);
#pragma unroll
                    for (int g = 0; g < 2; ++g) {
                        if (g == 0 ? act0 : act1) {
                            f32x16 z = zero16();
#pragma unroll
                            for (int ks = 0; ks < 4; ++ks) z = MFMA32(kf[ks], qf[g][ks], z);
                            const bool diag = (kb == q0[g]);
                            f32x16 a;
                            float tot = 1.f;
#pragma unroll
                            for (int i = 15; i >= 0; --i) {
                                const float w = __builtin_amdgcn_exp2f(fminf(z[i], 86.f));
                                float be = __builtin_amdgcn_rcpf(1.f + w);
                                float om = w * be;
                                if (diag) { const bool valid = (16 * h + i < r); be = valid ? be : 0.f; om = valid ? om : 1.f; }
                                a[i] = be * tot;
                                tot *= om;
                            }
                            float tlo, thi; xhalf(tot, tlo, thi);
                            const float bs = carry[g] * (h == 0 ? thi : 1.f);
                            carry[g] *= tlo * thi;
#pragma unroll
                            for (int i = 0; i < 16; ++i) a[i] *= bs;
                            bf16x8 pf[2];
#pragma unroll
                            for (int s2 = 0; s2 < 2; ++s2) {
                                u32x4 w; w.x = pk2(a[8 * s2 + 0], a[8 * s2 + 1]); w.y = pk2(a[8 * s2 + 2], a[8 * s2 + 3]); w.z = pk2(a[8 * s2 + 4], a[8 * s2 + 5]); w.w = pk2(a[8 * s2 + 6], a[8 * s2 + 7]);
                                pf[s2] = __builtin_bit_cast(bf16x8, w);
                            }
#pragma unroll
                            for (int s2 = 0; s2 < 2; ++s2) { o0[g] = MFMA32(vf[s2], pf[s2], o0[g]); o1[g] = MFMA32(vf[2 + s2], pf[s2], o1[g]); }
                            if (__all(carry[g] < SB_PTHR)) done[g] = true;
                        }
                    }
                }
            }
            if (kt == 0) { done[0] = true; done[1] = true; }
        }
        cur = cur == SB_NB - 1 ? 0 : cur + 1;
    }
    asm volatile("s_waitcnt vmcnt(0)" ::: "memory");
#undef SB_WAITV
#undef SB_STAGE
#pragma unroll
    for (int g = 0; g < 2; ++g) {
        bf16_t* mix = (bf16_t*)(p.ws + OFF_MIX) + (tok0 + q0[g] + r) * 1024 + hd * 64 + 4 * h;
        float ss = 0.f;
#pragma unroll
        for (int gg = 0; gg < 4; ++gg) {
            { const float a0 = o0[g][4 * gg], a1 = o0[g][4 * gg + 1], a2 = o0[g][4 * gg + 2], a3 = o0[g][4 * gg + 3];
              ss += (a0 * a0 + a1 * a1) + (a2 * a2 + a3 * a3); u32x2 w; w.x = pk2(a0, a1); w.y = pk2(a2, a3); *(u32x2*)(mix + 8 * gg) = w; }
            { const float a0 = o1[g][4 * gg], a1 = o1[g][4 * gg + 1], a2 = o1[g][4 * gg + 2], a3 = o1[g][4 * gg + 3];
              ss += (a0 * a0 + a1 * a1) + (a2 * a2 + a3 * a3); u32x2 w; w.x = pk2(a0, a1); w.y = pk2(a2, a3); *(u32x2*)(mix + 32 + 8 * gg) = w; }
        }
        ss = xhalf_sum(ss);
        if (h == 0) ((float*)(p.ws + OFF_HSS))[(tok0 + q0[g] + r) * 16 + hd] = ss;
    }
}

DI void phase_attention(const Params& p, LAS unsigned char* lds, int tid, int which = 3) {
    const int blk = blockIdx.x, G = gridDim.x;
#ifndef NO_MLA
    if (which & 1) for (int it = blk; it < 512; it += G) {
        const int xcd = it & 7, local = (it >> 3) & 63;
        const int bh = xcd * 8 + (local >> 3), pr = local & 7;
        mla_block(p, lds, bh >> 2, bh & 3, pr, tid);
        mla_block(p, lds, bh >> 2, bh & 3, 15 - pr, tid);
    }
#endif
#ifndef NO_SB
    if (which & 2) for (int it = blk; it < 1024; it += G) {
        const int xcd = it & 7, local = (it >> 3) & 127;
        sb_block2(p, lds, xcd * 16 + (local >> 3), local & 7, tid);
    }
#endif
}

DI void phase_final(const Params& p, int tid) {
    const int wid = tid >> 6, lane = tid & 63;
    const float* pf = (const float*)(p.ws + OFF_PF);
    const bf16_t* h2b = (const bf16_t*)(p.ws + OFF_MIX);
    f32x4 ga[2], gb[2];
#pragma unroll
    for (int j = 0; j < 2; ++j) { ga[j] = *(const f32x4*)(p.g_final + j * 512 + lane * 8); gb[j] = *(const f32x4*)(p.g_final + j * 512 + lane * 8 + 4); }
    for (int row = blockIdx.x * 8 + wid; row < T_; row += gridDim.x * 8) {
        const f32x4* pp = (const f32x4*)(pf + (size_t)row * 16);
        u32x4 w[2];
#pragma unroll
        for (int j = 0; j < 2; ++j) w[j] = *(const u32x4*)(h2b + (size_t)row * 1024 + j * 512 + lane * 8);
        const float rs = rsqrtf(((sum4(pp[0]) + sum4(pp[1])) + (sum4(pp[2]) + sum4(pp[3]))) * (1.f / 1024.f) + EPS_);
        float* orow = p.out + (size_t)row * 1024 + lane * 8;
#pragma unroll
        for (int j = 0; j < 2; ++j) { f32x4 a, b; unpack8(w[j], a, b); *(f32x4*)(orow + j * 512) = a * rs * ga[j]; *(f32x4*)(orow + j * 512 + 4) = b * rs * gb[j]; }
    }
}

#define XB_TMO      128
#define XB_XCNT(j)  (256  + 64 * (j))
#define XB_XSUB(j)  (1280 + 64 * (j))
#define XB_XGEN(j)  (2304 + 64 * (j))
#define XB_TOP      3328
#define XB_TOPGEN   3392
#define XCD_BAR_WORDS 3456
#define XB_SPIN_CAP (1u << 18)
DI unsigned xb_ld(unsigned* p)              { return __hip_atomic_load(p, __ATOMIC_RELAXED, __HIP_MEMORY_SCOPE_AGENT); }
DI unsigned xb_add(unsigned* p, unsigned v) { return __hip_atomic_fetch_add(p, v, __ATOMIC_RELAXED, __HIP_MEMORY_SCOPE_AGENT); }
DI unsigned xb_xcc_id() { return (unsigned)__builtin_amdgcn_s_getreg((3 << 11) | 20) & 0xFu; }
#define XB_SPIN(cond, bar) do { unsigned _sp = 0; while (cond) { __builtin_amdgcn_s_sleep(1); \
    if ((++_sp & 255u) == 0u) { if (xb_ld(&(bar)[XB_TMO])) break; if (_sp > XB_SPIN_CAP) { atomicAdd(&(bar)[XB_TMO], 1u); break; } } } } while (0)
struct XcdBarrier { unsigned* bar; unsigned x; volatile LAS unsigned* st; };
DI XcdBarrier xcd_barrier_post(unsigned* bar, volatile LAS unsigned* st) {
    XcdBarrier b; b.bar = bar; b.x = xb_xcc_id(); b.st = st;
    if (threadIdx.x == 0) (void)xb_add(&bar[XB_XCNT(b.x)], 1u);
    return b;
}
DI void xcd_barrier_complete(unsigned* bar, unsigned x, unsigned& nloc, unsigned& nx) {
    const unsigned G = gridDim.x * gridDim.y * gridDim.z;
    unsigned sum, cnt, mine, sp = 0u;
    for (;;) {
        sum = 0u; cnt = 0u; mine = 0u;
#pragma unroll
        for (unsigned j = 0; j < 16; ++j) { const unsigned c = xb_ld(&bar[XB_XCNT(j)]); sum += c; cnt += (c > 0u) ? 1u : 0u; mine = (j == x) ? c : mine; }
        if (sum == G) break;
        __builtin_amdgcn_s_sleep(1);
        if ((++sp & 255u) == 0u) { if (xb_ld(&bar[XB_TMO])) break; if (sp > XB_SPIN_CAP) { atomicAdd(&bar[XB_TMO], 1u); break; } }
    }
    nloc = mine > 0u ? mine : 1u; nx = cnt > 0u ? cnt : 1u;
}
DI void xcd_barrier(const XcdBarrier& b) {
    asm volatile("s_waitcnt vmcnt(0)" ::: "memory");
    __syncthreads();
    if (threadIdx.x == 0) {
        unsigned* bar = b.bar;
        __builtin_amdgcn_s_waitcnt(0);
        unsigned nloc = b.st[0], nx = b.st[1];
        if (nloc == 0u) { xcd_barrier_complete(bar, b.x, nloc, nx); b.st[0] = nloc; b.st[1] = nx; }
        const unsigned old = xb_add(&bar[XB_XSUB(b.x)], 1u);
        const unsigned gen = old / nloc;
        if (old + 1u == (gen + 1u) * nloc) {
            __builtin_amdgcn_fence(__ATOMIC_RELEASE, "agent");
            asm volatile("s_waitcnt vmcnt(0)" ::: "memory");
            const unsigned og = xb_add(&bar[XB_TOP], 1u);
            const unsigned tg = og / nx;
            if (og + 1u == (tg + 1u) * nx) xb_add(&bar[XB_TOPGEN], 1u);
            else XB_SPIN(xb_ld(&bar[XB_TOPGEN]) == tg, bar);
            __builtin_amdgcn_fence(__ATOMIC_ACQUIRE, "agent");
            xb_add(&bar[XB_XGEN(b.x)], 1u);
            asm volatile("s_waitcnt vmcnt(0)" ::: "memory");
        } else {
            XB_SPIN(xb_ld(&bar[XB_XGEN(b.x)]) == gen, bar);
            __builtin_amdgcn_fence(__ATOMIC_ACQUIRE, "agent");
            asm volatile("s_waitcnt vmcnt(0)" ::: "memory");
        }
    }
    __syncthreads();
}

#ifndef PH_MASK
#define PH_MASK 255
#endif
#ifndef DUP_MASK
#define DUP_MASK 0
#endif
#ifndef DUP_WHICH
#define DUP_WHICH 3
#endif
constexpr int LDS_XB = g8::STAGE_BYTES + 8192;
constexpr int LDS_BYTES = g8::STAGE_BYTES + 8192 + 64;

__global__ void __launch_bounds__(512, 2) hymba_fwd(Params p) {
    extern __shared__ __attribute__((aligned(16))) unsigned char lds_raw[];
    LAS unsigned char* lds = (LAS unsigned char*)lds_raw;
    cg::grid_group grid = cg::this_grid();
    const int wid_s = __builtin_amdgcn_readfirstlane((int)threadIdx.x >> 6);
    unsigned char* ws = p.ws;

    volatile LAS unsigned* xst = (volatile LAS unsigned*)(lds + LDS_XB);
    if (threadIdx.x == 0) { xst[0] = 0u; xst[1] = 0u; }
    __syncthreads();
    const XcdBarrier xb = xcd_barrier_post((unsigned*)(ws + OFF_BAR), xst);
    if (p.out == nullptr) grid.sync();
    if (PH_MASK & 1) phase0(p, lds, fresh_tid(wid_s));
    xcd_barrier(xb);
    if (DUP_MASK & 1) { phase0(p, lds, fresh_tid(wid_s)); xcd_barrier(xb); }
    if (PH_MASK & 2) {
        LAS float* tab = (LAS float*)(lds + g8::STAGE_BYTES);
        fill_row_tables(tab, wid_s, RowRsx{(const float*)(ws + OFF_RSX)});
        EpiProj E{tab, (const float*)(ws + OFF_CS), (bf16_t*)(ws + OFF_PROJ), (bf16_t*)(ws + OFF_VST), (float*)(ws + OFF_PQ), (float*)(ws + OFF_PKV)};
        g8::gemm_phase<1, 1>(lds, wid_s, (const bf16_t*)(ws + OFF_XB), 1024, (const bf16_t*)(ws + OFF_WIN), 1024, T_, 2048, 1024, E);
    }
    xcd_barrier(xb);
    if (PH_MASK & 4) {
        LAS float* tab = (LAS float*)(lds + g8::STAGE_BYTES);
        fill_row_tables(tab, wid_s, RowQKV{(const float*)(ws + OFF_PQ), (const float*)(ws + OFF_PKV)});
        EpiQKV E{tab, (const float*)(ws + OFF_CS), (bf16_t*)(ws + OFF_QN), (bf16_t*)(ws + OFF_QR), (bf16_t*)(ws + OFF_KN), (bf16_t*)(ws + OFF_VMT)};
        g8::gemm_phase<1>(lds, wid_s, (const bf16_t*)(ws + OFF_PROJ) + 1536, 2048, (const bf16_t*)(ws + OFF_WQB), 256, T_, 1792, 256, E);
    }
    xcd_barrier(xb);
    if (PH_MASK & 8) phase_attention(p, lds, fresh_tid(wid_s));
    xcd_barrier(xb);
    if (DUP_MASK & 8) { phase_attention(p, lds, fresh_tid(wid_s), DUP_WHICH); xcd_barrier(xb); }
    if (PH_MASK & 16) {
        LAS float* tab = (LAS float*)(lds + g8::STAGE_BYTES);
        fill_row_tables(tab, wid_s, RowOut{(const float*)(ws + OFF_HSS)});
        EpiOut E{tab, (const bf16_t*)(ws + OFF_XB), (bf16_t*)(ws + OFF_H1B), (float*)(ws + OFF_PH)};
        g8::gemm_phase<2>(lds, wid_s, (const bf16_t*)(ws + OFF_MIX), 1024, (const bf16_t*)(ws + OFF_WO), 1024, T_, 1024, 512, E);
    }
    xcd_barrier(xb);
    for (int rep = 0; rep < ((DUP_MASK & 32) ? 2 : 1); ++rep) {
    if (rep) xcd_barrier(xb);
    if (PH_MASK & 32) {
        LAS float* rst = (LAS float*)(lds + g8::STAGE_BYTES);
        fill_row_tables(rst, wid_s, RowUp{(const float*)(ws + OFF_PH)});
        EpiUp E{rst, (bf16_t*)(ws + OFF_HID)};
        g8::gemm_phase<1>(lds, wid_s, (const bf16_t*)(ws + OFF_H1B), 1024, (const bf16_t*)(ws + OFF_WUP), 1024, T_, 4096, 1024, E);
    }
    }
    xcd_barrier(xb);
    if (PH_MASK & 64) {
        EpiDown E{(const bf16_t*)(ws + OFF_H1B), (bf16_t*)(ws + OFF_MIX), (float*)(ws + OFF_PF)};
        g8::gemm_phase<1>(lds, wid_s, (const bf16_t*)(ws + OFF_HID), 4096, (const bf16_t*)(ws + OFF_WDN), 4096, T_, 1024, 4096, E);
    }
    xcd_barrier(xb);
    if (PH_MASK & 128) phase_final(p, fresh_tid(wid_s));
}

extern "C" void kernel_launch(void* const* d_in, const int* in_sizes, int n_in, void* d_out, int out_size, void* d_ws, size_t ws_size, hipStream_t stream) {
    static int grid_blocks = 0;
    if (grid_blocks == 0) {
        if (n_in != 15 || in_sizes[0] != T_ * 1024 || out_size != T_ * 1024 || ws_size < WS_END) {
            fprintf(stderr, "kernel_launch: unexpected shapes (n_in %d, in0 %d, out %d, ws %zu < %zu)\n", n_in, n_in > 0 ? in_sizes[0] : -1, out_size, ws_size, (size_t)WS_END);
            grid_blocks = -1; return;
        }
        int dev = 0, cus = 0, per_cu = 0;
        hipGetDevice(&dev);
        hipDeviceGetAttribute(&cus, hipDeviceAttributeMultiprocessorCount, dev);
        if (hipFuncSetAttribute((const void*)hymba_fwd, hipFuncAttributeMaxDynamicSharedMemorySize, LDS_BYTES) != hipSuccess) fprintf(stderr, "kernel_launch: hipFuncSetAttribute failed\n");
        if (hipOccupancyMaxActiveBlocksPerMultiprocessor(&per_cu, (const void*)hymba_fwd, 512, LDS_BYTES) != hipSuccess || per_cu < 1) { fprintf(stderr, "kernel_launch: occupancy query gave %d\n", per_cu); per_cu = 1; }
        (void)hipGetLastError();
        grid_blocks = cus;
        if (grid_blocks != 256) fprintf(stderr, "kernel_launch: note: %d CUs (work maps assume 256)\n", grid_blocks);
    }
    if (grid_blocks < 0) return;
    Params p{};
    p.x = (const float*)d_in[0]; p.pos = (const int*)d_in[1]; p.g_attn = (const float*)d_in[2]; p.w_in = (const float*)d_in[3];
    p.g_qa = (const float*)d_in[4]; p.w_qb = (const float*)d_in[5]; p.g_kva = (const float*)d_in[6]; p.w_kvb = (const float*)d_in[7];
    p.g_sbo = (const float*)d_in[8]; p.g_mlao = (const float*)d_in[9]; p.w_o = (const float*)d_in[10]; p.g_mlp = (const float*)d_in[11];
    p.w_up = (const float*)d_in[12]; p.w_down = (const float*)d_in[13]; p.g_final = (const float*)d_in[14];
    p.out = (float*)d_out; p.ws = (unsigned char*)d_ws;
    (void)hipMemsetAsync((unsigned char*)d_ws + OFF_BAR, 0, XCD_BAR_WORDS * 4, stream);
    void* args[] = {&p};
    hipError_t e = hipLaunchCooperativeKernel((const void*)hymba_fwd, dim3(grid_blocks), dim3(512), args, LDS_BYTES, stream);
    if (e != hipSuccess) fprintf(stderr, "kernel_launch: cooperative launch failed: %s (grid %d)\n", hipGetErrorString(e), grid_blocks);
}
```

```cpp
#include <hip/hip_runtime.h>
#include <hip/hip_cooperative_groups.h>
#include <cstdio>
namespace cg = cooperative_groups;

#define LAS __attribute__((address_space(3)))
#define DI __device__ __forceinline__
typedef unsigned short bf16_t;
typedef short bf16x8 __attribute__((ext_vector_type(8)));
typedef float f32x2 __attribute__((ext_vector_type(2)));
typedef float f32x4 __attribute__((ext_vector_type(4)));
typedef float f32x16 __attribute__((ext_vector_type(16)));
typedef unsigned u32x4 __attribute__((ext_vector_type(4)));
typedef unsigned u32x2 __attribute__((ext_vector_type(2)));
typedef __bf16 bf2_t __attribute__((ext_vector_type(2)));

constexpr int T_ = 65536, S_ = 4096;
constexpr float EPS_ = 1e-6f;
constexpr float LOG2E = 1.4426950408889634f, LN2 = 0.6931471805599453f;
constexpr float MLA_QSCALE = 0.07216878364870322f * 1.4426950408889634f;
constexpr float SB_PTHR = 1e-37f;

constexpr size_t SZ_T = (size_t)T_;
constexpr size_t OFF_PROJ = 0;
constexpr size_t OFF_VST  = OFF_PROJ + SZ_T * 2048 * 2;
constexpr size_t OFF_QN   = OFF_VST + SZ_T * 512 * 2;
constexpr size_t OFF_QR   = OFF_QN + SZ_T * 512 * 2;
constexpr size_t OFF_KN   = OFF_QR + SZ_T * 256 * 2;
constexpr size_t OFF_VMT  = OFF_KN + SZ_T * 512 * 2;
constexpr size_t OFF_REGA_END = OFF_VMT + SZ_T * 512 * 2;
constexpr size_t OFF_HID  = 0;
constexpr size_t OFF_XB   = OFF_REGA_END;
constexpr size_t OFF_MIX  = OFF_XB + SZ_T * 1024 * 2;
constexpr size_t OFF_H1B  = OFF_MIX + SZ_T * 1024 * 2;
constexpr size_t OFF_WIN  = OFF_H1B + SZ_T * 1024 * 2;
constexpr size_t OFF_WQB  = OFF_WIN + (size_t)2048 * 1024 * 2;
constexpr size_t OFF_WKVB = OFF_WQB + (size_t)768 * 256 * 2;
constexpr size_t OFF_WO   = OFF_WKVB + (size_t)1024 * 256 * 2;
constexpr size_t OFF_WUP  = OFF_WO + (size_t)1024 * 1024 * 2;
constexpr size_t OFF_WDN  = OFF_WUP + (size_t)4096 * 1024 * 2;
constexpr size_t OFF_CS   = OFF_WDN + (size_t)4096 * 1024 * 2;
constexpr size_t OFF_RSX  = OFF_CS + SZ_T * 32 * 8;
constexpr size_t OFF_PQ   = OFF_RSX + SZ_T * 4;
constexpr size_t OFF_PKV  = OFF_PQ + SZ_T * 16;
constexpr size_t OFF_HSS  = OFF_PKV + SZ_T * 16;
constexpr size_t OFF_PH   = OFF_HSS + SZ_T * 64;
constexpr size_t OFF_PF   = OFF_PH + SZ_T * 64;
constexpr size_t OFF_BAR  = OFF_PF + SZ_T * 64;
constexpr size_t WS_END   = OFF_BAR + 16384;

struct Params {
    const float* x; const int* pos; const float* g_attn; const float* w_in; const float* g_qa; const float* w_qb;
    const float* g_kva; const float* w_kvb; const float* g_sbo; const float* g_mlao; const float* w_o; const float* g_mlp;
    const float* w_up; const float* w_down; const float* g_final;
    float* out; unsigned char* ws;
};

__device__ const float INV_FREQ[32] = {
    1.000000000e+00f, 7.498942018e-01f, 5.623413324e-01f, 4.216965139e-01f, 3.162277639e-01f, 2.371373773e-01f, 1.778279394e-01f, 1.333521456e-01f,
    1.000000015e-01f, 7.498942316e-02f, 5.623413250e-02f, 4.216964915e-02f, 3.162277490e-02f, 2.371373773e-02f, 1.778279431e-02f, 1.333521400e-02f,
    9.999999776e-03f, 7.498942316e-03f, 5.623413250e-03f, 4.216964822e-03f, 3.162277630e-03f, 2.371373819e-03f, 1.778279431e-03f, 1.333521446e-03f,
    1.000000047e-03f, 7.498941850e-04f, 5.623413017e-04f, 4.216965172e-04f, 3.162277571e-04f, 2.371373703e-04f, 1.778279402e-04f, 1.333521504e-04f};

DI unsigned pk2(float lo, float hi) { f32x2 v = {lo, hi}; bf2_t r = __builtin_convertvector(v, bf2_t); return __builtin_bit_cast(unsigned, r); }
DI u32x4 pack8(f32x4 a, f32x4 b) { u32x4 o; o.x = pk2(a.x, a.y); o.y = pk2(a.z, a.w); o.z = pk2(b.x, b.y); o.w = pk2(b.z, b.w); return o; }
DI void unpack8(u32x4 w, f32x4& a, f32x4& b) {
    a.x = __uint_as_float(w.x << 16); a.y = __uint_as_float(w.x & 0xffff0000u); a.z = __uint_as_float(w.y << 16); a.w = __uint_as_float(w.y & 0xffff0000u);
    b.x = __uint_as_float(w.z << 16); b.y = __uint_as_float(w.z & 0xffff0000u); b.z = __uint_as_float(w.w << 16); b.w = __uint_as_float(w.w & 0xffff0000u);
}
DI float sum4(f32x4 v) { return (v.x + v.y) + (v.z + v.w); }
DI float sq4(f32x4 v) { return (v.x * v.x + v.y * v.y) + (v.z * v.z + v.w * v.w); }
DI float wave_sum(float v) {
#pragma unroll
    for (int o = 1; o < 64; o <<= 1) v += __shfl_xor(v, o);
    return v;
}
DI f32x16 zero16() { f32x16 z; for (int i = 0; i < 16; ++i) z[i] = 0.f; return z; }
DI const char* uptr(const char* p) {
    const unsigned long long u = (unsigned long long)p;
    const unsigned lo = __builtin_amdgcn_readfirstlane((unsigned)u), hi = __builtin_amdgcn_readfirstlane((unsigned)(u >> 32));
    return (const char*)(((unsigned long long)hi << 32) | lo);
}
DI int fresh_tid(int wid_s) {
    int l; asm volatile("v_mbcnt_lo_u32_b32 %0, -1, 0\n\tv_mbcnt_hi_u32_b32 %0, -1, %0" : "=v"(l));
    return wid_s * 64 + l;
}
typedef unsigned u32x2p __attribute__((ext_vector_type(2)));
DI void xhalf(float x, float& lo, float& hi) { const u32x2p r = __builtin_amdgcn_permlane32_swap(__float_as_uint(x), __float_as_uint(x), false, false); lo = __uint_as_float(r.x); hi = __uint_as_float(r.y); }
DI float xhalf_max(float x) { float lo, hi; xhalf(x, lo, hi); return fmaxf(lo, hi); }
DI float xhalf_sum(float x) { float lo, hi; xhalf(x, lo, hi); return lo + hi; }
#define MFMA32(a, b, c) __builtin_amdgcn_mfma_f32_32x32x16_bf16((a), (b), (c), 0, 0, 0)

DI void p0_weight_item(const Params& p, LAS float* scr, int mid, int t, int lane) {
    const float* W; int K, N, Kpad; bf16_t* out;
    switch (mid) {
        case 0:  W = p.w_in;   K = 1024; N = 1984; Kpad = 1024; out = (bf16_t*)(p.ws + OFF_WIN); break;
        case 1:  W = p.w_qb;   K = 256;  N = 768;  Kpad = 256;  out = (bf16_t*)(p.ws + OFF_WQB); break;
        case 2:  W = p.w_kvb;  K = 128;  N = 1024; Kpad = 256;  out = (bf16_t*)(p.ws + OFF_WKVB); break;
        case 3:  W = p.w_o;    K = 1024; N = 1024; Kpad = 1024; out = (bf16_t*)(p.ws + OFF_WO); break;
        case 4:  W = p.w_up;   K = 1024; N = 4096; Kpad = 1024; out = (bf16_t*)(p.ws + OFF_WUP); break;
        default: W = p.w_down; K = 4096; N = 1024; Kpad = 4096; out = (bf16_t*)(p.ws + OFF_WDN); break;
    }
    const int nkt = Kpad / 64, k0 = (t % nkt) * 64, n0 = (t / nkt) * 32;
    const int nn = lane & 31, no = n0 + nn;
    int src = no; float sc = 1.f;
    if (mid == 0) {
        if (no < 512) sc = -0.125f * LOG2E;
        else if (no >= 1920) { if (no < 1984) { const int pp = no - 1920; src = 1920 + ((pp >> 2) & 1) * 32 + 4 * (pp >> 3) + (pp & 3); } else src = -1; }
    } else if (mid == 1) {
        sc = MLA_QSCALE;
        if (no < 512) src = (no >> 7) * 192 + (no & 127);
        else { const int q = no - 512, hd = q >> 6, pp = q & 63; src = hd * 192 + 128 + ((pp >> 2) & 1) * 32 + 4 * (pp >> 3) + (pp & 3); }
    }
#pragma unroll 8
    for (int i = 0; i < 32; ++i) {
        const int kk = 2 * i + (lane >> 5), k = k0 + kk;
        float gv = 1.f; bool ok = src >= 0;
        if (mid == 0) gv = p.g_attn[k];
        else if (mid == 1) gv = p.g_qa[k];
        else if (mid == 2) { if (k >= K) ok = false; else gv = p.g_kva[k]; }
        else if (mid == 3) gv = (k < 512) ? p.g_sbo[k] : p.g_mlao[k - 512];
        else if (mid == 4) gv = p.g_mlp[k];
        float val = 0.f;
        if (ok) val = W[(size_t)k * N + src] * gv * sc;
        scr[kk * 33 + nn] = val;
    }
    asm volatile("s_waitcnt lgkmcnt(0)" ::: "memory");
    {
        const int c = lane & 7;
#pragma unroll
        for (int j = 0; j < 4; ++j) {
            const int n = (lane >> 3) + 8 * j; const LAS float* sp = scr + (8 * c) * 33 + n;
            u32x4 o; o.x = pk2(sp[0], sp[33]); o.y = pk2(sp[2 * 33], sp[3 * 33]); o.z = pk2(sp[4 * 33], sp[5 * 33]); o.w = pk2(sp[6 * 33], sp[7 * 33]);
            *(u32x4*)(out + (size_t)(n0 + n) * Kpad + k0 + 8 * c) = o;
        }
    }
    asm volatile("s_waitcnt lgkmcnt(0)" ::: "memory");
}

DI void phase0(const Params& p, LAS unsigned char* lds, int tid) {
    const int G = gridDim.x, blk = blockIdx.x;
    const int wid = tid >> 6, lane = tid & 63;
    {
        LAS float* scr = (LAS float*)(lds + wid * 8448);
        constexpr int C0 = 1024, C1 = C0 + 96, C2 = C1 + 128, C3 = C2 + 512, C4 = C3 + 2048, C5 = C4 + 2048;
        for (int it = blk * 8 + wid; it < C5; it += G * 8) {
            if (it < C0) p0_weight_item(p, scr, 0, it, lane);
            else if (it < C1) p0_weight_item(p, scr, 1, it - C0, lane);
            else if (it < C2) p0_weight_item(p, scr, 2, it - C1, lane);
            else if (it < C3) p0_weight_item(p, scr, 3, it - C2, lane);
            else if (it < C4) p0_weight_item(p, scr, 4, it - C3, lane);
            else p0_weight_item(p, scr, 5, it - C4, lane);
        }
    }
    float* rsx = (float*)(p.ws + OFF_RSX);
    bf16_t* xb = (bf16_t*)(p.ws + OFF_XB);
    for (int row = blk * 8 + wid; row < T_; row += G * 8) {
        const f32x4* xr = (const f32x4*)(p.x + (size_t)row * 1024) + lane;
        f32x4 v[4]; float s = 0.f;
#pragma unroll
        for (int j = 0; j < 4; ++j) { v[j] = xr[64 * j]; s += sq4(v[j]); }
        s = wave_sum(s);
        if (lane == 0) rsx[row] = rsqrtf(s * (1.f / 1024.f) + EPS_);
        u32x2* o = (u32x2*)(xb + (size_t)row * 1024) + lane;
#pragma unroll
        for (int j = 0; j < 4; ++j) { u32x2 w; w.x = pk2(v[j].x, v[j].y); w.y = pk2(v[j].z, v[j].w); o[64 * j] = w; }
    }
    f32x2* cs = (f32x2*)(p.ws + OFF_CS);
    for (int idx = blk * 512 + tid; idx < T_ * 32; idx += G * 512) {
        const int t = idx >> 5, i = idx & 31;
        const float ang = (float)p.pos[t] * INV_FREQ[i];
        const double rev = (double)ang * 0.15915494309189535;
        const float fr = (float)(rev - __builtin_rint(rev));
        f32x2 v; v.x = __builtin_amdgcn_cosf(fr); v.y = __builtin_amdgcn_sinf(fr);
        cs[idx] = v;
    }
}

namespace g8 {
constexpr int BM = 256, BK = 64, HALF = 128, HTB = HALF * BK * 2, STAGE_BYTES = 8 * HTB, NXCD = 8, WGM = 8;
DI int lds_byte(int r, int c) { const int st = (r >> 4) * 2 + (c >> 5), rr = r & 15, cc = c & 31, ob = rr * 64 + cc * 2; return st * 1024 + (ob ^ (((ob >> 9) & 1) << 5)); }
DI void stage_rc(int b, int& R, int& C) { const int st = b / 1024, sb = b % 1024, swz = sb ^ (((sb >> 9) & 1) << 5); R = (st >> 1) * 16 + swz / 64; C = (st & 1) * 32 + (swz % 64) / 2; }
DI int perm32(int rho) { const int n = rho >> 4, i = rho & 15; return 8 * (i >> 2) + 4 * n + (i & 3); }
struct Unit { int pm, pn, kh; };

template <int NKH, int ROT = 0>
DI bool next_unit(int i, int nM, int nN, Unit& u) {
    const int ti = i / NKH; u.kh = i % NKH;
    const int nwg = nM * nN;
    const long L = (long)ti * gridDim.x + blockIdx.x; if (L >= nwg) return false;
    int wgid = (int)L; { const int q = nwg / NXCD, r = nwg % NXCD, xcd = wgid % NXCD, off = wgid / NXCD; wgid = (xcd < r ? xcd * (q + 1) : r * (q + 1) + (xcd - r) * q) + off; }
    const int nig = WGM * nN, gid = wgid / nig, fm = gid * WGM, gsz = (nM - fm) < WGM ? (nM - fm) : WGM;
    u.pm = fm + ((wgid % nig) % gsz); u.pn = (wgid % nig) / gsz;
    if (ROT) u.pn = (u.pn & 4) | ((u.pn + (ti >> 1)) & 3);
    return true;
}

struct NoPre { DI void operator()() const {} };
template <int NKH, int ROT = 0, class Epi, class Pre = NoPre>
DI void gemm_phase(LAS unsigned char* lds, int wid_s, const bf16_t* A, int lda, const bf16_t* Bt, int ldb, int M, int N, int Kc, const Epi& E, const Pre& pre = Pre()) {
    const int tid = fresh_tid(wid_s);
    const int wid = __builtin_amdgcn_readfirstlane(tid >> 6), lane = tid & 63, wr = wid >> 2, wc = wid & 3, fr = lane & 15, fq = lane >> 4;
    const int nt = Kc / BK, nM = M / BM, nN = N / BM;
    unsigned voffA[2], voffB[2];
#pragma unroll
    for (int i = 0; i < 2; ++i) { int R, C; stage_rc(tid * 16 + i * 8192, R, C); const int Rb = (R & ~31) + perm32(R & 31);
        voffA[i] = (unsigned)(R * lda + C) * 2u; voffB[i] = (unsigned)(Rb * ldb + C) * 2u; }
    const size_t kstep = (size_t)(BK * 2);
    const size_t hstepA = (size_t)HALF * lda * 2, hstepB = (size_t)HALF * ldb * 2;
    const size_t tstepA = 2 * hstepA, tstepB = 2 * hstepB, kchunk = (size_t)Kc * 2;
    const unsigned ldsw = (unsigned)wid * 1024u;
    const int aoff = lds_byte(wr * 64 + fr, fq * 8), boff = lds_byte(wc * 32 + fr, fq * 8);
#define G8_SA(b, h) (((b) * 2 + (h)) * HTB)
#define G8_SB(b, h) ((4 + (b) * 2 + (h)) * HTB)
#define G8_STAGE(bufoff, gbase, voff) do { const char* _gb = uptr((const char*)(gbase)); _Pragma("unroll") for (int _i = 0; _i < 2; ++_i) \
        __builtin_amdgcn_global_load_lds((const unsigned*)(_gb + (voff)[_i]), (LAS unsigned*)(lds + (bufoff) + ldsw + _i * 8192), 16, 0, 0); } while (0)
#define G8_LDA(dst, b, h) do { _Pragma("unroll") for (int m = 0; m < 4; ++m) _Pragma("unroll") for (int k = 0; k < 2; ++k) dst[m][k] = *(const LAS bf16x8*)(lds + G8_SA(b, h) + aoff + m * 2048 + k * 1024); } while (0)
#define G8_LDB(dst, b, h) do { _Pragma("unroll") for (int n = 0; n < 2; ++n) _Pragma("unroll") for (int k = 0; k < 2; ++k) dst[n][k] = *(const LAS bf16x8*)(lds + G8_SB(b, h) + boff + n * 2048 + k * 1024); } while (0)
#define G8_MMA(ai, bj, At, Bt_) do { __builtin_amdgcn_s_setprio(1); _Pragma("unroll") for (int m = 0; m < 4; ++m) _Pragma("unroll") for (int n = 0; n < 2; ++n) _Pragma("unroll") for (int k = 0; k < 2; ++k) \
        acc[ai][bj][m][n] = __builtin_amdgcn_mfma_f32_16x16x32_bf16(Bt_[n][k], At[m][k], acc[ai][bj][m][n], 0, 0, 0); __builtin_amdgcn_s_setprio(0); } while (0)
#define G8_WAIT_V(n) asm volatile("s_waitcnt vmcnt(" #n ")" ::: "memory")
#define G8_WAIT_L(n) asm volatile("s_waitcnt lgkmcnt(" #n ")" ::: "memory")
#define G8_BAR __builtin_amdgcn_s_barrier()
#define G8_SCHED __builtin_amdgcn_sched_barrier(0)
    Unit cur, nxt; int ui = 0;
    if (!next_unit<NKH, ROT>(0, nM, nN, cur)) return;
    f32x4 acc[2][2][4][2];
#pragma unroll
    for (int a = 0; a < 2; ++a)
#pragma unroll
        for (int b = 0; b < 2; ++b)
#pragma unroll
            for (int m = 0; m < 4; ++m)
#pragma unroll
                for (int n = 0; n < 2; ++n) acc[a][b][m][n] = (f32x4){0.f, 0.f, 0.f, 0.f};
    bf16x8 At[4][2], B0[2][2], B1[2][2];
    const char* cA = uptr((const char*)A + (size_t)cur.pm * tstepA + (size_t)cur.kh * kchunk + E.a_off(cur.pn));
    const char* cB = uptr((const char*)Bt + (size_t)cur.pn * tstepB + (size_t)cur.kh * kchunk);
    G8_STAGE(G8_SB(0, 0), cB, voffB); G8_STAGE(G8_SA(0, 0), cA, voffA); G8_STAGE(G8_SB(0, 1), cB + hstepB, voffB); G8_STAGE(G8_SA(0, 1), cA + hstepA, voffA);
    pre();
    if (wr == 1) G8_BAR;
    G8_WAIT_V(4); G8_BAR;
    G8_STAGE(G8_SB(1, 0), cB + kstep, voffB); G8_STAGE(G8_SA(1, 0), cA + kstep, voffA); G8_STAGE(G8_SB(1, 1), cB + hstepB + kstep, voffB);
    G8_WAIT_V(6); G8_BAR;
    for (;;) {
        const bool has_next = next_unit<NKH, ROT>(ui + 1, nM, nN, nxt);
        const char* nA = uptr(has_next ? (const char*)A + (size_t)nxt.pm * tstepA + (size_t)nxt.kh * kchunk + E.a_off(nxt.pn) : cA);
        const char* nB = uptr(has_next ? (const char*)Bt + (size_t)nxt.pn * tstepB + (size_t)nxt.kh * kchunk : cB);
        for (int t = 0; t < nt; t += 2) {
            const bool last = (t == nt - 2);
            const char* a1 = cA + (size_t)(t + 1) * kstep;
            const char* a2 = last ? nA : cA + (size_t)(t + 2) * kstep; const char* b2 = last ? nB : cB + (size_t)(t + 2) * kstep;
            const char* a3 = a2 + kstep; const char* b3 = b2 + kstep;
            G8_LDB(B0, 0, 0); G8_SCHED; G8_LDA(At, 0, 0); G8_STAGE(G8_SA(1, 1), a1 + hstepA, voffA);
            G8_WAIT_L(8); G8_BAR; G8_WAIT_L(0); G8_MMA(0, 0, At, B0); G8_BAR; G8_SCHED;
            G8_LDB(B1, 0, 1); G8_STAGE(G8_SB(0, 0), b2, voffB);
            G8_BAR; G8_WAIT_L(0); G8_MMA(0, 1, At, B1); G8_BAR;
            G8_LDA(At, 0, 1); G8_STAGE(G8_SA(0, 0), a2, voffA);
            G8_BAR; G8_WAIT_L(0); G8_MMA(1, 0, At, B0); G8_BAR; G8_SCHED;
            G8_STAGE(G8_SB(0, 1), b2 + hstepB, voffB);
            G8_WAIT_V(6); G8_BAR; G8_MMA(1, 1, At, B1); G8_BAR;
            G8_LDB(B0, 1, 0); G8_SCHED; G8_LDA(At, 1, 0); G8_STAGE(G8_SA(0, 1), a2 + hstepA, voffA);
            G8_WAIT_L(8); G8_BAR; G8_WAIT_L(0); G8_MMA(0, 0, At, B0); G8_BAR; G8_SCHED;
            G8_LDB(B1, 1, 1); G8_STAGE(G8_SB(1, 0), b3, voffB);
            G8_BAR; G8_WAIT_L(0); G8_MMA(0, 1, At, B1); G8_BAR;
            G8_LDA(At, 1, 1); G8_STAGE(G8_SA(1, 0), a3, voffA);
            G8_BAR; G8_WAIT_L(0); G8_MMA(1, 0, At, B0); G8_BAR; G8_SCHED;
            G8_STAGE(G8_SB(1, 1), b3 + hstepB, voffB);
            G8_WAIT_V(6); G8_BAR; G8_MMA(1, 1, At, B1); G8_BAR;
        }
        { int l2 = lane; asm volatile("" : "+v"(l2)); E(acc, cur, wr, wc, l2 & 15, l2 >> 4); }
        if (!has_next) break;
        if (cur.kh == NKH - 1) {
#pragma unroll
            for (int a = 0; a < 2; ++a)
#pragma unroll
                for (int b = 0; b < 2; ++b)
#pragma unroll
                    for (int m = 0; m < 4; ++m)
#pragma unroll
                        for (int n = 0; n < 2; ++n) acc[a][b][m][n] = (f32x4){0.f, 0.f, 0.f, 0.f};
        }
        cur = nxt; cA = nA; cB = nB; ++ui;
    }
    G8_WAIT_V(0);
    if (wr == 0) G8_BAR;
    G8_BAR;
#undef G8_SA
#undef G8_SB
#undef G8_STAGE
#undef G8_LDA
#undef G8_LDB
#undef G8_MMA
#undef G8_WAIT_V
#undef G8_WAIT_L
#undef G8_BAR
#undef G8_SCHED
}
}
using g8::Unit;
typedef f32x4 AccT[2][2][4][2];

DI void rope8(f32x4& v0, f32x4& v1, const f32x4 ca, const f32x4 cb) {
    f32x4 o1, o2;
    o1.x = v0.x * ca.x - v1.x * ca.y; o2.x = v1.x * ca.x + v0.x * ca.y;
    o1.y = v0.y * ca.z - v1.y * ca.w; o2.y = v1.y * ca.z + v0.y * ca.w;
    o1.z = v0.z * cb.x - v1.z * cb.y; o2.z = v1.z * cb.x + v0.z * cb.y;
    o1.w = v0.w * cb.z - v1.w * cb.w; o2.w = v1.w * cb.z + v0.w * cb.w;
    v0 = o1; v1 = o2;
}
DI void store_tr8(bf16_t* base, f32x4 v0, f32x4 v1) {
    base[0 * S_] = (bf16_t)pk2(v0.x, 0.f); base[1 * S_] = (bf16_t)pk2(v0.y, 0.f); base[2 * S_] = (bf16_t)pk2(v0.z, 0.f); base[3 * S_] = (bf16_t)pk2(v0.w, 0.f);
    base[4 * S_] = (bf16_t)pk2(v1.x, 0.f); base[5 * S_] = (bf16_t)pk2(v1.y, 0.f); base[6 * S_] = (bf16_t)pk2(v1.z, 0.f); base[7 * S_] = (bf16_t)pk2(v1.w, 0.f);
}

template <class F>
DI void fill_row_tables(LAS float* tab, int wid_s, const F& f) {
    const int t2 = fresh_tid(wid_s), bx = blockIdx.x & 7, bj8 = (blockIdx.x >> 3) & 7;
    for (int idx = t2; idx < 1024; idx += 512) {
        const int row = (8 * (4 * bx + (idx >> 8)) + bj8) * 256 + (idx & 255);
        const f32x2 v = f(row); tab[idx] = v.x; tab[1024 + idx] = v.y;
    }
    __syncthreads();
}
template <class F> struct TabFill {
    LAS float* tab; int wid_s; F f;
    DI void operator()() const {
        const int t2 = fresh_tid(wid_s), bx = blockIdx.x & 7, bj8 = (blockIdx.x >> 3) & 7;
        for (int idx = t2; idx < 1024; idx += 512) {
            const int row = (8 * (4 * bx + (idx >> 8)) + bj8) * 256 + (idx & 255);
            const f32x2 v = f(row); tab[idx] = v.x; tab[1024 + idx] = v.y;
        }
    }
};
struct RowRsx { const float* rsx; DI f32x2 operator()(int row) const { f32x2 v; v.x = rsx[row]; v.y = 0.f; return v; } };
struct RowQKV { const float* pq; const float* pkv; DI f32x2 operator()(int row) const { f32x2 v;
    v.x = rsqrtf(sum4(*(const f32x4*)(pq + (size_t)row * 4)) * (1.f / 256.f) + EPS_); v.y = rsqrtf(sum4(*(const f32x4*)(pkv + (size_t)row * 4)) * (1.f / 128.f) + EPS_); return v; } };
struct RowOut { const float* hss; DI f32x2 operator()(int row) const { const float* hp = hss + (size_t)row * 16; f32x2 v;
    const float rml = rsqrtf(sum4(*(const f32x4*)(hp + 8)) * (1.f / 512.f) + EPS_), rsb = rsqrtf((sum4(*(const f32x4*)hp) + sum4(*(const f32x4*)(hp + 4))) * (1.f / 512.f) + EPS_);
    v.x = rsb / rml; v.y = rml; return v; } };
struct RowUp { const float* ph; DI f32x2 operator()(int row) const { const f32x4* pp = (const f32x4*)(ph + (size_t)row * 16); f32x2 v;
    v.x = rsqrtf(((sum4(pp[0]) + sum4(pp[1])) + (sum4(pp[2]) + sum4(pp[3]))) * (1.f / 1024.f) + EPS_); v.y = 0.f; return v; } };
#define EPI_TAB(tab, which, i) ((tab)[(which) * 1024 + ((u.pm >> 3) & 3) * 256 + wr * 64 + fr + ((i) >> 2) * 128 + ((i) & 3) * 16])
#define EPI_ROW(ai, m) (u.pm * 256 + (ai) * 128 + wr * 64 + (m) * 16 + fr)
struct EpiProj {
    DI int a_off(int) const { return 0; }
    const LAS float* tab; const float* cs; bf16_t* proj; bf16_t* vst; float* pq; float* pkv;
    DI void operator()(AccT& acc, const Unit& u, int wr, int wc, int fr, int fq) const {
        const int pn = u.pn;
        float rsv[8];
#pragma unroll
        for (int i = 0; i < 8; ++i) rsv[i] = EPI_TAB(tab, 0, i);
        const bool do_rope = (pn == 7 && wc < 2);
        f32x4 rca[8], rcb[8];
        if (do_rope) {
#pragma unroll
            for (int i = 0; i < 8; ++i) { const float* cr = cs + (size_t)EPI_ROW(i >> 2, i & 3) * 64 + 2 * (16 * wc + 4 * fq); rca[i] = *(const f32x4*)cr; rcb[i] = *(const f32x4*)(cr + 4); }
        }
#pragma unroll
        for (int ai = 0; ai < 2; ++ai)
#pragma unroll
            for (int m = 0; m < 4; ++m) {
                const int row = EPI_ROW(ai, m);
                const float rs = rsv[ai * 4 + m]; float ss = 0.f;
#pragma unroll
                for (int bj = 0; bj < 2; ++bj) {
                    f32x4 v0 = acc[ai][bj][m][0] * rs, v1 = acc[ai][bj][m][1] * rs;
                    const int cl = bj * 128 + wc * 32 + fq * 8;
                    if (do_rope && bj == 1) rope8(v0, v1, rca[ai * 4 + m], rcb[ai * 4 + m]);
                    if (pn == 6 || (pn == 7 && bj == 0)) ss += sq4(v0) + sq4(v1);
                    if (pn == 4 || pn == 5) {
                        const int dg = (pn - 4) * 256 + cl, hd = dg >> 6, d = dg & 63, b = row >> 12, s = row & 4095;
                        store_tr8(vst + ((size_t)(b * 8 + hd) * 64 + d) * S_ + s, v0, v1);
                    } else {
                        *(u32x4*)(proj + (size_t)row * 2048 + pn * 256 + cl) = pack8(v0, v1);
                    }
                }
                if (pn >= 6) { ss += __shfl_xor(ss, 16); ss = xhalf_sum(ss); if (fq == 0) (pn == 6 ? pq : pkv)[(size_t)row * 4 + wc] = ss; }
            }
    }
};
struct EpiQKV {
    const LAS float* tab; const float* cs; bf16_t* qn; bf16_t* qr; bf16_t* kn; bf16_t* vmt;
    DI int a_off(int pn) const { return pn >= 3 ? 512 : 0; }
    DI void operator()(AccT& acc, const Unit& u, int wr, int wc, int fr, int fq) const {
        const int pn = u.pn;
        const int wh = pn < 3 ? 0 : 1;
        float rsv[8];
#pragma unroll
        for (int i = 0; i < 8; ++i) rsv[i] = EPI_TAB(tab, wh, i);
        f32x4 rca[8], rcb[8];
        if (pn == 2) {
#pragma unroll
            for (int i = 0; i < 8; ++i) { const float* cr = cs + (size_t)EPI_ROW(i >> 2, i & 3) * 64 + 2 * (4 * ((((wc & 1) * 32 + fq * 8)) >> 3)); rca[i] = *(const f32x4*)cr; rcb[i] = *(const f32x4*)(cr + 4); }
        }
#pragma unroll
        for (int ai = 0; ai < 2; ++ai)
#pragma unroll
            for (int m = 0; m < 4; ++m) {
                const int row = EPI_ROW(ai, m);
                const float rs = rsv[ai * 4 + m];
                if (pn < 3) {
#pragma unroll
                    for (int bj = 0; bj < 2; ++bj) {
                        f32x4 v0 = acc[ai][bj][m][0] * rs, v1 = acc[ai][bj][m][1] * rs;
                        const int cl = bj * 128 + wc * 32 + fq * 8;
                        if (pn < 2) *(u32x4*)(qn + (size_t)row * 512 + pn * 256 + cl) = pack8(v0, v1);
                        else { rope8(v0, v1, rca[ai * 4 + m], rcb[ai * 4 + m]); *(u32x4*)(qr + (size_t)row * 256 + cl) = pack8(v0, v1); }
                    }
                } else {
                    const int hd = pn - 3;
                    const int cl = wc * 32 + fq * 8, b = row >> 12, s = row & 4095;
                    { f32x4 v0 = acc[ai][0][m][0] * rs, v1 = acc[ai][0][m][1] * rs; *(u32x4*)(kn + (size_t)row * 512 + hd * 128 + cl) = pack8(v0, v1); }
                    { f32x4 v0 = acc[ai][1][m][0] * rs, v1 = acc[ai][1][m][1] * rs; store_tr8(vmt + ((size_t)(b * 4 + hd) * 128 + cl) * S_ + s, v0, v1); }
                }
            }
    }
};
struct EpiOut {
    DI int a_off(int) const { return 0; }
    const LAS float* tab; const bf16_t* xb; bf16_t* h1b; float* ph;
    DI void operator()(AccT& acc, const Unit& u, int wr, int wc, int fr, int fq) const {
        float rsv[8];
        const int wh = u.kh == 0 ? 0 : 1;
#pragma unroll
        for (int i = 0; i < 8; ++i) rsv[i] = EPI_TAB(tab, wh, i);
        if (u.kh == 0) {
#pragma unroll
            for (int ai = 0; ai < 2; ++ai)
#pragma unroll
                for (int m = 0; m < 4; ++m)
#pragma unroll
                    for (int bj = 0; bj < 2; ++bj) { acc[ai][bj][m][0] *= rsv[ai * 4 + m]; acc[ai][bj][m][1] *= rsv[ai * 4 + m]; }
            return;
        }
        u32x4 res[8][2];
#pragma unroll
        for (int i = 0; i < 8; ++i)
#pragma unroll
            for (int bj = 0; bj < 2; ++bj) res[i][bj] = *(const u32x4*)(xb + (size_t)EPI_ROW(i >> 2, i & 3) * 1024 + u.pn * 256 + bj * 128 + wc * 32 + fq * 8);
#pragma unroll
        for (int ai = 0; ai < 2; ++ai)
#pragma unroll
            for (int m = 0; m < 4; ++m) {
                const int row = EPI_ROW(ai, m);
                const float rml = rsv[ai * 4 + m];
                float ss = 0.f;
#pragma unroll
                for (int bj = 0; bj < 2; ++bj) {
                    const size_t off = (size_t)row * 1024 + u.pn * 256 + bj * 128 + wc * 32 + fq * 8;
                    f32x4 r0, r1; unpack8(res[ai * 4 + m][bj], r0, r1);
                    const f32x4 v0 = acc[ai][bj][m][0] * rml + r0, v1 = acc[ai][bj][m][1] * rml + r1;
                    *(u32x4*)(h1b + off) = pack8(v0, v1);
                    ss += sq4(v0) + sq4(v1);
                }
                ss += __shfl_xor(ss, 16); ss = xhalf_sum(ss);
                if (fq == 0) ph[(size_t)row * 16 + u.pn * 4 + wc] = ss;
            }
    }
};
struct EpiUp {
    DI int a_off(int) const { return 0; }
    const LAS float* rst; bf16_t* hid;
    DI void operator()(AccT& acc, const Unit& u, int wr, int wc, int fr, int fq) const {
        float rsv[8];
#pragma unroll
        for (int i = 0; i < 8; ++i) rsv[i] = EPI_TAB(rst, 0, i);
#pragma unroll
        for (int ai = 0; ai < 2; ++ai)
#pragma unroll
            for (int m = 0; m < 4; ++m) {
                const int row = EPI_ROW(ai, m);
                const float rs = rsv[ai * 4 + m];
#pragma unroll
                for (int bj = 0; bj < 2; ++bj) {
                    f32x4 v0 = acc[ai][bj][m][0] * rs, v1 = acc[ai][bj][m][1] * rs;
#pragma unroll
                    for (int e = 0; e < 4; ++e) { const float a = fmaxf(v0[e], 0.f), b = fmaxf(v1[e], 0.f); v0[e] = a * a; v1[e] = b * b; }
                    *(u32x4*)(hid + (size_t)row * 4096 + u.pn * 256 + bj * 128 + wc * 32 + fq * 8) = pack8(v0, v1);
                }
            }
    }
};
struct EpiDown {
    DI int a_off(int) const { return 0; }
    const bf16_t* h1b; bf16_t* h2b; float* pf;
    DI void operator()(AccT& acc, const Unit& u, int wr, int wc, int fr, int fq) const {
        u32x4 res[8][2];
#pragma unroll
        for (int i = 0; i < 8; ++i)
#pragma unroll
            for (int bj = 0; bj < 2; ++bj) res[i][bj] = *(const u32x4*)(h1b + (size_t)EPI_ROW(i >> 2, i & 3) * 1024 + u.pn * 256 + bj * 128 + wc * 32 + fq * 8);
#pragma unroll
        for (int ai = 0; ai < 2; ++ai)
#pragma unroll
            for (int m = 0; m < 4; ++m) {
                const int row = EPI_ROW(ai, m);
                float ss = 0.f;
#pragma unroll
                for (int bj = 0; bj < 2; ++bj) {
                    const size_t off = (size_t)row * 1024 + u.pn * 256 + bj * 128 + wc * 32 + fq * 8;
                    f32x4 r0, r1; unpack8(res[ai * 4 + m][bj], r0, r1);
                    const f32x4 v0 = acc[ai][bj][m][0] + r0, v1 = acc[ai][bj][m][1] + r1;
                    *(u32x4*)(h2b + off) = pack8(v0, v1);
                    ss += sq4(v0) + sq4(v1);
                }
                ss += __shfl_xor(ss, 16); ss = xhalf_sum(ss);
                if (fq == 0) pf[(size_t)row * 16 + u.pn * 4 + wc] = ss;
            }
    }
};

constexpr int MLA_KROW = 400, MLA_VROW = 144, MLA_KBYTES = 64 * MLA_KROW, MLA_BUF = MLA_KBYTES + 128 * MLA_VROW;

DI void mla_s_softmax(const LAS unsigned char* base, int r, int h, bool is_diag, int lim, const bf16x8 (&qf)[12], f32x16 (&o)[4], float& m_run, float& l_run,
                      bf16x8 (&pf0)[2], bf16x8 (&pf1)[2]) {
    f32x16 s0 = zero16(), s1 = zero16();
    const LAS unsigned char* kp = base + r * MLA_KROW + h * 16;
#pragma unroll
    for (int g = 0; g < 3; ++g) {
        bf16x8 fa[4], fb[4];
#pragma unroll
        for (int j = 0; j < 4; ++j) { fa[j] = *(const LAS bf16x8*)(kp + (4 * g + j) * 32); fb[j] = *(const LAS bf16x8*)(kp + 32 * MLA_KROW + (4 * g + j) * 32); }
        __builtin_amdgcn_sched_barrier(0);
#pragma unroll
        for (int j = 0; j < 4; ++j) { s0 = MFMA32(fa[j], qf[4 * g + j], s0); s1 = MFMA32(fb[j], qf[4 * g + j], s1); }
        __builtin_amdgcn_sched_barrier(0);
    }
    if (is_diag) {
#pragma unroll
        for (int i = 0; i < 16; ++i) { if (16 * h + i > lim) s0[i] = -1e30f; if (32 + 16 * h + i > lim) s1[i] = -1e30f; }
    }
    float mx = fmaxf(s0[0], s1[0]);
#pragma unroll
    for (int i = 1; i < 16; ++i) mx = fmaxf(mx, fmaxf(s0[i], s1[i]));
    mx = xhalf_max(mx);
    const float mnew = fmaxf(m_run, mx);
    if (__builtin_amdgcn_ballot_w64(mnew > m_run + 8.0f) != 0ull) {
        const float alpha = __builtin_amdgcn_exp2f(m_run - mnew);
        l_run *= alpha;
#pragma unroll
        for (int dt = 0; dt < 4; ++dt) o[dt] *= alpha;
        m_run = mnew;
    }
    float ls = 0.f;
#pragma unroll
    for (int i = 0; i < 16; ++i) { s0[i] = __builtin_amdgcn_exp2f(s0[i] - m_run); s1[i] = __builtin_amdgcn_exp2f(s1[i] - m_run); ls += s0[i] + s1[i]; }
    l_run += ls;
#pragma unroll
    for (int s = 0; s < 2; ++s) {
        u32x4 a, c;
        a.x = pk2(s0[8 * s + 0], s0[8 * s + 1]); a.y = pk2(s0[8 * s + 2], s0[8 * s + 3]); a.z = pk2(s0[8 * s + 4], s0[8 * s + 5]); a.w = pk2(s0[8 * s + 6], s0[8 * s + 7]);
        c.x = pk2(s1[8 * s + 0], s1[8 * s + 1]); c.y = pk2(s1[8 * s + 2], s1[8 * s + 3]); c.z = pk2(s1[8 * s + 4], s1[8 * s + 5]); c.w = pk2(s1[8 * s + 6], s1[8 * s + 7]);
        pf0[s] = __builtin_bit_cast(bf16x8, a); pf1[s] = __builtin_bit_cast(bf16x8, c);
    }
}
DI void mla_pv(const LAS unsigned char* base, int r, int h, const bf16x8 (&pf0)[2], const bf16x8 (&pf1)[2], f32x16 (&o)[4]) {
    const LAS unsigned char* vp = base + MLA_KBYTES + r * MLA_VROW + h * 32;
#pragma unroll
    for (int s = 0; s < 2; ++s) {
        bf16x8 va[4], vb[4];
#pragma unroll
        for (int dt = 0; dt < 4; ++dt) { va[dt] = *(const LAS bf16x8*)(vp + dt * 32 * MLA_VROW + s * 16); vb[dt] = *(const LAS bf16x8*)(vp + dt * 32 * MLA_VROW + 64 + s * 16); }
        __builtin_amdgcn_sched_barrier(0);
#pragma unroll
        for (int dt = 0; dt < 4; ++dt) o[dt] = MFMA32(va[dt], pf0[s], o[dt]);
#pragma unroll
        for (int dt = 0; dt < 4; ++dt) o[dt] = MFMA32(vb[dt], pf1[s], o[dt]);
        __builtin_amdgcn_sched_barrier(0);
    }
}

DI void mla_block(const Params& p, LAS unsigned char* lds, int b, int hd, int qb, int tid) {
    asm volatile("" : "+v"(tid));
    const int wu = __builtin_amdgcn_readfirstlane(tid >> 6), lane = tid & 63, r = lane & 31, h = lane >> 5;
    const int q0 = qb * 256 + wu * 32;
    const bf16_t* QN = (const bf16_t*)(p.ws + OFF_QN); const bf16_t* QR = (const bf16_t*)(p.ws + OFF_QR);
    const size_t tok0 = (size_t)b * S_;
    bf16x8 qf[12];
    {
        const size_t qrow = tok0 + q0 + r;
#pragma unroll
        for (int ks = 0; ks < 8; ++ks) qf[ks] = *(const bf16x8*)(QN + qrow * 512 + hd * 128 + ks * 16 + h * 8);
#pragma unroll
        for (int ks = 0; ks < 4; ++ks) qf[8 + ks] = *(const bf16x8*)(QR + qrow * 256 + hd * 64 + ks * 16 + h * 8);
    }
    unsigned goff[6];
#pragma unroll
    for (int j = 0; j < 6; ++j) {
        const int pc = wu + 8 * j; goff[j] = 0;
        if (pc < 25) {
            const int c = pc * 64 + lane, lr = c / 25; int cc = c - lr * 25; if (cc == 24) cc = 0;
            const int k32 = lr & 31, key = (lr & 32) + 16 * ((k32 >> 2) & 1) + (k32 & 3) + 4 * (k32 >> 3);
            const unsigned tok = (unsigned)(b * S_ + key);
            goff[j] = (cc < 16) ? (unsigned)OFF_KN + (tok * 512u + hd * 128 + cc * 8) * 2u : (unsigned)OFF_PROJ + (tok * 2048u + 1920 + (cc - 16) * 8) * 2u;
        } else if (pc < 43) {
            const int c = (pc - 25) * 64 + lane, d = c / 9; int cc = c - d * 9; if (cc == 8) cc = 0;
            goff[j] = (unsigned)OFF_VMT + ((unsigned)((b * 4 + hd) * 128 + d) * (unsigned)S_ + cc * 8) * 2u;
        }
    }
    const char* wsb = uptr((const char*)p.ws);
#define MLA_STAGE(KT, BUF) do { _Pragma("unroll") for (int _j = 0; _j < 6; ++_j) { const int _pc = wu + 8 * _j; if (_pc < 43) { \
        const unsigned _inc = goff[_j] >= (unsigned)OFF_VMT ? 128u : (goff[_j] < (unsigned)OFF_VST ? 262144u : 65536u); \
        __builtin_amdgcn_global_load_lds((const unsigned*)(wsb + (goff[_j] + (unsigned)(KT) * _inc)), (LAS unsigned*)(lds + (BUF) * MLA_BUF + _pc * 1024), 16, 0, 0); } } } while (0)
    f32x16 o[4]; for (int dt = 0; dt < 4; ++dt) o[dt] = zero16();
    float m_run = -1e30f, l_run = 0.f;
    const int ntiles = 4 * qb + 4, wlast = q0 >> 6;
    __syncthreads();
    MLA_STAGE(0, 0);
    const bool late = wu >= 4;
    bf16x8 pf0[2], pf1[2];
    int bcur = 0;
    for (int kt = 0; kt < ntiles; ++kt) {
        asm volatile("s_waitcnt vmcnt(0)" ::: "memory");
        __builtin_amdgcn_s_barrier();
        asm volatile("" ::: "memory");
        const int bprev = bcur == 0 ? 2 : bcur - 1, bnext = bcur == 2 ? 0 : bcur + 1;
        if (kt + 1 < ntiles) MLA_STAGE(kt + 1, bnext);
        if (late && kt >= 1 && kt - 1 <= wlast) mla_pv(lds + bprev * MLA_BUF, r, h, pf0, pf1, o);
        if (kt <= wlast) {
            mla_s_softmax(lds + bcur * MLA_BUF, r, h, kt == wlast, q0 + r - kt * 64, qf, o, m_run, l_run, pf0, pf1);
            if (!late) mla_pv(lds + bcur * MLA_BUF, r, h, pf0, pf1, o);
        }
        bcur = bnext;
    }
    if (late && wlast == ntiles - 1) { const int bprev = bcur == 0 ? 2 : bcur - 1; mla_pv(lds + bprev * MLA_BUF, r, h, pf0, pf1, o); }
#undef MLA_STAGE
    const float lt = xhalf_sum(l_run), inv = 1.f / lt;
    bf16_t* mix = (bf16_t*)(p.ws + OFF_MIX) + (tok0 + q0 + r) * 1024 + 512 + hd * 128 + 4 * h;
    float ss = 0.f;
#pragma unroll
    for (int dt = 0; dt < 4; ++dt)
#pragma unroll
        for (int g = 0; g < 4; ++g) {
            const float a0 = o[dt][4 * g] * inv, a1 = o[dt][4 * g + 1] * inv, a2 = o[dt][4 * g + 2] * inv, a3 = o[dt][4 * g + 3] * inv;
            ss += (a0 * a0 + a1 * a1) + (a2 * a2 + a3 * a3);
            u32x2 w; w.x = pk2(a0, a1); w.y = pk2(a2, a3);
            *(u32x2*)(mix + dt * 32 + 8 * g) = w;
        }
    ss = xhalf_sum(ss);
    if (h == 0) ((float*)(p.ws + OFF_HSS))[(tok0 + q0 + r) * 16 + 8 + hd] = ss;
}

DI void sb_item(const Params& p, int bh, int qb32, int lane) {
    asm volatile("" : "+v"(lane));
    const int r = lane & 31, h = lane >> 5, b = bh >> 3, hd = bh & 7, q0 = qb32 * 32;
    const bf16_t* PROJ = (const bf16_t*)(p.ws + OFF_PROJ);
    const bf16_t* VST = (const bf16_t*)(p.ws + OFF_VST);
    const size_t tok0 = (size_t)b * S_;
    bf16x8 qf[4];
#pragma unroll
    for (int ks = 0; ks < 4; ++ks) qf[ks] = *(const bf16x8*)(PROJ + (tok0 + q0 + r) * 2048 + hd * 64 + ks * 16 + h * 8);
    const int pr = 16 * ((r >> 2) & 1) + (r & 3) + 4 * (r >> 3);
    const bf16_t* kbase = PROJ + (tok0 + pr) * 2048 + 512 + hd * 64 + h * 8;
    const bf16_t* vbase = VST + ((size_t)(b * 8 + hd) * 64 + r) * S_ + 16 * h;
    bf16x8 kc[4], kn[4], vf[4];
#pragma unroll
    for (int ks = 0; ks < 4; ++ks) kc[ks] = *(const bf16x8*)(kbase + (size_t)q0 * 2048 + ks * 16);
    f32x16 o0 = zero16(), o1 = zero16();
    float carry = 1.f;
    for (int kb = q0; kb >= 0; kb -= 32) {
#pragma unroll
        for (int dt = 0; dt < 2; ++dt)
#pragma unroll
            for (int s = 0; s < 2; ++s) vf[dt * 2 + s] = *(const bf16x8*)(vbase + (size_t)dt * 32 * S_ + kb + 8 * s);
        if (kb >= 32) {
#pragma unroll
            for (int ks = 0; ks < 4; ++ks) kn[ks] = *(const bf16x8*)(kbase + (size_t)(kb - 32) * 2048 + ks * 16);
        }
        f32x16 z = zero16();
#pragma unroll
        for (int ks = 0; ks < 4; ++ks) z = MFMA32(kc[ks], qf[ks], z);
        const bool diag = (kb == q0);
        f32x16 a;
        float tot = 1.f;
#pragma unroll
        for (int i = 15; i >= 0; --i) {
            const float w = __builtin_amdgcn_exp2f(fminf(z[i], 86.f));
            float be = __builtin_amdgcn_rcpf(1.f + w);
            float om = w * be;
            if (diag) { const bool valid = (16 * h + i < r); be = valid ? be : 0.f; om = valid ? om : 1.f; }
            a[i] = be * tot;
            tot *= om;
        }
        const float other = __shfl_xor(tot, 32);
        const float base = carry * (h == 0 ? other : 1.f);
        carry *= tot * other;
#pragma unroll
        for (int i = 0; i < 16; ++i) a[i] *= base;
        bf16x8 pf[2];
#pragma unroll
        for (int s = 0; s < 2; ++s) {
            u32x4 w; w.x = pk2(a[8 * s + 0], a[8 * s + 1]); w.y = pk2(a[8 * s + 2], a[8 * s + 3]); w.z = pk2(a[8 * s + 4], a[8 * s + 5]); w.w = pk2(a[8 * s + 6], a[8 * s + 7]);
            pf[s] = __builtin_bit_cast(bf16x8, w);
        }
#pragma unroll
        for (int s = 0; s < 2; ++s) { o0 = MFMA32(vf[s], pf[s], o0); o1 = MFMA32(vf[2 + s], pf[s], o1); }
        if (kb >= 32) {
#pragma unroll
            for (int ks = 0; ks < 4; ++ks) kc[ks] = kn[ks];
        }
        if (__all(carry < SB_PTHR)) break;
    }
    bf16_t* mix = (bf16_t*)(p.ws + OFF_MIX) + (tok0 + q0 + r) * 1024 + hd * 64 + 4 * h;
    float ss = 0.f;
#pragma unroll
    for (int g = 0; g < 4; ++g) {
        { const float a0 = o0[4 * g], a1 = o0[4 * g + 1], a2 = o0[4 * g + 2], a3 = o0[4 * g + 3];
          ss += (a0 * a0 + a1 * a1) + (a2 * a2 + a3 * a3); u32x2 w; w.x = pk2(a0, a1); w.y = pk2(a2, a3); *(u32x2*)(mix + 8 * g) = w; }
        { const float a0 = o1[4 * g], a1 = o1[4 * g + 1], a2 = o1[4 * g + 2], a3 = o1[4 * g + 3];
          ss += (a0 * a0 + a1 * a1) + (a2 * a2 + a3 * a3); u32x2 w; w.x = pk2(a0, a1); w.y = pk2(a2, a3); *(u32x2*)(mix + 32 + 8 * g) = w; }
    }
    ss = xhalf_sum(ss);
    if (h == 0) ((float*)(p.ws + OFF_HSS))[(tok0 + q0 + r) * 16 + hd] = ss;
}

constexpr int SB_ROW = 144, SB_KBYTES = 64 * SB_ROW, SB_BUF = 2 * SB_KBYTES  , SB_NB = 7, SB_FLAGS = SB_NB * SB_BUF;
DI void sb_block(const Params& p, LAS unsigned char* lds, int bh, int qb, int tid) {
    asm volatile("" : "+v"(tid));
    const int wu = __builtin_amdgcn_readfirstlane(tid >> 6), lane = tid & 63, r = lane & 31, h = lane >> 5;
    const int b = bh >> 3, hd = bh & 7, q0 = qb * 256 + wu * 32;
    const bf16_t* PROJ = (const bf16_t*)(p.ws + OFF_PROJ);
    const size_t tok0 = (size_t)b * S_;
    bf16x8 qf[4];
#pragma unroll
    for (int ks = 0; ks < 4; ++ks) qf[ks] = *(const bf16x8*)(PROJ + (tok0 + q0 + r) * 2048 + hd * 64 + ks * 16 + h * 8);
    unsigned goff[3];
#pragma unroll
    for (int j = 0; j < 3; ++j) {
        const int pc = wu + 8 * j; goff[j] = 0;
        if (pc < 18) {
            const int c = (pc < 9 ? pc : pc - 9) * 64 + lane, lr = c / 9; int cc = c - lr * 9; if (cc == 8) cc = 0;
            if (pc < 9) { const int k32 = lr & 31, key = (lr & 32) + 16 * ((k32 >> 2) & 1) + (k32 & 3) + 4 * (k32 >> 3);
                goff[j] = (unsigned)OFF_PROJ + ((unsigned)(b * S_ + key) * 2048u + 512 + hd * 64 + cc * 8) * 2u; }
            else goff[j] = (unsigned)OFF_VST + ((unsigned)((b * 8 + hd) * 64 + lr) * (unsigned)S_ + cc * 8) * 2u;
        }
    }
    const char* wsb = uptr((const char*)p.ws);
#define SB_STAGE(KT, BUF) do { _Pragma("unroll") for (int _j = 0; _j < 3; ++_j) { const int _pc = wu + 8 * _j; if (_pc < 18) { \
        const unsigned _inc = goff[_j] >= (unsigned)OFF_VST ? 128u : 262144u; \
        __builtin_amdgcn_global_load_lds((const unsigned*)(wsb + (goff[_j] + (unsigned)(KT) * _inc)), (LAS unsigned*)(lds + (BUF) * SB_BUF + _pc * 1024), 16, 0, 0); } } } while (0)
    f32x16 o0 = zero16(), o1 = zero16();
    float carry = 1.f;
    bool done = false;
    const int ktop = 4 * qb + 3;
    LAS int* flags = (LAS int*)(lds + SB_FLAGS);
    asm volatile("s_waitcnt vmcnt(0)" ::: "memory");
    __syncthreads();
    const int nstaged = ktop + 1 < SB_NB ? ktop + 1 : SB_NB;
    for (int i = 0; i < nstaged; ++i) SB_STAGE(ktop - i, i);
#define SB_WAITV(n) asm volatile("s_waitcnt vmcnt(" #n ") lgkmcnt(0)" ::: "memory")
    int cur = 0, it = 0;
    for (int kt = ktop; ; --kt, ++it) {
        if (lane == 0) flags[(it & 1) * 8 + wu] = done ? 1 : 0;
        if (it >= SB_NB && kt >= 0) SB_STAGE(kt, cur);
        const int ahead = it < nstaged ? nstaged - 1 - it : 0;
        if (wu < 2) { switch (ahead) { case 0: SB_WAITV(0); break; case 1: SB_WAITV(3); break; case 2: SB_WAITV(6); break; case 3: SB_WAITV(9); break; case 4: SB_WAITV(12); break; case 5: SB_WAITV(15); break; default: SB_WAITV(18); break; } }
        else { switch (ahead) { case 0: SB_WAITV(0); break; case 1: SB_WAITV(2); break; case 2: SB_WAITV(4); break; case 3: SB_WAITV(6); break; case 4: SB_WAITV(8); break; case 5: SB_WAITV(10); break; default: SB_WAITV(12); break; } }
        __builtin_amdgcn_s_barrier();
        asm volatile("" ::: "memory");
        {
            const LAS int* f = flags + (it & 1) * 8;
            const int all = f[0] & f[1] & f[2] & f[3] & f[4] & f[5] & f[6] & f[7];
            if (__builtin_amdgcn_readfirstlane(all)) break;
        }
        if (!done && kt * 64 <= q0) {
            const LAS unsigned char* base = lds + cur * SB_BUF;
#pragma unroll
            for (int sub = 1; sub >= 0; --sub) {
                const int kb = kt * 64 + sub * 32;
                if (kb <= q0 && !done) {
                    const LAS unsigned char* kp = base + (sub * 32 + r) * SB_ROW + h * 16;
                    bf16x8 kf[4], vf[4];
#pragma unroll
                    for (int ks = 0; ks < 4; ++ks) kf[ks] = *(const LAS bf16x8*)(kp + ks * 32);
#pragma unroll
                    for (int dt = 0; dt < 2; ++dt)
#pragma unroll
                        for (int s2 = 0; s2 < 2; ++s2) vf[dt * 2 + s2] = *(const LAS bf16x8*)(base + SB_KBYTES + (dt * 32 + r) * SB_ROW + (sub * 32 + 16 * h + 8 * s2) * 2);
                    f32x16 z = zero16();
#pragma unroll
                    for (int ks = 0; ks < 4; ++ks) z = MFMA32(kf[ks], qf[ks], z);
                    const bool diag = (kb == q0);
                    f32x16 a;
                    float tot = 1.f;
#pragma unroll
                    for (int i = 15; i >= 0; --i) {
                        const float w = __builtin_amdgcn_exp2f(fminf(z[i], 86.f));
                        float be = __builtin_amdgcn_rcpf(1.f + w);
                        float om = w * be;
                        if (diag) { const bool valid = (16 * h + i < r); be = valid ? be : 0.f; om = valid ? om : 1.f; }
                        a[i] = be * tot;
                        tot *= om;
                    }
                    const float other = __shfl_xor(tot, 32);
                    const float bs = carry * (h == 0 ? other : 1.f);
                    carry *= tot * other;
#pragma unroll
                    for (int i = 0; i < 16; ++i) a[i] *= bs;
                    bf16x8 pf[2];
#pragma unroll
                    for (int s2 = 0; s2 < 2; ++s2) {
                        u32x4 w; w.x = pk2(a[8 * s2 + 0], a[8 * s2 + 1]); w.y = pk2(a[8 * s2 + 2], a[8 * s2 + 3]); w.z = pk2(a[8 * s2 + 4], a[8 * s2 + 5]); w.w = pk2(a[8 * s2 + 6], a[8 * s2 + 7]);
                        pf[s2] = __builtin_bit_cast(bf16x8, w);
                    }
#pragma unroll
                    for (int s2 = 0; s2 < 2; ++s2) { o0 = MFMA32(vf[s2], pf[s2], o0); o1 = MFMA32(vf[2 + s2], pf[s2], o1); }
                    if (__all(carry < SB_PTHR)) done = true;
                }
            }
            if (kt == 0) done = true;
        }
        cur = cur == SB_NB - 1 ? 0 : cur + 1;
    }
    asm volatile("s_waitcnt vmcnt(0)" ::: "memory");
#undef SB_WAITV
#undef SB_STAGE
    bf16_t* mix = (bf16_t*)(p.ws + OFF_MIX) + (tok0 + q0 + r) * 1024 + hd * 64 + 4 * h;
    float ss = 0.f;
#pragma unroll
    for (int g = 0; g < 4; ++g) {
        { const float a0 = o0[4 * g], a1 = o0[4 * g + 1], a2 = o0[4 * g + 2], a3 = o0[4 * g + 3];
          ss += (a0 * a0 + a1 * a1) + (a2 * a2 + a3 * a3); u32x2 w; w.x = pk2(a0, a1); w.y = pk2(a2, a3); *(u32x2*)(mix + 8 * g) = w; }
        { const float a0 = o1[4 * g], a1 = o1[4 * g + 1], a2 = o1[4 * g + 2], a3 = o1[4 * g + 3];
          ss += (a0 * a0 + a1 * a1) + (a2 * a2 + a3 * a3); u32x2 w; w.x = pk2(a0, a1); w.y = pk2(a2, a3); *(u32x2*)(mix + 32 + 8 * g) = w; }
    }
    ss = xhalf_sum(ss);
    if (h == 0) ((float*)(p.ws + OFF_HSS))[(tok0 + q0 + r) * 16 + hd] = ss;
}

DI void sb_block2(const Params& p, LAS unsigned char* lds, int bh, int qb2, int tid) {
    asm volatile("" : "+v"(tid));
    const int wu = __builtin_amdgcn_readfirstlane(tid >> 6), lane = tid & 63, r = lane & 31, h = lane >> 5;
    const int b = bh >> 3, hd = bh & 7;
    int q0[2]; q0[0] = qb2 * 512 + wu * 32; q0[1] = q0[0] + 256;
    const bf16_t* PROJ = (const bf16_t*)(p.ws + OFF_PROJ);
    const size_t tok0 = (size_t)b * S_;
    bf16x8 qf[2][4];
#pragma unroll
    for (int g = 0; g < 2; ++g)
#pragma unroll
        for (int ks = 0; ks < 4; ++ks) qf[g][ks] = *(const bf16x8*)(PROJ + (tok0 + q0[g] + r) * 2048 + hd * 64 + ks * 16 + h * 8);
    unsigned goff[3];
#pragma unroll
    for (int j = 0; j < 3; ++j) {
        const int pc = wu + 8 * j; goff[j] = 0;
        if (pc < 18) {
            const int c = (pc < 9 ? pc : pc - 9) * 64 + lane, lr = c / 9; int cc = c - lr * 9; if (cc == 8) cc = 0;
            if (pc < 9) { const int k32 = lr & 31, key = (lr & 32) + 16 * ((k32 >> 2) & 1) + (k32 & 3) + 4 * (k32 >> 3);
                goff[j] = (unsigned)OFF_PROJ + ((unsigned)(b * S_ + key) * 2048u + 512 + hd * 64 + cc * 8) * 2u; }
            else goff[j] = (unsigned)OFF_VST + ((unsigned)((b * 8 + hd) * 64 + lr) * (unsigned)S_ + cc * 8) * 2u;
        }
    }
    const char* wsb = uptr((const char*)p.ws);
#define SB_STAGE(KT, BUF) do { _Pragma("unroll") for (int _j = 0; _j < 3; ++_j) { const int _pc = wu + 8 * _j; if (_pc < 18) { \
        const unsigned _inc = goff[_j] >= (unsigned)OFF_VST ? 128u : 262144u; \
        __builtin_amdgcn_global_load_lds((const unsigned*)(wsb + (goff[_j] + (unsigned)(KT) * _inc)), (LAS unsigned*)(lds + (BUF) * SB_BUF + _pc * 1024), 16, 0, 0); } } } while (0)
    f32x16 o0[2], o1[2]; float carry[2]; bool done[2];
#pragma unroll
    for (int g = 0; g < 2; ++g) { o0[g] = zero16(); o1[g] = zero16(); carry[g] = 1.f; done[g] = false; }
    const int ktop = 8 * qb2 + 7;
    LAS int* flags = (LAS int*)(lds + SB_FLAGS);
    asm volatile("s_waitcnt vmcnt(0)" ::: "memory");
    __syncthreads();
    const int nstaged = ktop + 1 < SB_NB ? ktop + 1 : SB_NB;
    for (int i = 0; i < nstaged; ++i) SB_STAGE(ktop - i, i);
#define SB_WAITV(n) asm volatile("s_waitcnt vmcnt(" #n ") lgkmcnt(0)" ::: "memory")
    int cur = 0, it = 0;
    for (int kt = ktop; ; --kt, ++it) {
        if (lane == 0) flags[(it & 1) * 8 + wu] = (done[0] && done[1]) ? 1 : 0;
        int lowest = ktop - (SB_NB - 1) - (it > 0 ? it - 1 : 0); if (lowest < 0) lowest = 0;
        int ahead = kt - lowest; if (ahead < 0) ahead = 0;
        if (wu < 2) { switch (ahead) { case 0: SB_WAITV(0); break; case 1: SB_WAITV(3); break; case 2: SB_WAITV(6); break; case 3: SB_WAITV(9); break; case 4: SB_WAITV(12); break; case 5: SB_WAITV(15); break; default: SB_WAITV(18); break; } }
        else { switch (ahead) { case 0: SB_WAITV(0); break; case 1: SB_WAITV(2); break; case 2: SB_WAITV(4); break; case 3: SB_WAITV(6); break; case 4: SB_WAITV(8); break; case 5: SB_WAITV(10); break; default: SB_WAITV(12); break; } }
        __builtin_amdgcn_s_barrier();
        asm volatile("" ::: "memory");
        {
            const LAS int* f = flags + (it & 1) * 8;
            const int all = f[0] & f[1] & f[2] & f[3] & f[4] & f[5] & f[6] & f[7];
            if (__builtin_amdgcn_readfirstlane(all)) break;
        }
        if (it >= 1 && kt - (SB_NB - 1) >= 0) SB_STAGE(kt - (SB_NB - 1), cur == 0 ? SB_NB - 1 : cur - 1);
        {
            const LAS unsigned char* base = lds + cur * SB_BUF;
#pragma unroll
            for (int sub = 1; sub >= 0; --sub) {
                const int kb = kt * 64 + sub * 32;
                const LAS unsigned char* kp = base + (sub * 32 + r) * SB_ROW + h * 16;
                const bool act0 = !done[0] && kb <= q0[0], act1 = !done[1] && kb <= q0[1];
                if (act0 || act1) {
                    bf16x8 kf[4], vf[4];
#pragma unroll
                    for (int ks = 0; ks < 4; ++ks) kf[ks] = *(const LAS bf16x8*)(kp + ks * 32);
#pragma unroll
                    for (int dt = 0; dt < 2; ++dt)
#pragma unroll
                        for (int s2 = 0; s2 < 2; ++s2) vf[dt * 2 + s2] = *(const LAS bf16x8*)(base + SB_KBYTES + (dt * 32 + r) * SB_ROW + (sub * 32 + 16 * h + 8 * s2) * 2);
#pragma unroll
                    for (int g = 0; g < 2; ++g) {
                        if (g == 0 ? act0 : act1) {
                            f32x16 z = zero16();
#pragma unroll
                            for (int ks = 0; ks < 4; ++ks) z = MFMA32(kf[ks], qf[g][ks], z);
                            const bool diag = (kb == q0[g]);
                            f32x16 a;
                            float tot = 1.f;
#pragma unroll
                            for (int i = 15; i >= 0; --i) {
                                const float w = __builtin_amdgcn_exp2f(fminf(z[i], 86.f));
                                float be = __builtin_amdgcn_rcpf(1.f + w);
                                float om = w * be;
                                if (diag) { const bool valid = (16 * h + i < r); be = valid ? be : 0.f; om = valid ? om : 1.f; }
                                a[i] = be * tot;
                                tot *= om;
                            }
                            float tlo, thi; xhalf(tot, tlo, thi);
                            const float bs = carry[g] * (h == 0 ? thi : 1.f);
                            carry[g] *= tlo * thi;
#pragma unroll
                            for (int i = 0; i < 16; ++i) a[i] *= bs;
                            bf16x8 pf[2];
#pragma unroll
                            for (int s2 = 0; s2 < 2; ++s2) {
                                u32x4 w; w.x = pk2(a[8 * s2 + 0], a[8 * s2 + 1]); w.y = pk2(a[8 * s2 + 2], a[8 * s2 + 3]); w.z = pk2(a[8 * s2 + 4], a[8 * s2 + 5]); w.w = pk2(a[8 * s2 + 6], a[8 * s2 + 7]);
                                pf[s2] = __builtin_bit_cast(bf16x8, w);
                            }
#pragma unroll
                            for (int s2 = 0; s2 < 2; ++s2) { o0[g] = MFMA32(vf[s2], pf[s2], o0[g]); o1[g] = MFMA32(vf[2 + s2], pf[s2], o1[g]); }
                            if (__all(carry[g] < SB_PTHR)) done[g] = true;
                        }
                    }
                }
            }
            if (kt == 0) { done[0] = true; done[1] = true; }
        }
        cur = cur == SB_NB - 1 ? 0 : cur + 1;
    }
    asm volatile("s_waitcnt vmcnt(0)" ::: "memory");
#undef SB_WAITV
#undef SB_STAGE
#pragma unroll
    for (int g = 0; g < 2; ++g) {
        bf16_t* mix = (bf16_t*)(p.ws + OFF_MIX) + (tok0 + q0[g] + r) * 1024 + hd * 64 + 4 * h;
        float ss = 0.f;
#pragma unroll
        for (int gg = 0; gg < 4; ++gg) {
            { const float a0 = o0[g][4 * gg], a1 = o0[g][4 * gg + 1], a2 = o0[g][4 * gg + 2], a3 = o0[g][4 * gg + 3];
              ss += (a0 * a0 + a1 * a1) + (a2 * a2 + a3 * a3); u32x2 w; w.x = pk2(a0, a1); w.y = pk2(a2, a3); *(u32x2*)(mix + 8 * gg) = w; }
            { const float a0 = o1[g][4 * gg], a1 = o1[g][4 * gg + 1], a2 = o1[g][4 * gg + 2], a3 = o1[g][4 * gg + 3];
              ss += (a0 * a0 + a1 * a1) + (a2 * a2 + a3 * a3); u32x2 w; w.x = pk2(a0, a1); w.y = pk2(a2, a3); *(u32x2*)(mix + 32 + 8 * gg) = w; }
        }
        ss = xhalf_sum(ss);
        if (h == 0) ((float*)(p.ws + OFF_HSS))[(tok0 + q0[g] + r) * 16 + hd] = ss;
    }
}

DI void phase_attention(const Params& p, LAS unsigned char* lds, int tid, int which = 3) {
    const int blk = blockIdx.x, G = gridDim.x;
#ifndef NO_MLA
    if (which & 1) for (int it = blk; it < 512; it += G) {
        const int xcd = it & 7, local = (it >> 3) & 63;
        const int bh = xcd * 8 + (local >> 3), pr = local & 7;
        mla_block(p, lds, bh >> 2, bh & 3, pr, tid);
        mla_block(p, lds, bh >> 2, bh & 3, 15 - pr, tid);
    }
#endif
#ifndef NO_SB
    if (which & 2) for (int it = blk; it < 1024; it += G) {
        const int xcd = it & 7, local = (it >> 3) & 127;
        sb_block2(p, lds, xcd * 16 + (local >> 3), local & 7, tid);
    }
#endif
}

DI void phase_final(const Params& p, int tid) {
    const int wid = tid >> 6, lane = tid & 63;
    const float* pf = (const float*)(p.ws + OFF_PF);
    const bf16_t* h2b = (const bf16_t*)(p.ws + OFF_MIX);
    f32x4 ga[2], gb[2];
#pragma unroll
    for (int j = 0; j < 2; ++j) { ga[j] = *(const f32x4*)(p.g_final + j * 512 + lane * 8); gb[j] = *(const f32x4*)(p.g_final + j * 512 + lane * 8 + 4); }
    for (int row = blockIdx.x * 8 + wid; row < T_; row += gridDim.x * 8) {
        const f32x4* pp = (const f32x4*)(pf + (size_t)row * 16);
        u32x4 w[2];
#pragma unroll
        for (int j = 0; j < 2; ++j) w[j] = *(const u32x4*)(h2b + (size_t)row * 1024 + j * 512 + lane * 8);
        const float rs = rsqrtf(((sum4(pp[0]) + sum4(pp[1])) + (sum4(pp[2]) + sum4(pp[3]))) * (1.f / 1024.f) + EPS_);
        float* orow = p.out + (size_t)row * 1024 + lane * 8;
#pragma unroll
        for (int j = 0; j < 2; ++j) { f32x4 a, b; unpack8(w[j], a, b); *(f32x4*)(orow + j * 512) = a * rs * ga[j]; *(f32x4*)(orow + j * 512 + 4) = b * rs * gb[j]; }
    }
}

#define XB_TMO      128
#define XB_XCNT(j)  (256  + 64 * (j))
#define XB_XSUB(j)  (1280 + 64 * (j))
#define XB_XGEN(j)  (2304 + 64 * (j))
#define XB_TOP      3328
#define XB_TOPGEN   3392
#define XCD_BAR_WORDS 3456
#define XB_SPIN_CAP (1u << 18)
DI unsigned xb_ld(unsigned* p)              { return __hip_atomic_load(p, __ATOMIC_RELAXED, __HIP_MEMORY_SCOPE_AGENT); }
DI unsigned xb_add(unsigned* p, unsigned v) { return __hip_atomic_fetch_add(p, v, __ATOMIC_RELAXED, __HIP_MEMORY_SCOPE_AGENT); }
DI unsigned xb_xcc_id() { return (unsigned)__builtin_amdgcn_s_getreg((3 << 11) | 20) & 0xFu; }
#define XB_SPIN(cond, bar) do { unsigned _sp = 0; while (cond) { __builtin_amdgcn_s_sleep(1); \
    if ((++_sp & 255u) == 0u) { if (xb_ld(&(bar)[XB_TMO])) break; if (_sp > XB_SPIN_CAP) { atomicAdd(&(bar)[XB_TMO], 1u); break; } } } } while (0)
struct XcdBarrier { unsigned* bar; unsigned x; volatile LAS unsigned* st; };
DI XcdBarrier xcd_barrier_post(unsigned* bar, volatile LAS unsigned* st) {
    XcdBarrier b; b.bar = bar; b.x = xb_xcc_id(); b.st = st;
    if (threadIdx.x == 0) (void)xb_add(&bar[XB_XCNT(b.x)], 1u);
    return b;
}
DI void xcd_barrier_complete(unsigned* bar, unsigned x, unsigned& nloc, unsigned& nx) {
    const unsigned G = gridDim.x * gridDim.y * gridDim.z;
    unsigned sum, cnt, mine, sp = 0u;
    for (;;) {
        sum = 0u; cnt = 0u; mine = 0u;
#pragma unroll
        for (unsigned j = 0; j < 16; ++j) { const unsigned c = xb_ld(&bar[XB_XCNT(j)]); sum += c; cnt += (c > 0u) ? 1u : 0u; mine = (j == x) ? c : mine; }
        if (sum == G) break;
        __builtin_amdgcn_s_sleep(1);
        if ((++sp & 255u) == 0u) { if (xb_ld(&bar[XB_TMO])) break; if (sp > XB_SPIN_CAP) { atomicAdd(&bar[XB_TMO], 1u); break; } }
    }
    nloc = mine > 0u ? mine : 1u; nx = cnt > 0u ? cnt : 1u;
}
DI void xcd_barrier(const XcdBarrier& b) {
    asm volatile("s_waitcnt vmcnt(0)" ::: "memory");
    __syncthreads();
    if (threadIdx.x == 0) {
        unsigned* bar = b.bar;
        __builtin_amdgcn_s_waitcnt(0);
        unsigned nloc = b.st[0], nx = b.st[1];
        if (nloc == 0u) { xcd_barrier_complete(bar, b.x, nloc, nx); b.st[0] = nloc; b.st[1] = nx; }
        const unsigned old = xb_add(&bar[XB_XSUB(b.x)], 1u);
        const unsigned gen = old / nloc;
        if (old + 1u == (gen + 1u) * nloc) {
            __builtin_amdgcn_fence(__ATOMIC_RELEASE, "agent");
            asm volatile("s_waitcnt vmcnt(0)" ::: "memory");
            const unsigned og = xb_add(&bar[XB_TOP], 1u);
            const unsigned tg = og / nx;
            if (og + 1u == (tg + 1u) * nx) xb_add(&bar[XB_TOPGEN], 1u);
            else XB_SPIN(xb_ld(&bar[XB_TOPGEN]) == tg, bar);
            __builtin_amdgcn_fence(__ATOMIC_ACQUIRE, "agent");
            xb_add(&bar[XB_XGEN(b.x)], 1u);
            asm volatile("s_waitcnt vmcnt(0)" ::: "memory");
        } else {
            XB_SPIN(xb_ld(&bar[XB_XGEN(b.x)]) == gen, bar);
            __builtin_amdgcn_fence(__ATOMIC_ACQUIRE, "agent");
            asm volatile("s_waitcnt vmcnt(0)" ::: "memory");
        }
    }
    __syncthreads();
}

#ifndef PH_MASK
#define PH_MASK 255
#endif
#ifndef DUP_MASK
#define DUP_MASK 0
#endif
#ifndef DUP_WHICH
#define DUP_WHICH 3
#endif
constexpr int LDS_XB = g8::STAGE_BYTES + 8192;
constexpr int LDS_BYTES = g8::STAGE_BYTES + 8192 + 64;

__global__ void __launch_bounds__(512, 2) hymba_fwd(Params p) {
    extern __shared__ __attribute__((aligned(16))) unsigned char lds_raw[];
    LAS unsigned char* lds = (LAS unsigned char*)lds_raw;
    cg::grid_group grid = cg::this_grid();
    const int wid_s = __builtin_amdgcn_readfirstlane((int)threadIdx.x >> 6);
    unsigned char* ws = p.ws;

    volatile LAS unsigned* xst = (volatile LAS unsigned*)(lds + LDS_XB);
    if (threadIdx.x == 0) { xst[0] = 0u; xst[1] = 0u; }
    __syncthreads();
    const XcdBarrier xb = xcd_barrier_post((unsigned*)(ws + OFF_BAR), xst);
    if (p.out == nullptr) grid.sync();
    if (PH_MASK & 1) phase0(p, lds, fresh_tid(wid_s));
    xcd_barrier(xb);
    if (DUP_MASK & 1) { phase0(p, lds, fresh_tid(wid_s)); xcd_barrier(xb); }
    if (PH_MASK & 2) {
        LAS float* tab = (LAS float*)(lds + g8::STAGE_BYTES);
        EpiProj E{tab, (const float*)(ws + OFF_CS), (bf16_t*)(ws + OFF_PROJ), (bf16_t*)(ws + OFF_VST), (float*)(ws + OFF_PQ), (float*)(ws + OFF_PKV)};
        g8::gemm_phase<1, 1>(lds, wid_s, (const bf16_t*)(ws + OFF_XB), 1024, (const bf16_t*)(ws + OFF_WIN), 1024, T_, 2048, 1024, E, TabFill<RowRsx>{tab, wid_s, RowRsx{(const float*)(ws + OFF_RSX)}});
    }
    xcd_barrier(xb);
    if (PH_MASK & 4) {
        LAS float* tab = (LAS float*)(lds + g8::STAGE_BYTES);
        EpiQKV E{tab, (const float*)(ws + OFF_CS), (bf16_t*)(ws + OFF_QN), (bf16_t*)(ws + OFF_QR), (bf16_t*)(ws + OFF_KN), (bf16_t*)(ws + OFF_VMT)};
        g8::gemm_phase<1>(lds, wid_s, (const bf16_t*)(ws + OFF_PROJ) + 1536, 2048, (const bf16_t*)(ws + OFF_WQB), 256, T_, 1792, 256, E, TabFill<RowQKV>{tab, wid_s, RowQKV{(const float*)(ws + OFF_PQ), (const float*)(ws + OFF_PKV)}});
    }
    xcd_barrier(xb);
    if (PH_MASK & 8) phase_attention(p, lds, fresh_tid(wid_s));
    xcd_barrier(xb);
    if (DUP_MASK & 8) { phase_attention(p, lds, fresh_tid(wid_s), DUP_WHICH); xcd_barrier(xb); }
    if (PH_MASK & 16) {
        LAS float* tab = (LAS float*)(lds + g8::STAGE_BYTES);
        EpiOut E{tab, (const bf16_t*)(ws + OFF_XB), (bf16_t*)(ws + OFF_H1B), (float*)(ws + OFF_PH)};
        g8::gemm_phase<2>(lds, wid_s, (const bf16_t*)(ws + OFF_MIX), 1024, (const bf16_t*)(ws + OFF_WO), 1024, T_, 1024, 512, E, TabFill<RowOut>{tab, wid_s, RowOut{(const float*)(ws + OFF_HSS)}});
    }
    xcd_barrier(xb);
    for (int rep = 0; rep < ((DUP_MASK & 32) ? 2 : 1); ++rep) {
    if (rep) xcd_barrier(xb);
    if (PH_MASK & 32) {
        LAS float* rst = (LAS float*)(lds + g8::STAGE_BYTES);
        EpiUp E{rst, (bf16_t*)(ws + OFF_HID)};
        g8::gemm_phase<1>(lds, wid_s, (const bf16_t*)(ws + OFF_H1B), 1024, (const bf16_t*)(ws + OFF_WUP), 1024, T_, 4096, 1024, E, TabFill<RowUp>{rst, wid_s, RowUp{(const float*)(ws + OFF_PH)}});
    }
    }
    xcd_barrier(xb);
    if (PH_MASK & 64) {
        EpiDown E{(const bf16_t*)(ws + OFF_H1B), (bf16_t*)(ws + OFF_MIX), (float*)(ws + OFF_PF)};
        g8::gemm_phase<1>(lds, wid_s, (const bf16_t*)(ws + OFF_HID), 4096, (const bf16_t*)(ws + OFF_WDN), 4096, T_, 1024, 4096, E);
    }
    xcd_barrier(xb);
    if (PH_MASK & 128) phase_final(p, fresh_tid(wid_s));
}

extern "C" void kernel_launch(void* const* d_in, const int* in_sizes, int n_in, void* d_out, int out_size, void* d_ws, size_t ws_size, hipStream_t stream) {
    static int grid_blocks = 0;
    if (grid_blocks == 0) {
        if (n_in != 15 || in_sizes[0] != T_ * 1024 || out_size != T_ * 1024 || ws_size < WS_END) {
            fprintf(stderr, "kernel_launch: unexpected shapes (n_in %d, in0 %d, out %d, ws %zu < %zu)\n", n_in, n_in > 0 ? in_sizes[0] : -1, out_size, ws_size, (size_t)WS_END);
            grid_blocks = -1; return;
        }
        int dev = 0, cus = 0, per_cu = 0;
        hipGetDevice(&dev);
        hipDeviceGetAttribute(&cus, hipDeviceAttributeMultiprocessorCount, dev);
        if (hipFuncSetAttribute((const void*)hymba_fwd, hipFuncAttributeMaxDynamicSharedMemorySize, LDS_BYTES) != hipSuccess) fprintf(stderr, "kernel_launch: hipFuncSetAttribute failed\n");
        if (hipOccupancyMaxActiveBlocksPerMultiprocessor(&per_cu, (const void*)hymba_fwd, 512, LDS_BYTES) != hipSuccess || per_cu < 1) { fprintf(stderr, "kernel_launch: occupancy query gave %d\n", per_cu); per_cu = 1; }
        (void)hipGetLastError();
        grid_blocks = cus;
        if (grid_blocks != 256) fprintf(stderr, "kernel_launch: note: %d CUs (work maps assume 256)\n", grid_blocks);
    }
    if (grid_blocks < 0) return;
    Params p{};
    p.x = (const float*)d_in[0]; p.pos = (const int*)d_in[1]; p.g_attn = (const float*)d_in[2]; p.w_in = (const float*)d_in[3];
    p.g_qa = (const float*)d_in[4]; p.w_qb = (const float*)d_in[5]; p.g_kva = (const float*)d_in[6]; p.w_kvb = (const float*)d_in[7];
    p.g_sbo = (const float*)d_in[8]; p.g_mlao = (const float*)d_in[9]; p.w_o = (const float*)d_in[10]; p.g_mlp = (const float*)d_in[11];
    p.w_up = (const float*)d_in[12]; p.w_down = (const float*)d_in[13]; p.g_final = (const float*)d_in[14];
    p.out = (float*)d_out; p.ws = (unsigned char*)d_ws;
    (void)hipMemsetAsync((unsigned char*)d_ws + OFF_BAR, 0, XCD_BAR_WORDS * 4, stream);
    void* args[] = {&p};
    hipError_t e = hipLaunchCooperativeKernel((const void*)hymba_fwd, dim3(grid_blocks), dim3(512), args, LDS_BYTES, stream);
    if (e != hipSuccess) fprintf(stderr, "kernel_launch: cooperative launch failed: %s (grid %d)\n", hipGetErrorString(e), grid_blocks);
}
```

```cpp
#include <hip/hip_runtime.h>
#include <hip/hip_cooperative_groups.h>
#include <cstdio>
namespace cg = cooperative_groups;

#define LAS __attribute__((address_space(3)))
#define DI __device__ __forceinline__
typedef unsigned short bf16_t;
typedef short bf16x8 __attribute__((ext_vector_type(8)));
typedef float f32x2 __attribute__((ext_vector_type(2)));
typedef float f32x4 __attribute__((ext_vector_type(4)));
typedef float f32x16 __attribute__((ext_vector_type(16)));
typedef unsigned u32x4 __attribute__((ext_vector_type(4)));
typedef unsigned u32x2 __attribute__((ext_vector_type(2)));
typedef __bf16 bf2_t __attribute__((ext_vector_type(2)));

constexpr int T_ = 65536, S_ = 4096;
constexpr float EPS_ = 1e-6f;
constexpr float LOG2E = 1.4426950408889634f, LN2 = 0.6931471805599453f;
constexpr float MLA_QSCALE = 0.07216878364870322f * 1.4426950408889634f;
constexpr float SB_PTHR = 1e-37f;

constexpr size_t SZ_T = (size_t)T_;
constexpr size_t OFF_PROJ = 0;
constexpr size_t OFF_VST  = OFF_PROJ + SZ_T * 2048 * 2;
constexpr size_t OFF_QN   = OFF_VST + SZ_T * 512 * 2;
constexpr size_t OFF_QR   = OFF_QN + SZ_T * 512 * 2;
constexpr size_t OFF_KN   = OFF_QR + SZ_T * 256 * 2;
constexpr size_t OFF_VMT  = OFF_KN + SZ_T * 512 * 2;
constexpr size_t OFF_REGA_END = OFF_VMT + SZ_T * 512 * 2;
constexpr size_t OFF_HID  = 0;
constexpr size_t OFF_XB   = OFF_REGA_END;
constexpr size_t OFF_MIX  = OFF_XB + SZ_T * 1024 * 2;
constexpr size_t OFF_H1B  = OFF_MIX + SZ_T * 1024 * 2;
constexpr size_t OFF_WIN  = OFF_H1B + SZ_T * 1024 * 2;
constexpr size_t OFF_WQB  = OFF_WIN + (size_t)2048 * 1024 * 2;
constexpr size_t OFF_WKVB = OFF_WQB + (size_t)768 * 256 * 2;
constexpr size_t OFF_WO   = OFF_WKVB + (size_t)1024 * 256 * 2;
constexpr size_t OFF_WUP  = OFF_WO + (size_t)1024 * 1024 * 2;
constexpr size_t OFF_WDN  = OFF_WUP + (size_t)4096 * 1024 * 2;
constexpr size_t OFF_CS   = OFF_WDN + (size_t)4096 * 1024 * 2;
constexpr size_t OFF_RSX  = OFF_CS + SZ_T * 32 * 8;
constexpr size_t OFF_PQ   = OFF_RSX + SZ_T * 4;
constexpr size_t OFF_PKV  = OFF_PQ + SZ_T * 16;
constexpr size_t OFF_HSS  = OFF_PKV + SZ_T * 16;
constexpr size_t OFF_PH   = OFF_HSS + SZ_T * 64;
constexpr size_t OFF_PF   = OFF_PH + SZ_T * 64;
constexpr size_t OFF_BAR  = OFF_PF + SZ_T * 64;
constexpr size_t WS_END   = OFF_BAR + 16384;

struct Params {
    const float* x; const int* pos; const float* g_attn; const float* w_in; const float* g_qa; const float* w_qb;
    const float* g_kva; const float* w_kvb; const float* g_sbo; const float* g_mlao; const float* w_o; const float* g_mlp;
    const float* w_up; const float* w_down; const float* g_final;
    float* out; unsigned char* ws;
};

__device__ const float INV_FREQ[32] = {
    1.000000000e+00f, 7.498942018e-01f, 5.623413324e-01f, 4.216965139e-01f, 3.162277639e-01f, 2.371373773e-01f, 1.778279394e-01f, 1.333521456e-01f,
    1.000000015e-01f, 7.498942316e-02f, 5.623413250e-02f, 4.216964915e-02f, 3.162277490e-02f, 2.371373773e-02f, 1.778279431e-02f, 1.333521400e-02f,
    9.999999776e-03f, 7.498942316e-03f, 5.623413250e-03f, 4.216964822e-03f, 3.162277630e-03f, 2.371373819e-03f, 1.778279431e-03f, 1.333521446e-03f,
    1.000000047e-03f, 7.498941850e-04f, 5.623413017e-04f, 4.216965172e-04f, 3.162277571e-04f, 2.371373703e-04f, 1.778279402e-04f, 1.333521504e-04f};

DI unsigned pk2(float lo, float hi) { f32x2 v = {lo, hi}; bf2_t r = __builtin_convertvector(v, bf2_t); return __builtin_bit_cast(unsigned, r); }
DI u32x4 pack8(f32x4 a, f32x4 b) { u32x4 o; o.x = pk2(a.x, a.y); o.y = pk2(a.z, a.w); o.z = pk2(b.x, b.y); o.w = pk2(b.z, b.w); return o; }
DI void unpack8(u32x4 w, f32x4& a, f32x4& b) {
    a.x = __uint_as_float(w.x << 16); a.y = __uint_as_float(w.x & 0xffff0000u); a.z = __uint_as_float(w.y << 16); a.w = __uint_as_float(w.y & 0xffff0000u);
    b.x = __uint_as_float(w.z << 16); b.y = __uint_as_float(w.z & 0xffff0000u); b.z = __uint_as_float(w.w << 16); b.w = __uint_as_float(w.w & 0xffff0000u);
}
DI float sum4(f32x4 v) { return (v.x + v.y) + (v.z + v.w); }
DI float sq4(f32x4 v) { return (v.x * v.x + v.y * v.y) + (v.z * v.z + v.w * v.w); }
DI float wave_sum(float v) {
#pragma unroll
    for (int o = 1; o < 64; o <<= 1) v += __shfl_xor(v, o);
    return v;
}
DI f32x16 zero16() { f32x16 z; for (int i = 0; i < 16; ++i) z[i] = 0.f; return z; }
DI const char* uptr(const char* p) {
    const unsigned long long u = (unsigned long long)p;
    const unsigned lo = __builtin_amdgcn_readfirstlane((unsigned)u), hi = __builtin_amdgcn_readfirstlane((unsigned)(u >> 32));
    return (const char*)(((unsigned long long)hi << 32) | lo);
}
DI int fresh_tid(int wid_s) {
    int l; asm volatile("v_mbcnt_lo_u32_b32 %0, -1, 0\n\tv_mbcnt_hi_u32_b32 %0, -1, %0" : "=v"(l));
    return wid_s * 64 + l;
}
typedef unsigned u32x2p __attribute__((ext_vector_type(2)));
DI void xhalf(float x, float& lo, float& hi) { const u32x2p r = __builtin_amdgcn_permlane32_swap(__float_as_uint(x), __float_as_uint(x), false, false); lo = __uint_as_float(r.x); hi = __uint_as_float(r.y); }
DI float xhalf_max(float x) { float lo, hi; xhalf(x, lo, hi); return fmaxf(lo, hi); }
DI float xhalf_sum(float x) { float lo, hi; xhalf(x, lo, hi); return lo + hi; }
#define MFMA32(a, b, c) __builtin_amdgcn_mfma_f32_32x32x16_bf16((a), (b), (c), 0, 0, 0)

DI void p0_weight_item(const Params& p, LAS float* scr, int mid, int t, int lane) {
    const float* W; int K, N, Kpad; bf16_t* out;
    switch (mid) {
        case 0:  W = p.w_in;   K = 1024; N = 1984; Kpad = 1024; out = (bf16_t*)(p.ws + OFF_WIN); break;
        case 1:  W = p.w_qb;   K = 256;  N = 768;  Kpad = 256;  out = (bf16_t*)(p.ws + OFF_WQB); break;
        case 2:  W = p.w_kvb;  K = 128;  N = 1024; Kpad = 256;  out = (bf16_t*)(p.ws + OFF_WKVB); break;
        case 3:  W = p.w_o;    K = 1024; N = 1024; Kpad = 1024; out = (bf16_t*)(p.ws + OFF_WO); break;
        case 4:  W = p.w_up;   K = 1024; N = 4096; Kpad = 1024; out = (bf16_t*)(p.ws + OFF_WUP); break;
        default: W = p.w_down; K = 4096; N = 1024; Kpad = 4096; out = (bf16_t*)(p.ws + OFF_WDN); break;
    }
    const int nkt = Kpad / 64, k0 = (t % nkt) * 64, n0 = (t / nkt) * 32;
    const int nn = lane & 31, no = n0 + nn;
    int src = no; float sc = 1.f;
    if (mid == 0) {
        if (no < 512) sc = -0.125f * LOG2E;
        else if (no >= 1920) { if (no < 1984) { const int pp = no - 1920; src = 1920 + ((pp >> 2) & 1) * 32 + 4 * (pp >> 3) + (pp & 3); } else src = -1; }
    } else if (mid == 1) {
        sc = MLA_QSCALE;
        if (no < 512) src = (no >> 7) * 192 + (no & 127);
        else { const int q = no - 512, hd = q >> 6, pp = q & 63; src = hd * 192 + 128 + ((pp >> 2) & 1) * 32 + 4 * (pp >> 3) + (pp & 3); }
    }
#pragma unroll 8
    for (int i = 0; i < 32; ++i) {
        const int kk = 2 * i + (lane >> 5), k = k0 + kk;
        float gv = 1.f; bool ok = src >= 0;
        if (mid == 0) gv = p.g_attn[k];
        else if (mid == 1) gv = p.g_qa[k];
        else if (mid == 2) { if (k >= K) ok = false; else gv = p.g_kva[k]; }
        else if (mid == 3) gv = (k < 512) ? p.g_sbo[k] : p.g_mlao[k - 512];
        else if (mid == 4) gv = p.g_mlp[k];
        float val = 0.f;
        if (ok) val = W[(size_t)k * N + src] * gv * sc;
        scr[kk * 33 + nn] = val;
    }
    asm volatile("s_waitcnt lgkmcnt(0)" ::: "memory");
    {
        const int c = lane & 7;
#pragma unroll
        for (int j = 0; j < 4; ++j) {
            const int n = (lane >> 3) + 8 * j; const LAS float* sp = scr + (8 * c) * 33 + n;
            u32x4 o; o.x = pk2(sp[0], sp[33]); o.y = pk2(sp[2 * 33], sp[3 * 33]); o.z = pk2(sp[4 * 33], sp[5 * 33]); o.w = pk2(sp[6 * 33], sp[7 * 33]);
            *(u32x4*)(out + (size_t)(n0 + n) * Kpad + k0 + 8 * c) = o;
        }
    }
    asm volatile("s_waitcnt lgkmcnt(0)" ::: "memory");
}

DI void phase0(const Params& p, LAS unsigned char* lds, int tid) {
    const int G = gridDim.x, blk = blockIdx.x;
    const int wid = tid >> 6, lane = tid & 63;
    {
        LAS float* scr = (LAS float*)(lds + wid * 8448);
        constexpr int C0 = 1024, C1 = C0 + 96, C2 = C1 + 128, C3 = C2 + 512, C4 = C3 + 2048, C5 = C4 + 2048;
        for (int it = blk * 8 + wid; it < C5; it += G * 8) {
            if (it < C0) p0_weight_item(p, scr, 0, it, lane);
            else if (it < C1) p0_weight_item(p, scr, 1, it - C0, lane);
            else if (it < C2) p0_weight_item(p, scr, 2, it - C1, lane);
            else if (it < C3) p0_weight_item(p, scr, 3, it - C2, lane);
            else if (it < C4) p0_weight_item(p, scr, 4, it - C3, lane);
            else p0_weight_item(p, scr, 5, it - C4, lane);
        }
    }
    float* rsx = (float*)(p.ws + OFF_RSX);
    bf16_t* xb = (bf16_t*)(p.ws + OFF_XB);
    f32x2* cs = (f32x2*)(p.ws + OFF_CS);
    int cidx = blk * 512 + tid;
    int posv = p.pos[cidx >> 5];
    for (int row = blk * 8 + wid; row < T_; row += G * 8) {
        const f32x4* xr = (const f32x4*)(p.x + (size_t)row * 1024) + lane;
        f32x4 v[4]; float s = 0.f;
#pragma unroll
        for (int j = 0; j < 4; ++j) v[j] = xr[64 * j];
        f32x2 cv; const bool docs = cidx < T_ * 32;
        if (docs) {
            const int i = cidx & 31;
            const float ang = (float)posv * INV_FREQ[i];
            const double rev = (double)ang * 0.15915494309189535;
            const float fr = (float)(rev - __builtin_rint(rev));
            cv.x = __builtin_amdgcn_cosf(fr); cv.y = __builtin_amdgcn_sinf(fr);
        }
#pragma unroll
        for (int j = 0; j < 4; ++j) s += sq4(v[j]);
        s = wave_sum(s);
        if (lane == 0) rsx[row] = rsqrtf(s * (1.f / 1024.f) + EPS_);
        u32x2* o = (u32x2*)(xb + (size_t)row * 1024) + lane;
#pragma unroll
        for (int j = 0; j < 4; ++j) { u32x2 w; w.x = pk2(v[j].x, v[j].y); w.y = pk2(v[j].z, v[j].w); o[64 * j] = w; }
        if (docs) { cs[cidx] = cv; cidx += G * 512; if (cidx < T_ * 32) posv = p.pos[cidx >> 5]; }
    }
    for (; cidx < T_ * 32; cidx += G * 512) {
        const int t = cidx >> 5, i = cidx & 31;
        const float ang = (float)p.pos[t] * INV_FREQ[i];
        const double rev = (double)ang * 0.15915494309189535;
        const float fr = (float)(rev - __builtin_rint(rev));
        f32x2 v; v.x = __builtin_amdgcn_cosf(fr); v.y = __builtin_amdgcn_sinf(fr);
        cs[cidx] = v;
    }
}

namespace g8 {
constexpr int BM = 256, BK = 64, HALF = 128, HTB = HALF * BK * 2, STAGE_BYTES = 8 * HTB, NXCD = 8, WGM = 8;
DI int lds_byte(int r, int c) { const int st = (r >> 4) * 2 + (c >> 5), rr = r & 15, cc = c & 31, ob = rr * 64 + cc * 2; return st * 1024 + (ob ^ (((ob >> 9) & 1) << 5)); }
DI void stage_rc(int b, int& R, int& C) { const int st = b / 1024, sb = b % 1024, swz = sb ^ (((sb >> 9) & 1) << 5); R = (st >> 1) * 16 + swz / 64; C = (st & 1) * 32 + (swz % 64) / 2; }
DI int perm32(int rho) { const int n = rho >> 4, i = rho & 15; return 8 * (i >> 2) + 4 * n + (i & 3); }
struct Unit { int pm, pn, kh; };

template <int NKH, int ROT = 0>
DI bool next_unit(int i, int nM, int nN, Unit& u) {
    const int ti = i / NKH; u.kh = i % NKH;
    const int nwg = nM * nN;
    const long L = (long)ti * gridDim.x + blockIdx.x; if (L >= nwg) return false;
    int wgid = (int)L; { const int q = nwg / NXCD, r = nwg % NXCD, xcd = wgid % NXCD, off = wgid / NXCD; wgid = (xcd < r ? xcd * (q + 1) : r * (q + 1) + (xcd - r) * q) + off; }
    const int nig = WGM * nN, gid = wgid / nig, fm = gid * WGM, gsz = (nM - fm) < WGM ? (nM - fm) : WGM;
    u.pm = fm + ((wgid % nig) % gsz); u.pn = (wgid % nig) / gsz;
    if (ROT) u.pn = (u.pn & 4) | ((u.pn + (ti >> 1)) & 3);
    return true;
}

struct NoPre { DI void operator()() const {} };
template <int NKH, int ROT = 0, class Epi, class Pre = NoPre>
DI void gemm_phase(LAS unsigned char* lds, int wid_s, const bf16_t* A, int lda, const bf16_t* Bt, int ldb, int M, int N, int Kc, const Epi& E, const Pre& pre = Pre()) {
    const int tid = fresh_tid(wid_s);
    const int wid = __builtin_amdgcn_readfirstlane(tid >> 6), lane = tid & 63, wr = wid >> 2, wc = wid & 3, fr = lane & 15, fq = lane >> 4;
    const int nt = Kc / BK, nM = M / BM, nN = N / BM;
    unsigned voffA[2], voffB[2];
#pragma unroll
    for (int i = 0; i < 2; ++i) { int R, C; stage_rc(tid * 16 + i * 8192, R, C); const int Rb = (R & ~31) + perm32(R & 31);
        voffA[i] = (unsigned)(R * lda + C) * 2u; voffB[i] = (unsigned)(Rb * ldb + C) * 2u; }
    const size_t kstep = (size_t)(BK * 2);
    const size_t hstepA = (size_t)HALF * lda * 2, hstepB = (size_t)HALF * ldb * 2;
    const size_t tstepA = 2 * hstepA, tstepB = 2 * hstepB, kchunk = (size_t)Kc * 2;
    const unsigned ldsw = (unsigned)wid * 1024u;
    const int aoff = lds_byte(wr * 64 + fr, fq * 8), boff = lds_byte(wc * 32 + fr, fq * 8);
#define G8_SA(b, h) (((b) * 2 + (h)) * HTB)
#define G8_SB(b, h) ((4 + (b) * 2 + (h)) * HTB)
#define G8_STAGE(bufoff, gbase, voff) do { const char* _gb = uptr((const char*)(gbase)); _Pragma("unroll") for (int _i = 0; _i < 2; ++_i) \
        __builtin_amdgcn_global_load_lds((const unsigned*)(_gb + (voff)[_i]), (LAS unsigned*)(lds + (bufoff) + ldsw + _i * 8192), 16, 0, 0); } while (0)
#define G8_LDA(dst, b, h) do { _Pragma("unroll") for (int m = 0; m < 4; ++m) _Pragma("unroll") for (int k = 0; k < 2; ++k) dst[m][k] = *(const LAS bf16x8*)(lds + G8_SA(b, h) + aoff + m * 2048 + k * 1024); } while (0)
#define G8_LDB(dst, b, h) do { _Pragma("unroll") for (int n = 0; n < 2; ++n) _Pragma("unroll") for (int k = 0; k < 2; ++k) dst[n][k] = *(const LAS bf16x8*)(lds + G8_SB(b, h) + boff + n * 2048 + k * 1024); } while (0)
#define G8_MMA(ai, bj, At, Bt_) do { __builtin_amdgcn_s_setprio(1); _Pragma("unroll") for (int m = 0; m < 4; ++m) _Pragma("unroll") for (int n = 0; n < 2; ++n) _Pragma("unroll") for (int k = 0; k < 2; ++k) \
        acc[ai][bj][m][n] = __builtin_amdgcn_mfma_f32_16x16x32_bf16(Bt_[n][k], At[m][k], acc[ai][bj][m][n], 0, 0, 0); __builtin_amdgcn_s_setprio(0); } while (0)
#define G8_WAIT_V(n) asm volatile("s_waitcnt vmcnt(" #n ")" ::: "memory")
#define G8_WAIT_L(n) asm volatile("s_waitcnt lgkmcnt(" #n ")" ::: "memory")
#define G8_BAR __builtin_amdgcn_s_barrier()
#define G8_SCHED __builtin_amdgcn_sched_barrier(0)
    Unit cur, nxt; int ui = 0;
    if (!next_unit<NKH, ROT>(0, nM, nN, cur)) return;
    f32x4 acc[2][2][4][2];
#pragma unroll
    for (int a = 0; a < 2; ++a)
#pragma unroll
        for (int b = 0; b < 2; ++b)
#pragma unroll
            for (int m = 0; m < 4; ++m)
#pragma unroll
                for (int n = 0; n < 2; ++n) acc[a][b][m][n] = (f32x4){0.f, 0.f, 0.f, 0.f};
    bf16x8 At[4][2], B0[2][2], B1[2][2];
    const char* cA = uptr((const char*)A + (size_t)cur.pm * tstepA + (size_t)cur.kh * kchunk + E.a_off(cur.pn));
    const char* cB = uptr((const char*)Bt + (size_t)cur.pn * tstepB + (size_t)cur.kh * kchunk);
    G8_STAGE(G8_SB(0, 0), cB, voffB); G8_STAGE(G8_SA(0, 0), cA, voffA); G8_STAGE(G8_SB(0, 1), cB + hstepB, voffB); G8_STAGE(G8_SA(0, 1), cA + hstepA, voffA);
    pre();
    if (wr == 1) G8_BAR;
    G8_WAIT_V(4); G8_BAR;
    G8_STAGE(G8_SB(1, 0), cB + kstep, voffB); G8_STAGE(G8_SA(1, 0), cA + kstep, voffA); G8_STAGE(G8_SB(1, 1), cB + hstepB + kstep, voffB);
    G8_WAIT_V(6); G8_BAR;
    for (;;) {
        const bool has_next = next_unit<NKH, ROT>(ui + 1, nM, nN, nxt);
        const char* nA = uptr(has_next ? (const char*)A + (size_t)nxt.pm * tstepA + (size_t)nxt.kh * kchunk + E.a_off(nxt.pn) : cA);
        const char* nB = uptr(has_next ? (const char*)Bt + (size_t)nxt.pn * tstepB + (size_t)nxt.kh * kchunk : cB);
        for (int t = 0; t < nt; t += 2) {
            const bool last = (t == nt - 2);
            const char* a1 = cA + (size_t)(t + 1) * kstep;
            const char* a2 = last ? nA : cA + (size_t)(t + 2) * kstep; const char* b2 = last ? nB : cB + (size_t)(t + 2) * kstep;
            const char* a3 = a2 + kstep; const char* b3 = b2 + kstep;
            G8_LDB(B0, 0, 0); G8_SCHED; G8_LDA(At, 0, 0); G8_STAGE(G8_SA(1, 1), a1 + hstepA, voffA);
            G8_WAIT_L(8); G8_BAR; G8_WAIT_L(0); G8_MMA(0, 0, At, B0); G8_BAR; G8_SCHED;
            G8_LDB(B1, 0, 1); G8_STAGE(G8_SB(0, 0), b2, voffB);
            G8_BAR; G8_WAIT_L(0); G8_MMA(0, 1, At, B1); G8_BAR;
            G8_LDA(At, 0, 1); G8_STAGE(G8_SA(0, 0), a2, voffA);
            G8_BAR; G8_WAIT_L(0); G8_MMA(1, 0, At, B0); G8_BAR; G8_SCHED;
            G8_STAGE(G8_SB(0, 1), b2 + hstepB, voffB);
            G8_WAIT_V(6); G8_BAR; G8_MMA(1, 1, At, B1); G8_BAR;
            G8_LDB(B0, 1, 0); G8_SCHED; G8_LDA(At, 1, 0); G8_STAGE(G8_SA(0, 1), a2 + hstepA, voffA);
            G8_WAIT_L(8); G8_BAR; G8_WAIT_L(0); G8_MMA(0, 0, At, B0); G8_BAR; G8_SCHED;
            G8_LDB(B1, 1, 1); G8_STAGE(G8_SB(1, 0), b3, voffB);
            G8_BAR; G8_WAIT_L(0); G8_MMA(0, 1, At, B1); G8_BAR;
            G8_LDA(At, 1, 1); G8_STAGE(G8_SA(1, 0), a3, voffA);
            G8_BAR; G8_WAIT_L(0); G8_MMA(1, 0, At, B0); G8_BAR; G8_SCHED;
            G8_STAGE(G8_SB(1, 1), b3 + hstepB, voffB);
            G8_WAIT_V(6); G8_BAR; G8_MMA(1, 1, At, B1); G8_BAR;
        }
        { int l2 = lane; asm volatile("" : "+v"(l2)); E(acc, cur, wr, wc, l2 & 15, l2 >> 4); }
        if (!has_next) break;
        if (cur.kh == NKH - 1) {
#pragma unroll
            for (int a = 0; a < 2; ++a)
#pragma unroll
                for (int b = 0; b < 2; ++b)
#pragma unroll
                    for (int m = 0; m < 4; ++m)
#pragma unroll
                        for (int n = 0; n < 2; ++n) acc[a][b][m][n] = (f32x4){0.f, 0.f, 0.f, 0.f};
        }
        cur = nxt; cA = nA; cB = nB; ++ui;
    }
    G8_WAIT_V(0);
    if (wr == 0) G8_BAR;
    G8_BAR;
#undef G8_SA
#undef G8_SB
#undef G8_STAGE
#undef G8_LDA
#undef G8_LDB
#undef G8_MMA
#undef G8_WAIT_V
#undef G8_WAIT_L
#undef G8_BAR
#undef G8_SCHED
}
}
using g8::Unit;
typedef f32x4 AccT[2][2][4][2];

DI void rope8(f32x4& v0, f32x4& v1, const f32x4 ca, const f32x4 cb) {
    f32x4 o1, o2;
    o1.x = v0.x * ca.x - v1.x * ca.y; o2.x = v1.x * ca.x + v0.x * ca.y;
    o1.y = v0.y * ca.z - v1.y * ca.w; o2.y = v1.y * ca.z + v0.y * ca.w;
    o1.z = v0.z * cb.x - v1.z * cb.y; o2.z = v1.z * cb.x + v0.z * cb.y;
    o1.w = v0.w * cb.z - v1.w * cb.w; o2.w = v1.w * cb.z + v0.w * cb.w;
    v0 = o1; v1 = o2;
}
DI void store_tr8(bf16_t* base, f32x4 v0, f32x4 v1) {
    base[0 * S_] = (bf16_t)pk2(v0.x, 0.f); base[1 * S_] = (bf16_t)pk2(v0.y, 0.f); base[2 * S_] = (bf16_t)pk2(v0.z, 0.f); base[3 * S_] = (bf16_t)pk2(v0.w, 0.f);
    base[4 * S_] = (bf16_t)pk2(v1.x, 0.f); base[5 * S_] = (bf16_t)pk2(v1.y, 0.f); base[6 * S_] = (bf16_t)pk2(v1.z, 0.f); base[7 * S_] = (bf16_t)pk2(v1.w, 0.f);
}

template <class F>
DI void fill_row_tables(LAS float* tab, int wid_s, const F& f) {
    const int t2 = fresh_tid(wid_s), bx = blockIdx.x & 7, bj8 = (blockIdx.x >> 3) & 7;
    for (int idx = t2; idx < 1024; idx += 512) {
        const int row = (8 * (4 * bx + (idx >> 8)) + bj8) * 256 + (idx & 255);
        const f32x2 v = f(row); tab[idx] = v.x; tab[1024 + idx] = v.y;
    }
    __syncthreads();
}
template <class F> struct TabFill {
    LAS float* tab; int wid_s; F f;
    DI void operator()() const {
        const int t2 = fresh_tid(wid_s), bx = blockIdx.x & 7, bj8 = (blockIdx.x >> 3) & 7;
        for (int idx = t2; idx < 1024; idx += 512) {
            const int row = (8 * (4 * bx + (idx >> 8)) + bj8) * 256 + (idx & 255);
            const f32x2 v = f(row); tab[idx] = v.x; tab[1024 + idx] = v.y;
        }
    }
};
struct RowRsx { const float* rsx; DI f32x2 operator()(int row) const { f32x2 v; v.x = rsx[row]; v.y = 0.f; return v; } };
struct RowQKV { const float* pq; const float* pkv; DI f32x2 operator()(int row) const { f32x2 v;
    v.x = rsqrtf(sum4(*(const f32x4*)(pq + (size_t)row * 4)) * (1.f / 256.f) + EPS_); v.y = rsqrtf(sum4(*(const f32x4*)(pkv + (size_t)row * 4)) * (1.f / 128.f) + EPS_); return v; } };
struct RowOut { const float* hss; DI f32x2 operator()(int row) const { const float* hp = hss + (size_t)row * 16; f32x2 v;
    const float rml = rsqrtf(sum4(*(const f32x4*)(hp + 8)) * (1.f / 512.f) + EPS_), rsb = rsqrtf((sum4(*(const f32x4*)hp) + sum4(*(const f32x4*)(hp + 4))) * (1.f / 512.f) + EPS_);
    v.x = rsb / rml; v.y = rml; return v; } };
struct RowUp { const float* ph; DI f32x2 operator()(int row) const { const f32x4* pp = (const f32x4*)(ph + (size_t)row * 16); f32x2 v;
    v.x = rsqrtf(((sum4(pp[0]) + sum4(pp[1])) + (sum4(pp[2]) + sum4(pp[3]))) * (1.f / 1024.f) + EPS_); v.y = 0.f; return v; } };
#define EPI_TAB(tab, which, i) ((tab)[(which) * 1024 + ((u.pm >> 3) & 3) * 256 + wr * 64 + fr + ((i) >> 2) * 128 + ((i) & 3) * 16])
#define EPI_ROW(ai, m) (u.pm * 256 + (ai) * 128 + wr * 64 + (m) * 16 + fr)
struct EpiProj {
    DI int a_off(int) const { return 0; }
    const LAS float* tab; const float* cs; bf16_t* proj; bf16_t* vst; float* pq; float* pkv;
    DI void operator()(AccT& acc, const Unit& u, int wr, int wc, int fr, int fq) const {
        const int pn = u.pn;
        float rsv[8];
#pragma unroll
        for (int i = 0; i < 8; ++i) rsv[i] = EPI_TAB(tab, 0, i);
        const bool do_rope = (pn == 7 && wc < 2);
        f32x4 rca[8], rcb[8];
        if (do_rope) {
#pragma unroll
            for (int i = 0; i < 8; ++i) { const float* cr = cs + (size_t)EPI_ROW(i >> 2, i & 3) * 64 + 2 * (16 * wc + 4 * fq); rca[i] = *(const f32x4*)cr; rcb[i] = *(const f32x4*)(cr + 4); }
        }
#pragma unroll
        for (int ai = 0; ai < 2; ++ai)
#pragma unroll
            for (int m = 0; m < 4; ++m) {
                const int row = EPI_ROW(ai, m);
                const float rs = rsv[ai * 4 + m]; float ss = 0.f;
#pragma unroll
                for (int bj = 0; bj < 2; ++bj) {
                    f32x4 v0 = acc[ai][bj][m][0] * rs, v1 = acc[ai][bj][m][1] * rs;
                    const int cl = bj * 128 + wc * 32 + fq * 8;
                    if (do_rope && bj == 1) rope8(v0, v1, rca[ai * 4 + m], rcb[ai * 4 + m]);
                    if (pn == 6 || (pn == 7 && bj == 0)) ss += sq4(v0) + sq4(v1);
                    if (pn == 4 || pn == 5) {
                        const int dg = (pn - 4) * 256 + cl, hd = dg >> 6, d = dg & 63, b = row >> 12, s = row & 4095;
                        store_tr8(vst + ((size_t)(b * 8 + hd) * 64 + d) * S_ + s, v0, v1);
                    } else {
                        *(u32x4*)(proj + (size_t)row * 2048 + pn * 256 + cl) = pack8(v0, v1);
                    }
                }
                if (pn >= 6) { ss += __shfl_xor(ss, 16); ss = xhalf_sum(ss); if (fq == 0) (pn == 6 ? pq : pkv)[(size_t)row * 4 + wc] = ss; }
            }
    }
};
struct EpiQKV {
    const LAS float* tab; const float* cs; bf16_t* qn; bf16_t* qr; bf16_t* kn; bf16_t* vmt;
    DI int a_off(int pn) const { return pn >= 3 ? 512 : 0; }
    DI void operator()(AccT& acc, const Unit& u, int wr, int wc, int fr, int fq) const {
        const int pn = u.pn;
        const int wh = pn < 3 ? 0 : 1;
        float rsv[8];
#pragma unroll
        for (int i = 0; i < 8; ++i) rsv[i] = EPI_TAB(tab, wh, i);
        f32x4 rca[8], rcb[8];
        if (pn == 2) {
#pragma unroll
            for (int i = 0; i < 8; ++i) { const float* cr = cs + (size_t)EPI_ROW(i >> 2, i & 3) * 64 + 2 * (4 * ((((wc & 1) * 32 + fq * 8)) >> 3)); rca[i] = *(const f32x4*)cr; rcb[i] = *(const f32x4*)(cr + 4); }
        }
#pragma unroll
        for (int ai = 0; ai < 2; ++ai)
#pragma unroll
            for (int m = 0; m < 4; ++m) {
                const int row = EPI_ROW(ai, m);
                const float rs = rsv[ai * 4 + m];
                if (pn < 3) {
#pragma unroll
                    for (int bj = 0; bj < 2; ++bj) {
                        f32x4 v0 = acc[ai][bj][m][0] * rs, v1 = acc[ai][bj][m][1] * rs;
                        const int cl = bj * 128 + wc * 32 + fq * 8;
                        if (pn < 2) *(u32x4*)(qn + (size_t)row * 512 + pn * 256 + cl) = pack8(v0, v1);
                        else { rope8(v0, v1, rca[ai * 4 + m], rcb[ai * 4 + m]); *(u32x4*)(qr + (size_t)row * 256 + cl) = pack8(v0, v1); }
                    }
                } else {
                    const int hd = pn - 3;
                    const int cl = wc * 32 + fq * 8, b = row >> 12, s = row & 4095;
                    { f32x4 v0 = acc[ai][0][m][0] * rs, v1 = acc[ai][0][m][1] * rs; *(u32x4*)(kn + (size_t)row * 512 + hd * 128 + cl) = pack8(v0, v1); }
                    { f32x4 v0 = acc[ai][1][m][0] * rs, v1 = acc[ai][1][m][1] * rs; store_tr8(vmt + ((size_t)(b * 4 + hd) * 128 + cl) * S_ + s, v0, v1); }
                }
            }
    }
};
struct EpiOut {
    DI int a_off(int) const { return 0; }
    const LAS float* tab; const bf16_t* xb; bf16_t* h1b; float* ph;
    DI void operator()(AccT& acc, const Unit& u, int wr, int wc, int fr, int fq) const {
        float rsv[8];
        const int wh = u.kh == 0 ? 0 : 1;
#pragma unroll
        for (int i = 0; i < 8; ++i) rsv[i] = EPI_TAB(tab, wh, i);
        if (u.kh == 0) {
#pragma unroll
            for (int ai = 0; ai < 2; ++ai)
#pragma unroll
                for (int m = 0; m < 4; ++m)
#pragma unroll
                    for (int bj = 0; bj < 2; ++bj) { acc[ai][bj][m][0] *= rsv[ai * 4 + m]; acc[ai][bj][m][1] *= rsv[ai * 4 + m]; }
            return;
        }
        u32x4 res[8][2];
#pragma unroll
        for (int i = 0; i < 8; ++i)
#pragma unroll
            for (int bj = 0; bj < 2; ++bj) res[i][bj] = *(const u32x4*)(xb + (size_t)EPI_ROW(i >> 2, i & 3) * 1024 + u.pn * 256 + bj * 128 + wc * 32 + fq * 8);
#pragma unroll
        for (int ai = 0; ai < 2; ++ai)
#pragma unroll
            for (int m = 0; m < 4; ++m) {
                const int row = EPI_ROW(ai, m);
                const float rml = rsv[ai * 4 + m];
                float ss = 0.f;
#pragma unroll
                for (int bj = 0; bj < 2; ++bj) {
                    const size_t off = (size_t)row * 1024 + u.pn * 256 + bj * 128 + wc * 32 + fq * 8;
                    f32x4 r0, r1; unpack8(res[ai * 4 + m][bj], r0, r1);
                    const f32x4 v0 = acc[ai][bj][m][0] * rml + r0, v1 = acc[ai][bj][m][1] * rml + r1;
                    *(u32x4*)(h1b + off) = pack8(v0, v1);
                    ss += sq4(v0) + sq4(v1);
                }
                ss += __shfl_xor(ss, 16); ss = xhalf_sum(ss);
                if (fq == 0) ph[(size_t)row * 16 + u.pn * 4 + wc] = ss;
            }
    }
};
struct EpiUp {
    DI int a_off(int) const { return 0; }
    const LAS float* rst; bf16_t* hid;
    DI void operator()(AccT& acc, const Unit& u, int wr, int wc, int fr, int fq) const {
        float rsv[8];
#pragma unroll
        for (int i = 0; i < 8; ++i) rsv[i] = EPI_TAB(rst, 0, i);
#pragma unroll
        for (int ai = 0; ai < 2; ++ai)
#pragma unroll
            for (int m = 0; m < 4; ++m) {
                const int row = EPI_ROW(ai, m);
                const float rs = rsv[ai * 4 + m];
#pragma unroll
                for (int bj = 0; bj < 2; ++bj) {
                    f32x4 v0 = acc[ai][bj][m][0] * rs, v1 = acc[ai][bj][m][1] * rs;
#pragma unroll
                    for (int e = 0; e < 4; ++e) { const float a = fmaxf(v0[e], 0.f), b = fmaxf(v1[e], 0.f); v0[e] = a * a; v1[e] = b * b; }
                    *(u32x4*)(hid + (size_t)row * 4096 + u.pn * 256 + bj * 128 + wc * 32 + fq * 8) = pack8(v0, v1);
                }
            }
    }
};
struct EpiDown {
    DI int a_off(int) const { return 0; }
    const bf16_t* h1b; bf16_t* h2b; float* pf;
    DI void operator()(AccT& acc, const Unit& u, int wr, int wc, int fr, int fq) const {
        u32x4 res[8][2];
#pragma unroll
        for (int i = 0; i < 8; ++i)
#pragma unroll
            for (int bj = 0; bj < 2; ++bj) res[i][bj] = *(const u32x4*)(h1b + (size_t)EPI_ROW(i >> 2, i & 3) * 1024 + u.pn * 256 + bj * 128 + wc * 32 + fq * 8);
#pragma unroll
        for (int ai = 0; ai < 2; ++ai)
#pragma unroll
            for (int m = 0; m < 4; ++m) {
                const int row = EPI_ROW(ai, m);
                float ss = 0.f;
#pragma unroll
                for (int bj = 0; bj < 2; ++bj) {
                    const size_t off = (size_t)row * 1024 + u.pn * 256 + bj * 128 + wc * 32 + fq * 8;
                    f32x4 r0, r1; unpack8(res[ai * 4 + m][bj], r0, r1);
                    const f32x4 v0 = acc[ai][bj][m][0] + r0, v1 = acc[ai][bj][m][1] + r1;
                    *(u32x4*)(h2b + off) = pack8(v0, v1);
                    ss += sq4(v0) + sq4(v1);
                }
                ss += __shfl_xor(ss, 16); ss = xhalf_sum(ss);
                if (fq == 0) pf[(size_t)row * 16 + u.pn * 4 + wc] = ss;
            }
    }
};

constexpr int MLA_KROW = 400, MLA_VROW = 144, MLA_KBYTES = 64 * MLA_KROW, MLA_BUF = MLA_KBYTES + 128 * MLA_VROW;

DI void mla_s_softmax(const LAS unsigned char* base, int r, int h, bool is_diag, int lim, const bf16x8 (&qf)[12], f32x16 (&o)[4], float& m_run, float& l_run,
                      bf16x8 (&pf0)[2], bf16x8 (&pf1)[2]) {
    f32x16 s0 = zero16(), s1 = zero16();
    const LAS unsigned char* kp = base + r * MLA_KROW + h * 16;
#pragma unroll
    for (int g = 0; g < 3; ++g) {
        bf16x8 fa[4], fb[4];
#pragma unroll
        for (int j = 0; j < 4; ++j) { fa[j] = *(const LAS bf16x8*)(kp + (4 * g + j) * 32); fb[j] = *(const LAS bf16x8*)(kp + 32 * MLA_KROW + (4 * g + j) * 32); }
        __builtin_amdgcn_sched_barrier(0);
#pragma unroll
        for (int j = 0; j < 4; ++j) { s0 = MFMA32(fa[j], qf[4 * g + j], s0); s1 = MFMA32(fb[j], qf[4 * g + j], s1); }
        __builtin_amdgcn_sched_barrier(0);
    }
    if (is_diag) {
#pragma unroll
        for (int i = 0; i < 16; ++i) { if (16 * h + i > lim) s0[i] = -1e30f; if (32 + 16 * h + i > lim) s1[i] = -1e30f; }
    }
    float mx = fmaxf(s0[0], s1[0]);
#pragma unroll
    for (int i = 1; i < 16; ++i) mx = fmaxf(mx, fmaxf(s0[i], s1[i]));
    mx = xhalf_max(mx);
    const float mnew = fmaxf(m_run, mx);
    if (__builtin_amdgcn_ballot_w64(mnew > m_run + 8.0f) != 0ull) {
        const float alpha = __builtin_amdgcn_exp2f(m_run - mnew);
        l_run *= alpha;
#pragma unroll
        for (int dt = 0; dt < 4; ++dt) o[dt] *= alpha;
        m_run = mnew;
    }
    float ls = 0.f;
#pragma unroll
    for (int i = 0; i < 16; ++i) { s0[i] = __builtin_amdgcn_exp2f(s0[i] - m_run); s1[i] = __builtin_amdgcn_exp2f(s1[i] - m_run); ls += s0[i] + s1[i]; }
    l_run += ls;
#pragma unroll
    for (int s = 0; s < 2; ++s) {
        u32x4 a, c;
        a.x = pk2(s0[8 * s + 0], s0[8 * s + 1]); a.y = pk2(s0[8 * s + 2], s0[8 * s + 3]); a.z = pk2(s0[8 * s + 4], s0[8 * s + 5]); a.w = pk2(s0[8 * s + 6], s0[8 * s + 7]);
        c.x = pk2(s1[8 * s + 0], s1[8 * s + 1]); c.y = pk2(s1[8 * s + 2], s1[8 * s + 3]); c.z = pk2(s1[8 * s + 4], s1[8 * s + 5]); c.w = pk2(s1[8 * s + 6], s1[8 * s + 7]);
        pf0[s] = __builtin_bit_cast(bf16x8, a); pf1[s] = __builtin_bit_cast(bf16x8, c);
    }
}
DI void mla_pv(const LAS unsigned char* base, int r, int h, const bf16x8 (&pf0)[2], const bf16x8 (&pf1)[2], f32x16 (&o)[4]) {
    const LAS unsigned char* vp = base + MLA_KBYTES + r * MLA_VROW + h * 32;
#pragma unroll
    for (int s = 0; s < 2; ++s) {
        bf16x8 va[4], vb[4];
#pragma unroll
        for (int dt = 0; dt < 4; ++dt) { va[dt] = *(const LAS bf16x8*)(vp + dt * 32 * MLA_VROW + s * 16); vb[dt] = *(const LAS bf16x8*)(vp + dt * 32 * MLA_VROW + 64 + s * 16); }
        __builtin_amdgcn_sched_barrier(0);
#pragma unroll
        for (int dt = 0; dt < 4; ++dt) o[dt] = MFMA32(va[dt], pf0[s], o[dt]);
#pragma unroll
        for (int dt = 0; dt < 4; ++dt) o[dt] = MFMA32(vb[dt], pf1[s], o[dt]);
        __builtin_amdgcn_sched_barrier(0);
    }
}

DI void mla_block(const Params& p, LAS unsigned char* lds, int b, int hd, int qb, int tid) {
    asm volatile("" : "+v"(tid));
    const int wu = __builtin_amdgcn_readfirstlane(tid >> 6), lane = tid & 63, r = lane & 31, h = lane >> 5;
    const int q0 = qb * 256 + wu * 32;
    const bf16_t* QN = (const bf16_t*)(p.ws + OFF_QN); const bf16_t* QR = (const bf16_t*)(p.ws + OFF_QR);
    const size_t tok0 = (size_t)b * S_;
    bf16x8 qf[12];
    {
        const size_t qrow = tok0 + q0 + r;
#pragma unroll
        for (int ks = 0; ks < 8; ++ks) qf[ks] = *(const bf16x8*)(QN + qrow * 512 + hd * 128 + ks * 16 + h * 8);
#pragma unroll
        for (int ks = 0; ks < 4; ++ks) qf[8 + ks] = *(const bf16x8*)(QR + qrow * 256 + hd * 64 + ks * 16 + h * 8);
    }
    unsigned goff[6];
#pragma unroll
    for (int j = 0; j < 6; ++j) {
        const int pc = wu + 8 * j; goff[j] = 0;
        if (pc < 25) {
            const int c = pc * 64 + lane, lr = c / 25; int cc = c - lr * 25; if (cc == 24) cc = 0;
            const int k32 = lr & 31, key = (lr & 32) + 16 * ((k32 >> 2) & 1) + (k32 & 3) + 4 * (k32 >> 3);
            const unsigned tok = (unsigned)(b * S_ + key);
            goff[j] = (cc < 16) ? (unsigned)OFF_KN + (tok * 512u + hd * 128 + cc * 8) * 2u : (unsigned)OFF_PROJ + (tok * 2048u + 1920 + (cc - 16) * 8) * 2u;
        } else if (pc < 43) {
            const int c = (pc - 25) * 64 + lane, d = c / 9; int cc = c - d * 9; if (cc == 8) cc = 0;
            goff[j] = (unsigned)OFF_VMT + ((unsigned)((b * 4 + hd) * 128 + d) * (unsigned)S_ + cc * 8) * 2u;
        }
    }
    const char* wsb = uptr((const char*)p.ws);
#define MLA_STAGE(KT, BUF) do { _Pragma("unroll") for (int _j = 0; _j < 6; ++_j) { const int _pc = wu + 8 * _j; if (_pc < 43) { \
        const unsigned _inc = goff[_j] >= (unsigned)OFF_VMT ? 128u : (goff[_j] < (unsigned)OFF_VST ? 262144u : 65536u); \
        __builtin_amdgcn_global_load_lds((const unsigned*)(wsb + (goff[_j] + (unsigned)(KT) * _inc)), (LAS unsigned*)(lds + (BUF) * MLA_BUF + _pc * 1024), 16, 0, 0); } } } while (0)
    f32x16 o[4]; for (int dt = 0; dt < 4; ++dt) o[dt] = zero16();
    float m_run = -1e30f, l_run = 0.f;
    const int ntiles = 4 * qb + 4, wlast = q0 >> 6;
    __syncthreads();
    MLA_STAGE(0, 0);
    const bool late = wu >= 4;
    bf16x8 pf0[2], pf1[2];
    int bcur = 0;
    for (int kt = 0; kt < ntiles; ++kt) {
        asm volatile("s_waitcnt vmcnt(0)" ::: "memory");
        __builtin_amdgcn_s_barrier();
        asm volatile("" ::: "memory");
        const int bprev = bcur == 0 ? 2 : bcur - 1, bnext = bcur == 2 ? 0 : bcur + 1;
        if (kt + 1 < ntiles) MLA_STAGE(kt + 1, bnext);
        if (late && kt >= 1 && kt - 1 <= wlast) mla_pv(lds + bprev * MLA_BUF, r, h, pf0, pf1, o);
        if (kt <= wlast) {
            mla_s_softmax(lds + bcur * MLA_BUF, r, h, kt == wlast, q0 + r - kt * 64, qf, o, m_run, l_run, pf0, pf1);
            if (!late) mla_pv(lds + bcur * MLA_BUF, r, h, pf0, pf1, o);
        }
        bcur = bnext;
    }
    if (late && wlast == ntiles - 1) { const int bprev = bcur == 0 ? 2 : bcur - 1; mla_pv(lds + bprev * MLA_BUF, r, h, pf0, pf1, o); }
#undef MLA_STAGE
    const float lt = xhalf_sum(l_run), inv = 1.f / lt;
    bf16_t* mix = (bf16_t*)(p.ws + OFF_MIX) + (tok0 + q0 + r) * 1024 + 512 + hd * 128 + 4 * h;
    float ss = 0.f;
#pragma unroll
    for (int dt = 0; dt < 4; ++dt)
#pragma unroll
        for (int g = 0; g < 4; ++g) {
            const float a0 = o[dt][4 * g] * inv, a1 = o[dt][4 * g + 1] * inv, a2 = o[dt][4 * g + 2] * inv, a3 = o[dt][4 * g + 3] * inv;
            ss += (a0 * a0 + a1 * a1) + (a2 * a2 + a3 * a3);
            u32x2 w; w.x = pk2(a0, a1); w.y = pk2(a2, a3);
            *(u32x2*)(mix + dt * 32 + 8 * g) = w;
        }
    ss = xhalf_sum(ss);
    if (h == 0) ((float*)(p.ws + OFF_HSS))[(tok0 + q0 + r) * 16 + 8 + hd] = ss;
}

DI void sb_item(const Params& p, int bh, int qb32, int lane) {
    asm volatile("" : "+v"(lane));
    const int r = lane & 31, h = lane >> 5, b = bh >> 3, hd = bh & 7, q0 = qb32 * 32;
    const bf16_t* PROJ = (const bf16_t*)(p.ws + OFF_PROJ);
    const bf16_t* VST = (const bf16_t*)(p.ws + OFF_VST);
    const size_t tok0 = (size_t)b * S_;
    bf16x8 qf[4];
#pragma unroll
    for (int ks = 0; ks < 4; ++ks) qf[ks] = *(const bf16x8*)(PROJ + (tok0 + q0 + r) * 2048 + hd * 64 + ks * 16 + h * 8);
    const int pr = 16 * ((r >> 2) & 1) + (r & 3) + 4 * (r >> 3);
    const bf16_t* kbase = PROJ + (tok0 + pr) * 2048 + 512 + hd * 64 + h * 8;
    const bf16_t* vbase = VST + ((size_t)(b * 8 + hd) * 64 + r) * S_ + 16 * h;
    bf16x8 kc[4], kn[4], vf[4];
#pragma unroll
    for (int ks = 0; ks < 4; ++ks) kc[ks] = *(const bf16x8*)(kbase + (size_t)q0 * 2048 + ks * 16);
    f32x16 o0 = zero16(), o1 = zero16();
    float carry = 1.f;
    for (int kb = q0; kb >= 0; kb -= 32) {
#pragma unroll
        for (int dt = 0; dt < 2; ++dt)
#pragma unroll
            for (int s = 0; s < 2; ++s) vf[dt * 2 + s] = *(const bf16x8*)(vbase + (size_t)dt * 32 * S_ + kb + 8 * s);
        if (kb >= 32) {
#pragma unroll
            for (int ks = 0; ks < 4; ++ks) kn[ks] = *(const bf16x8*)(kbase + (size_t)(kb - 32) * 2048 + ks * 16);
        }
        f32x16 z = zero16();
#pragma unroll
        for (int ks = 0; ks < 4; ++ks) z = MFMA32(kc[ks], qf[ks], z);
        const bool diag = (kb == q0);
        f32x16 a;
        float tot = 1.f;
#pragma unroll
        for (int i = 15; i >= 0; --i) {
            const float w = __builtin_amdgcn_exp2f(fminf(z[i], 86.f));
            float be = __builtin_amdgcn_rcpf(1.f + w);
            float om = w * be;
            if (diag) { const bool valid = (16 * h + i < r); be = valid ? be : 0.f; om = valid ? om : 1.f; }
            a[i] = be * tot;
            tot *= om;
        }
        const float other = __shfl_xor(tot, 32);
        const float base = carry * (h == 0 ? other : 1.f);
        carry *= tot * other;
#pragma unroll
        for (int i = 0; i < 16; ++i) a[i] *= base;
        bf16x8 pf[2];
#pragma unroll
        for (int s = 0; s < 2; ++s) {
            u32x4 w; w.x = pk2(a[8 * s + 0], a[8 * s + 1]); w.y = pk2(a[8 * s + 2], a[8 * s + 3]); w.z = pk2(a[8 * s + 4], a[8 * s + 5]); w.w = pk2(a[8 * s + 6], a[8 * s + 7]);
            pf[s] = __builtin_bit_cast(bf16x8, w);
        }
#pragma unroll
        for (int s = 0; s < 2; ++s) { o0 = MFMA32(vf[s], pf[s], o0); o1 = MFMA32(vf[2 + s], pf[s], o1); }
        if (kb >= 32) {
#pragma unroll
            for (int ks = 0; ks < 4; ++ks) kc[ks] = kn[ks];
        }
        if (__all(carry < SB_PTHR)) break;
    }
    bf16_t* mix = (bf16_t*)(p.ws + OFF_MIX) + (tok0 + q0 + r) * 1024 + hd * 64 + 4 * h;
    float ss = 0.f;
#pragma unroll
    for (int g = 0; g < 4; ++g) {
        { const float a0 = o0[4 * g], a1 = o0[4 * g + 1], a2 = o0[4 * g + 2], a3 = o0[4 * g + 3];
          ss += (a0 * a0 + a1 * a1) + (a2 * a2 + a3 * a3); u32x2 w; w.x = pk2(a0, a1); w.y = pk2(a2, a3); *(u32x2*)(mix + 8 * g) = w; }
        { const float a0 = o1[4 * g], a1 = o1[4 * g + 1], a2 = o1[4 * g + 2], a3 = o1[4 * g + 3];
          ss += (a0 * a0 + a1 * a1) + (a2 * a2 + a3 * a3); u32x2 w; w.x = pk2(a0, a1); w.y = pk2(a2, a3); *(u32x2*)(mix + 32 + 8 * g) = w; }
    }
    ss = xhalf_sum(ss);
    if (h == 0) ((float*)(p.ws + OFF_HSS))[(tok0 + q0 + r) * 16 + hd] = ss;
}

constexpr int SB_ROW = 144, SB_KBYTES = 64 * SB_ROW, SB_BUF = 2 * SB_KBYTES  , SB_NB = 7, SB_FLAGS = SB_NB * SB_BUF;
DI void sb_block(const Params& p, LAS unsigned char* lds, int bh, int qb, int tid) {
    asm volatile("" : "+v"(tid));
    const int wu = __builtin_amdgcn_readfirstlane(tid >> 6), lane = tid & 63, r = lane & 31, h = lane >> 5;
    const int b = bh >> 3, hd = bh & 7, q0 = qb * 256 + wu * 32;
    const bf16_t* PROJ = (const bf16_t*)(p.ws + OFF_PROJ);
    const size_t tok0 = (size_t)b * S_;
    bf16x8 qf[4];
#pragma unroll
    for (int ks = 0; ks < 4; ++ks) qf[ks] = *(const bf16x8*)(PROJ + (tok0 + q0 + r) * 2048 + hd * 64 + ks * 16 + h * 8);
    unsigned goff[3];
#pragma unroll
    for (int j = 0; j < 3; ++j) {
        const int pc = wu + 8 * j; goff[j] = 0;
        if (pc < 18) {
            const int c = (pc < 9 ? pc : pc - 9) * 64 + lane, lr = c / 9; int cc = c - lr * 9; if (cc == 8) cc = 0;
            if (pc < 9) { const int k32 = lr & 31, key = (lr & 32) + 16 * ((k32 >> 2) & 1) + (k32 & 3) + 4 * (k32 >> 3);
                goff[j] = (unsigned)OFF_PROJ + ((unsigned)(b * S_ + key) * 2048u + 512 + hd * 64 + cc * 8) * 2u; }
            else goff[j] = (unsigned)OFF_VST + ((unsigned)((b * 8 + hd) * 64 + lr) * (unsigned)S_ + cc * 8) * 2u;
        }
    }
    const char* wsb = uptr((const char*)p.ws);
#define SB_STAGE(KT, BUF) do { _Pragma("unroll") for (int _j = 0; _j < 3; ++_j) { const int _pc = wu + 8 * _j; if (_pc < 18) { \
        const unsigned _inc = goff[_j] >= (unsigned)OFF_VST ? 128u : 262144u; \
        __builtin_amdgcn_global_load_lds((const unsigned*)(wsb + (goff[_j] + (unsigned)(KT) * _inc)), (LAS unsigned*)(lds + (BUF) * SB_BUF + _pc * 1024), 16, 0, 0); } } } while (0)
    f32x16 o0 = zero16(), o1 = zero16();
    float carry = 1.f;
    bool done = false;
    const int ktop = 4 * qb + 3;
    LAS int* flags = (LAS int*)(lds + SB_FLAGS);
    asm volatile("s_waitcnt vmcnt(0)" ::: "memory");
    __syncthreads();
    const int nstaged = ktop + 1 < SB_NB ? ktop + 1 : SB_NB;
    for (int i = 0; i < nstaged; ++i) SB_STAGE(ktop - i, i);
#define SB_WAITV(n) asm volatile("s_waitcnt vmcnt(" #n ") lgkmcnt(0)" ::: "memory")
    int cur = 0, it = 0;
    for (int kt = ktop; ; --kt, ++it) {
        if (lane == 0) flags[(it & 1) * 8 + wu] = done ? 1 : 0;
        if (it >= SB_NB && kt >= 0) SB_STAGE(kt, cur);
        const int ahead = it < nstaged ? nstaged - 1 - it : 0;
        if (wu < 2) { switch (ahead) { case 0: SB_WAITV(0); break; case 1: SB_WAITV(3); break; case 2: SB_WAITV(6); break; case 3: SB_WAITV(9); break; case 4: SB_WAITV(12); break; case 5: SB_WAITV(15); break; default: SB_WAITV(18); break; } }
        else { switch (ahead) { case 0: SB_WAITV(0); break; case 1: SB_WAITV(2); break; case 2: SB_WAITV(4); break; case 3: SB_WAITV(6); break; case 4: SB_WAITV(8); break; case 5: SB_WAITV(10); break; default: SB_WAITV(12); break; } }
        __builtin_amdgcn_s_barrier();
        asm volatile("" ::: "memory");
        {
            const LAS int* f = flags + (it & 1) * 8;
            const int all = f[0] & f[1] & f[2] & f[3] & f[4] & f[5] & f[6] & f[7];
            if (__builtin_amdgcn_readfirstlane(all)) break;
        }
        if (!done && kt * 64 <= q0) {
            const LAS unsigned char* base = lds + cur * SB_BUF;
#pragma unroll
            for (int sub = 1; sub >= 0; --sub) {
                const int kb = kt * 64 + sub * 32;
                if (kb <= q0 && !done) {
                    const LAS unsigned char* kp = base + (sub * 32 + r) * SB_ROW + h * 16;
                    bf16x8 kf[4], vf[4];
#pragma unroll
                    for (int ks = 0; ks < 4; ++ks) kf[ks] = *(const LAS bf16x8*)(kp + ks * 32);
#pragma unroll
                    for (int dt = 0; dt < 2; ++dt)
#pragma unroll
                        for (int s2 = 0; s2 < 2; ++s2) vf[dt * 2 + s2] = *(const LAS bf16x8*)(base + SB_KBYTES + (dt * 32 + r) * SB_ROW + (sub * 32 + 16 * h + 8 * s2) * 2);
                    f32x16 z = zero16();
#pragma unroll
                    for (int ks = 0; ks < 4; ++ks) z = MFMA32(kf[ks], qf[ks], z);
                    const bool diag = (kb == q0);
                    f32x16 a;
                    float tot = 1.f;
#pragma unroll
                    for (int i = 15; i >= 0; --i) {
                        const float w = __builtin_amdgcn_exp2f(fminf(z[i], 86.f));
                        float be = __builtin_amdgcn_rcpf(1.f + w);
                        float om = w * be;
                        if (diag) { const bool valid = (16 * h + i < r); be = valid ? be : 0.f; om = valid ? om : 1.f; }
                        a[i] = be * tot;
                        tot *= om;
                    }
                    const float other = __shfl_xor(tot, 32);
                    const float bs = carry * (h == 0 ? other : 1.f);
                    carry *= tot * other;
#pragma unroll
                    for (int i = 0; i < 16; ++i) a[i] *= bs;
                    bf16x8 pf[2];
#pragma unroll
                    for (int s2 = 0; s2 < 2; ++s2) {
                        u32x4 w; w.x = pk2(a[8 * s2 + 0], a[8 * s2 + 1]); w.y = pk2(a[8 * s2 + 2], a[8 * s2 + 3]); w.z = pk2(a[8 * s2 + 4], a[8 * s2 + 5]); w.w = pk2(a[8 * s2 + 6], a[8 * s2 + 7]);
                        pf[s2] = __builtin_bit_cast(bf16x8, w);
                    }
#pragma unroll
                    for (int s2 = 0; s2 < 2; ++s2) { o0 = MFMA32(vf[s2], pf[s2], o0); o1 = MFMA32(vf[2 + s2], pf[s2], o1); }
                    if (__all(carry < SB_PTHR)) done = true;
                }
            }
            if (kt == 0) done = true;
        }
        cur = cur == SB_NB - 1 ? 0 : cur + 1;
    }
    asm volatile("s_waitcnt vmcnt(0)" ::: "memory");
#undef SB_WAITV
#undef SB_STAGE
    bf16_t* mix = (bf16_t*)(p.ws + OFF_MIX) + (tok0 + q0 + r) * 1024 + hd * 64 + 4 * h;
    float ss = 0.f;
#pragma unroll
    for (int g = 0; g < 4; ++g) {
        { const float a0 = o0[4 * g], a1 = o0[4 * g + 1], a2 = o0[4 * g + 2], a3 = o0[4 * g + 3];
          ss += (a0 * a0 + a1 * a1) + (a2 * a2 + a3 * a3); u32x2 w; w.x = pk2(a0, a1); w.y = pk2(a2, a3); *(u32x2*)(mix + 8 * g) = w; }
        { const float a0 = o1[4 * g], a1 = o1[4 * g + 1], a2 = o1[4 * g + 2], a3 = o1[4 * g + 3];
          ss += (a0 * a0 + a1 * a1) + (a2 * a2 + a3 * a3); u32x2 w; w.x = pk2(a0, a1); w.y = pk2(a2, a3); *(u32x2*)(mix + 32 + 8 * g) = w; }
    }
    ss = xhalf_sum(ss);
    if (h == 0) ((float*)(p.ws + OFF_HSS))[(tok0 + q0 + r) * 16 + hd] = ss;
}

DI void sb_block2(const Params& p, LAS unsigned char* lds, int bh, int qb2, int tid) {
    asm volatile("" : "+v"(tid));
    const int wu = __builtin_amdgcn_readfirstlane(tid >> 6), lane = tid & 63, r = lane & 31, h = lane >> 5;
    const int b = bh >> 3, hd = bh & 7;
    int q0[2]; q0[0] = qb2 * 512 + wu * 32; q0[1] = q0[0] + 256;
    const bf16_t* PROJ = (const bf16_t*)(p.ws + OFF_PROJ);
    const size_t tok0 = (size_t)b * S_;
    bf16x8 qf[2][4];
#pragma unroll
    for (int g = 0; g < 2; ++g)
#pragma unroll
        for (int ks = 0; ks < 4; ++ks) qf[g][ks] = *(const bf16x8*)(PROJ + (tok0 + q0[g] + r) * 2048 + hd * 64 + ks * 16 + h * 8);
    unsigned goff[3];
#pragma unroll
    for (int j = 0; j < 3; ++j) {
        const int pc = wu + 8 * j; goff[j] = 0;
        if (pc < 18) {
            const int c = (pc < 9 ? pc : pc - 9) * 64 + lane, lr = c / 9; int cc = c - lr * 9; if (cc == 8) cc = 0;
            if (pc < 9) { const int k32 = lr & 31, key = (lr & 32) + 16 * ((k32 >> 2) & 1) + (k32 & 3) + 4 * (k32 >> 3);
                goff[j] = (unsigned)OFF_PROJ + ((unsigned)(b * S_ + key) * 2048u + 512 + hd * 64 + cc * 8) * 2u; }
            else goff[j] = (unsigned)OFF_VST + ((unsigned)((b * 8 + hd) * 64 + lr) * (unsigned)S_ + cc * 8) * 2u;
        }
    }
    const char* wsb = uptr((const char*)p.ws);
#define SB_STAGE(KT, BUF) do { _Pragma("unroll") for (int _j = 0; _j < 3; ++_j) { const int _pc = wu + 8 * _j; if (_pc < 18) { \
        const unsigned _inc = goff[_j] >= (unsigned)OFF_VST ? 128u : 262144u; \
        __builtin_amdgcn_global_load_lds((const unsigned*)(wsb + (goff[_j] + (unsigned)(KT) * _inc)), (LAS unsigned*)(lds + (BUF) * SB_BUF + _pc * 1024), 16, 0, 0); } } } while (0)
    f32x16 o0[2], o1[2]; float carry[2]; bool done[2];
#pragma unroll
    for (int g = 0; g < 2; ++g) { o0[g] = zero16(); o1[g] = zero16(); carry[g] = 1.f; done[g] = false; }
    const int ktop = 8 * qb2 + 7;
    LAS int* flags = (LAS int*)(lds + SB_FLAGS);
    asm volatile("s_waitcnt vmcnt(0)" ::: "memory");
    __syncthreads();
    const int nstaged = ktop + 1 < SB_NB ? ktop + 1 : SB_NB;
    for (int i = 0; i < nstaged; ++i) SB_STAGE(ktop - i, i);
#define SB_WAITV(n) asm volatile("s_waitcnt vmcnt(" #n ") lgkmcnt(0)" ::: "memory")
    int cur = 0, it = 0;
    for (int kt = ktop; ; --kt, ++it) {
        if (lane == 0) flags[(it & 1) * 8 + wu] = (done[0] && done[1]) ? 1 : 0;
        int lowest = ktop - (SB_NB - 1) - (it > 0 ? it - 1 : 0); if (lowest < 0) lowest = 0;
        int ahead = kt - lowest; if (ahead < 0) ahead = 0;
        if (wu < 2) { switch (ahead) { case 0: SB_WAITV(0); break; case 1: SB_WAITV(3); break; case 2: SB_WAITV(6); break; case 3: SB_WAITV(9); break; case 4: SB_WAITV(12); break; case 5: SB_WAITV(15); break; default: SB_WAITV(18); break; } }
        else { switch (ahead) { case 0: SB_WAITV(0); break; case 1: SB_WAITV(2); break; case 2: SB_WAITV(4); break; case 3: SB_WAITV(6); break; case 4: SB_WAITV(8); break; case 5: SB_WAITV(10); break; default: SB_WAITV(12); break; } }
        __builtin_amdgcn_s_barrier();
        asm volatile("" ::: "memory");
        {
            const LAS int* f = flags + (it & 1) * 8;
            const int all = f[0] & f[1] & f[2] & f[3] & f[4] & f[5] & f[6] & f[7];
            if (__builtin_amdgcn_readfirstlane(all)) break;
        }
        if (it >= 1 && kt - (SB_NB - 1) >= 0) SB_STAGE(kt - (SB_NB - 1), cur == 0 ? SB_NB - 1 : cur - 1);
        {
            const LAS unsigned char* base = lds + cur * SB_BUF;
#pragma unroll
            for (int sub = 1; sub >= 0; --sub) {
                const int kb = kt * 64 + sub * 32;
                const LAS unsigned char* kp = base + (sub * 32 + r) * SB_ROW + h * 16;
                const bool act0 = !done[0] && kb <= q0[0], act1 = !done[1] && kb <= q0[1];
                if (act0 || act1) {
                    bf16x8 kf[4], vf[4];
#pragma unroll
                    for (int ks = 0; ks < 4; ++ks) kf[ks] = *(const LAS bf16x8*)(kp + ks * 32);
#pragma unroll
                    for (int dt = 0; dt < 2; ++dt)
#pragma unroll
                        for (int s2 = 0; s2 < 2; ++s2) vf[dt * 2 + s2] = *(const LAS bf16x8*)(base + SB_KBYTES + (dt * 32 + r) * SB_ROW + (sub * 32 + 16 * h + 8 * s2) * 2);
#pragma unroll
                    for (int g = 0; g < 2; ++g) {
                        if (g == 0 ? act0 : act1) {
                            f32x16 z = zero16();
#pragma unroll
                            for (int ks = 0; ks < 4; ++ks) z = MFMA32(kf[ks], qf[g][ks], z);
                            const bool diag = (kb == q0[g]);
                            f32x16 a;
                            float tot = 1.f;
#pragma unroll
                            for (int i = 15; i >= 0; --i) {
                                const float w = __builtin_amdgcn_exp2f(fminf(z[i], 86.f));
                                float be = __builtin_amdgcn_rcpf(1.f + w);
                                float om = w * be;
                                if (diag) { const bool valid = (16 * h + i < r); be = valid ? be : 0.f; om = valid ? om : 1.f; }
                                a[i] = be * tot;
                                tot *= om;
                            }
                            float tlo, thi; xhalf(tot, tlo, thi);
                            const float bs = carry[g] * (h == 0 ? thi : 1.f);
                            carry[g] *= tlo * thi;
#pragma unroll
                            for (int i = 0; i < 16; ++i) a[i] *= bs;
                            bf16x8 pf[2];
#pragma unroll
                            for (int s2 = 0; s2 < 2; ++s2) {
                                u32x4 w; w.x = pk2(a[8 * s2 + 0], a[8 * s2 + 1]); w.y = pk2(a[8 * s2 + 2], a[8 * s2 + 3]); w.z = pk2(a[8 * s2 + 4], a[8 * s2 + 5]); w.w = pk2(a[8 * s2 + 6], a[8 * s2 + 7]);
                                pf[s2] = __builtin_bit_cast(bf16x8, w);
                            }
#pragma unroll
                            for (int s2 = 0; s2 < 2; ++s2) { o0[g] = MFMA32(vf[s2], pf[s2], o0[g]); o1[g] = MFMA32(vf[2 + s2], pf[s2], o1[g]); }
                            if (__all(carry[g] < SB_PTHR)) done[g] = true;
                        }
                    }
                }
            }
            if (kt == 0) { done[0] = true; done[1] = true; }
        }
        cur = cur == SB_NB - 1 ? 0 : cur + 1;
    }
    asm volatile("s_waitcnt vmcnt(0)" ::: "memory");
#undef SB_WAITV
#undef SB_STAGE
#pragma unroll
    for (int g = 0; g < 2; ++g) {
        bf16_t* mix = (bf16_t*)(p.ws + OFF_MIX) + (tok0 + q0[g] + r) * 1024 + hd * 64 + 4 * h;
        float ss = 0.f;
#pragma unroll
        for (int gg = 0; gg < 4; ++gg) {
            { const float a0 = o0[g][4 * gg], a1 = o0[g][4 * gg + 1], a2 = o0[g][4 * gg + 2], a3 = o0[g][4 * gg + 3];
              ss += (a0 * a0 + a1 * a1) + (a2 * a2 + a3 * a3); u32x2 w; w.x = pk2(a0, a1); w.y = pk2(a2, a3); *(u32x2*)(mix + 8 * gg) = w; }
            { const float a0 = o1[g][4 * gg], a1 = o1[g][4 * gg + 1], a2 = o1[g][4 * gg + 2], a3 = o1[g][4 * gg + 3];
              ss += (a0 * a0 + a1 * a1) + (a2 * a2 + a3 * a3); u32x2 w; w.x = pk2(a0, a1); w.y = pk2(a2, a3); *(u32x2*)(mix + 32 + 8 * gg) = w; }
        }
        ss = xhalf_sum(ss);
        if (h == 0) ((float*)(p.ws + OFF_HSS))[(tok0 + q0[g] + r) * 16 + hd] = ss;
    }
}

DI void phase_attention(const Params& p, LAS unsigned char* lds, int tid, int which = 3) {
    const int blk = blockIdx.x, G = gridDim.x;
#ifndef NO_MLA
    if (which & 1) for (int it = blk; it < 512; it += G) {
        const int xcd = it & 7, local = (it >> 3) & 63;
        const int bh = xcd * 8 + (local >> 3), pr = local & 7;
        mla_block(p, lds, bh >> 2, bh & 3, pr, tid);
        mla_block(p, lds, bh >> 2, bh & 3, 15 - pr, tid);
    }
#endif
#ifndef NO_SB
    if (which & 2) for (int it = blk; it < 1024; it += G) {
        const int xcd = it & 7, local = (it >> 3) & 127;
        sb_block2(p, lds, xcd * 16 + (local >> 3), local & 7, tid);
    }
#endif
}

DI void phase_final(const Params& p, int tid) {
    const int wid = tid >> 6, lane = tid & 63;
    const float* pf = (const float*)(p.ws + OFF_PF);
    const bf16_t* h2b = (const bf16_t*)(p.ws + OFF_MIX);
    f32x4 ga[2], gb[2];
#pragma unroll
    for (int j = 0; j < 2; ++j) { ga[j] = *(const f32x4*)(p.g_final + j * 512 + lane * 8); gb[j] = *(const f32x4*)(p.g_final + j * 512 + lane * 8 + 4); }
    for (int row = blockIdx.x * 8 + wid; row < T_; row += gridDim.x * 8) {
        const f32x4* pp = (const f32x4*)(pf + (size_t)row * 16);
        u32x4 w[2];
#pragma unroll
        for (int j = 0; j < 2; ++j) w[j] = *(const u32x4*)(h2b + (size_t)row * 1024 + j * 512 + lane * 8);
        const float rs = rsqrtf(((sum4(pp[0]) + sum4(pp[1])) + (sum4(pp[2]) + sum4(pp[3]))) * (1.f / 1024.f) + EPS_);
        float* orow = p.out + (size_t)row * 1024 + lane * 8;
#pragma unroll
        for (int j = 0; j < 2; ++j) { f32x4 a, b; unpack8(w[j], a, b); *(f32x4*)(orow + j * 512) = a * rs * ga[j]; *(f32x4*)(orow + j * 512 + 4) = b * rs * gb[j]; }
    }
}

#define XB_TMO      128
#define XB_XCNT(j)  (256  + 64 * (j))
#define XB_XSUB(j)  (1280 + 64 * (j))
#define XB_XGEN(j)  (2304 + 64 * (j))
#define XB_TOP      3328
#define XB_TOPGEN   3392
#define XCD_BAR_WORDS 3456
#define XB_SPIN_CAP (1u << 18)
DI unsigned xb_ld(unsigned* p)              { return __hip_atomic_load(p, __ATOMIC_RELAXED, __HIP_MEMORY_SCOPE_AGENT); }
DI unsigned xb_add(unsigned* p, unsigned v) { return __hip_atomic_fetch_add(p, v, __ATOMIC_RELAXED, __HIP_MEMORY_SCOPE_AGENT); }
DI unsigned xb_xcc_id() { return (unsigned)__builtin_amdgcn_s_getreg((3 << 11) | 20) & 0xFu; }
#define XB_SPIN(cond, bar) do { unsigned _sp = 0; while (cond) { __builtin_amdgcn_s_sleep(1); \
    if ((++_sp & 255u) == 0u) { if (xb_ld(&(bar)[XB_TMO])) break; if (_sp > XB_SPIN_CAP) { atomicAdd(&(bar)[XB_TMO], 1u); break; } } } } while (0)
struct XcdBarrier { unsigned* bar; unsigned x; volatile LAS unsigned* st; };
DI XcdBarrier xcd_barrier_post(unsigned* bar, volatile LAS unsigned* st) {
    XcdBarrier b; b.bar = bar; b.x = xb_xcc_id(); b.st = st;
    if (threadIdx.x == 0) (void)xb_add(&bar[XB_XCNT(b.x)], 1u);
    return b;
}
DI void xcd_barrier_complete(unsigned* bar, unsigned x, unsigned& nloc, unsigned& nx) {
    const unsigned G = gridDim.x * gridDim.y * gridDim.z;
    unsigned sum, cnt, mine, sp = 0u;
    for (;;) {
        sum = 0u; cnt = 0u; mine = 0u;
#pragma unroll
        for (unsigned j = 0; j < 16; ++j) { const unsigned c = xb_ld(&bar[XB_XCNT(j)]); sum += c; cnt += (c > 0u) ? 1u : 0u; mine = (j == x) ? c : mine; }
        if (sum == G) break;
        __builtin_amdgcn_s_sleep(1);
        if ((++sp & 255u) == 0u) { if (xb_ld(&bar[XB_TMO])) break; if (sp > XB_SPIN_CAP) { atomicAdd(&bar[XB_TMO], 1u); break; } }
    }
    nloc = mine > 0u ? mine : 1u; nx = cnt > 0u ? cnt : 1u;
}
DI void xcd_barrier(const XcdBarrier& b) {
    asm volatile("s_waitcnt vmcnt(0)" ::: "memory");
    __syncthreads();
    if (threadIdx.x == 0) {
        unsigned* bar = b.bar;
        __builtin_amdgcn_s_waitcnt(0);
        unsigned nloc = b.st[0], nx = b.st[1];
        if (nloc == 0u) { xcd_barrier_complete(bar, b.x, nloc, nx); b.st[0] = nloc; b.st[1] = nx; }
        const unsigned old = xb_add(&bar[XB_XSUB(b.x)], 1u);
        const unsigned gen = old / nloc;
        if (old + 1u == (gen + 1u) * nloc) {
            __builtin_amdgcn_fence(__ATOMIC_RELEASE, "agent");
            asm volatile("s_waitcnt vmcnt(0)" ::: "memory");
            const unsigned og = xb_add(&bar[XB_TOP], 1u);
            const unsigned tg = og / nx;
            if (og + 1u == (tg + 1u) * nx) xb_add(&bar[XB_TOPGEN], 1u);
            else XB_SPIN(xb_ld(&bar[XB_TOPGEN]) == tg, bar);
            __builtin_amdgcn_fence(__ATOMIC_ACQUIRE, "agent");
            xb_add(&bar[XB_XGEN(b.x)], 1u);
            asm volatile("s_waitcnt vmcnt(0)" ::: "memory");
        } else {
            XB_SPIN(xb_ld(&bar[XB_XGEN(b.x)]) == gen, bar);
            __builtin_amdgcn_fence(__ATOMIC_ACQUIRE, "agent");
            asm volatile("s_waitcnt vmcnt(0)" ::: "memory");
        }
    }
    __syncthreads();
}

#ifndef PH_MASK
#define PH_MASK 255
#endif
#ifndef DUP_MASK
#define DUP_MASK 0
#endif
#ifndef DUP_WHICH
#define DUP_WHICH 3
#endif
constexpr int LDS_XB = g8::STAGE_BYTES + 8192;
constexpr int LDS_BYTES = g8::STAGE_BYTES + 8192 + 64;

__global__ void __launch_bounds__(512, 2) hymba_fwd(Params p) {
    extern __shared__ __attribute__((aligned(16))) unsigned char lds_raw[];
    LAS unsigned char* lds = (LAS unsigned char*)lds_raw;
    cg::grid_group grid = cg::this_grid();
    const int wid_s = __builtin_amdgcn_readfirstlane((int)threadIdx.x >> 6);
    unsigned char* ws = p.ws;

    volatile LAS unsigned* xst = (volatile LAS unsigned*)(lds + LDS_XB);
    if (threadIdx.x == 0) { xst[0] = 0u; xst[1] = 0u; }
    __syncthreads();
    const XcdBarrier xb = xcd_barrier_post((unsigned*)(ws + OFF_BAR), xst);
    if (p.out == nullptr) grid.sync();
    if (PH_MASK & 1) phase0(p, lds, fresh_tid(wid_s));
    xcd_barrier(xb);
    if (DUP_MASK & 1) { phase0(p, lds, fresh_tid(wid_s)); xcd_barrier(xb); }
    if (PH_MASK & 2) {
        LAS float* tab = (LAS float*)(lds + g8::STAGE_BYTES);
        EpiProj E{tab, (const float*)(ws + OFF_CS), (bf16_t*)(ws + OFF_PROJ), (bf16_t*)(ws + OFF_VST), (float*)(ws + OFF_PQ), (float*)(ws + OFF_PKV)};
        g8::gemm_phase<1, 1>(lds, wid_s, (const bf16_t*)(ws + OFF_XB), 1024, (const bf16_t*)(ws + OFF_WIN), 1024, T_, 2048, 1024, E, TabFill<RowRsx>{tab, wid_s, RowRsx{(const float*)(ws + OFF_RSX)}});
    }
    xcd_barrier(xb);
    if (PH_MASK & 4) {
        LAS float* tab = (LAS float*)(lds + g8::STAGE_BYTES);
        EpiQKV E{tab, (const float*)(ws + OFF_CS), (bf16_t*)(ws + OFF_QN), (bf16_t*)(ws + OFF_QR), (bf16_t*)(ws + OFF_KN), (bf16_t*)(ws + OFF_VMT)};
        g8::gemm_phase<1>(lds, wid_s, (const bf16_t*)(ws + OFF_PROJ) + 1536, 2048, (const bf16_t*)(ws + OFF_WQB), 256, T_, 1792, 256, E, TabFill<RowQKV>{tab, wid_s, RowQKV{(const float*)(ws + OFF_PQ), (const float*)(ws + OFF_PKV)}});
    }
    xcd_barrier(xb);
    if (PH_MASK & 8) phase_attention(p, lds, fresh_tid(wid_s));
    xcd_barrier(xb);
    if (DUP_MASK & 8) { phase_attention(p, lds, fresh_tid(wid_s), DUP_WHICH); xcd_barrier(xb); }
    if (PH_MASK & 16) {
        LAS float* tab = (LAS float*)(lds + g8::STAGE_BYTES);
        EpiOut E{tab, (const bf16_t*)(ws + OFF_XB), (bf16_t*)(ws + OFF_H1B), (float*)(ws + OFF_PH)};
        g8::gemm_phase<2>(lds, wid_s, (const bf16_t*)(ws + OFF_MIX), 1024, (const bf16_t*)(ws + OFF_WO), 1024, T_, 1024, 512, E, TabFill<RowOut>{tab, wid_s, RowOut{(const float*)(ws + OFF_HSS)}});
    }
    xcd_barrier(xb);
    for (int rep = 0; rep < ((DUP_MASK & 32) ? 2 : 1); ++rep) {
    if (rep) xcd_barrier(xb);
    if (PH_MASK & 32) {
        LAS float* rst = (LAS float*)(lds + g8::STAGE_BYTES);
        EpiUp E{rst, (bf16_t*)(ws + OFF_HID)};
        g8::gemm_phase<1>(lds, wid_s, (const bf16_t*)(ws + OFF_H1B), 1024, (const bf16_t*)(ws + OFF_WUP), 1024, T_, 4096, 1024, E, TabFill<RowUp>{rst, wid_s, RowUp{(const float*)(ws + OFF_PH)}});
    }
    }
    xcd_barrier(xb);
    if (PH_MASK & 64) {
        EpiDown E{(const bf16_t*)(ws + OFF_H1B), (bf16_t*)(ws + OFF_MIX), (float*)(ws + OFF_PF)};
        g8::gemm_phase<1>(lds, wid_s, (const bf16_t*)(ws + OFF_HID), 4096, (const bf16_t*)(ws + OFF_WDN), 4096, T_, 1024, 4096, E);
    }
    xcd_barrier(xb);
    if (PH_MASK & 128) phase_final(p, fresh_tid(wid_s));
}

extern "C" void kernel_launch(void* const* d_in, const int* in_sizes, int n_in, void* d_out, int out_size, void* d_ws, size_t ws_size, hipStream_t stream) {
    static int grid_blocks = 0;
    if (grid_blocks == 0) {
        if (n_in != 15 || in_sizes[0] != T_ * 1024 || out_size != T_ * 1024 || ws_size < WS_END) {
            fprintf(stderr, "kernel_launch: unexpected shapes (n_in %d, in0 %d, out %d, ws %zu < %zu)\n", n_in, n_in > 0 ? in_sizes[0] : -1, out_size, ws_size, (size_t)WS_END);
            grid_blocks = -1; return;
        }
        int dev = 0, cus = 0, per_cu = 0;
        hipGetDevice(&dev);
        hipDeviceGetAttribute(&cus, hipDeviceAttributeMultiprocessorCount, dev);
        if (hipFuncSetAttribute((const void*)hymba_fwd, hipFuncAttributeMaxDynamicSharedMemorySize, LDS_BYTES) != hipSuccess) fprintf(stderr, "kernel_launch: hipFuncSetAttribute failed\n");
        if (hipOccupancyMaxActiveBlocksPerMultiprocessor(&per_cu, (const void*)hymba_fwd, 512, LDS_BYTES) != hipSuccess || per_cu < 1) { fprintf(stderr, "kernel_launch: occupancy query gave %d\n", per_cu); per_cu = 1; }
        (void)hipGetLastError();
        grid_blocks = cus;
        if (grid_blocks != 256) fprintf(stderr, "kernel_launch: note: %d CUs (work maps assume 256)\n", grid_blocks);
    }
    if (grid_blocks < 0) return;
    Params p{};
    p.x = (const float*)d_in[0]; p.pos = (const int*)d_in[1]; p.g_attn = (const float*)d_in[2]; p.w_in = (const float*)d_in[3];
    p.g_qa = (const float*)d_in[4]; p.w_qb = (const float*)d_in[5]; p.g_kva = (const float*)d_in[6]; p.w_kvb = (const float*)d_in[7];
    p.g_sbo = (const float*)d_in[8]; p.g_mlao = (const float*)d_in[9]; p.w_o = (const float*)d_in[10]; p.g_mlp = (const float*)d_in[11];
    p.w_up = (const float*)d_in[12]; p.w_down = (const float*)d_in[13]; p.g_final = (const float*)d_in[14];
    p.out = (float*)d_out; p.ws = (unsigned char*)d_ws;
    (void)hipMemsetAsync((unsigned char*)d_ws + OFF_BAR, 0, XCD_BAR_WORDS * 4, stream);
    void* args[] = {&p};
    hipError_t e = hipLaunchCooperativeKernel((const void*)hymba_fwd, dim3(grid_blocks), dim3(512), args, LDS_BYTES, stream);
    if (e != hipSuccess) fprintf(stderr, "kernel_launch: cooperative launch failed: %s (grid %d)\n", hipGetErrorString(e), grid_blocks);
}
```

```cpp
#include <hip/hip_runtime.h>
#include <hip/hip_cooperative_groups.h>
#include <cstdio>
namespace cg = cooperative_groups;

#define LAS __attribute__((address_space(3)))
#define DI __device__ __forceinline__
typedef unsigned short bf16_t;
typedef short bf16x8 __attribute__((ext_vector_type(8)));
typedef float f32x2 __attribute__((ext_vector_type(2)));
typedef float f32x4 __attribute__((ext_vector_type(4)));
typedef float f32x16 __attribute__((ext_vector_type(16)));
typedef unsigned u32x4 __attribute__((ext_vector_type(4)));
typedef unsigned u32x2 __attribute__((ext_vector_type(2)));
typedef __bf16 bf2_t __attribute__((ext_vector_type(2)));

constexpr int T_ = 65536, S_ = 4096;
constexpr float EPS_ = 1e-6f;
constexpr float LOG2E = 1.4426950408889634f, LN2 = 0.6931471805599453f;
constexpr float MLA_QSCALE = 0.07216878364870322f * 1.4426950408889634f;
constexpr float SB_PTHR = 1e-37f;

constexpr size_t SZ_T = (size_t)T_;
constexpr size_t OFF_PROJ = 0;
constexpr size_t OFF_VST  = OFF_PROJ + SZ_T * 2048 * 2;
constexpr size_t OFF_QN   = OFF_VST + SZ_T * 512 * 2;
constexpr size_t OFF_QR   = OFF_QN + SZ_T * 512 * 2;
constexpr size_t OFF_KN   = OFF_QR + SZ_T * 256 * 2;
constexpr size_t OFF_VMT  = OFF_KN + SZ_T * 512 * 2;
constexpr size_t OFF_REGA_END = OFF_VMT + SZ_T * 512 * 2;
constexpr size_t OFF_HID  = 0;
constexpr size_t OFF_XB   = OFF_REGA_END;
constexpr size_t OFF_MIX  = OFF_XB + SZ_T * 1024 * 2;
constexpr size_t OFF_H1B  = OFF_MIX + SZ_T * 1024 * 2;
constexpr size_t OFF_WIN  = OFF_H1B + SZ_T * 1024 * 2;
constexpr size_t OFF_WQB  = OFF_WIN + (size_t)2048 * 1024 * 2;
constexpr size_t OFF_WKVB = OFF_WQB + (size_t)768 * 256 * 2;
constexpr size_t OFF_WO   = OFF_WKVB + (size_t)1024 * 256 * 2;
constexpr size_t OFF_WUP  = OFF_WO + (size_t)1024 * 1024 * 2;
constexpr size_t OFF_WDN  = OFF_WUP + (size_t)4096 * 1024 * 2;
constexpr size_t OFF_CS   = OFF_WDN + (size_t)4096 * 1024 * 2;
constexpr size_t OFF_RSX  = OFF_CS + SZ_T * 32 * 8;
constexpr size_t OFF_PQ   = OFF_RSX + SZ_T * 4;
constexpr size_t OFF_PKV  = OFF_PQ + SZ_T * 16;
constexpr size_t OFF_HSS  = OFF_PKV + SZ_T * 16;
constexpr size_t OFF_PH   = OFF_HSS + SZ_T * 64;
constexpr size_t OFF_PF   = OFF_PH + SZ_T * 64;
constexpr size_t OFF_BAR  = OFF_PF + SZ_T * 64;
constexpr size_t WS_END   = OFF_BAR + 16384;

struct Params {
    const float* x; const int* pos; const float* g_attn; const float* w_in; const float* g_qa; const float* w_qb;
    const float* g_kva; const float* w_kvb; const float* g_sbo; const float* g_mlao; const float* w_o; const float* g_mlp;
    const float* w_up; const float* w_down; const float* g_final;
    float* out; unsigned char* ws;
};

__device__ const float INV_FREQ[32] = {
    1.000000000e+00f, 7.498942018e-01f, 5.623413324e-01f, 4.216965139e-01f, 3.162277639e-01f, 2.371373773e-01f, 1.778279394e-01f, 1.333521456e-01f,
    1.000000015e-01f, 7.498942316e-02f, 5.623413250e-02f, 4.216964915e-02f, 3.162277490e-02f, 2.371373773e-02f, 1.778279431e-02f, 1.333521400e-02f,
    9.999999776e-03f, 7.498942316e-03f, 5.623413250e-03f, 4.216964822e-03f, 3.162277630e-03f, 2.371373819e-03f, 1.778279431e-03f, 1.333521446e-03f,
    1.000000047e-03f, 7.498941850e-04f, 5.623413017e-04f, 4.216965172e-04f, 3.162277571e-04f, 2.371373703e-04f, 1.778279402e-04f, 1.333521504e-04f};

DI unsigned pk2(float lo, float hi) { f32x2 v = {lo, hi}; bf2_t r = __builtin_convertvector(v, bf2_t); return __builtin_bit_cast(unsigned, r); }
DI u32x4 pack8(f32x4 a, f32x4 b) { u32x4 o; o.x = pk2(a.x, a.y); o.y = pk2(a.z, a.w); o.z = pk2(b.x, b.y); o.w = pk2(b.z, b.w); return o; }
DI void unpack8(u32x4 w, f32x4& a, f32x4& b) {
    a.x = __uint_as_float(w.x << 16); a.y = __uint_as_float(w.x & 0xffff0000u); a.z = __uint_as_float(w.y << 16); a.w = __uint_as_float(w.y & 0xffff0000u);
    b.x = __uint_as_float(w.z << 16); b.y = __uint_as_float(w.z & 0xffff0000u); b.z = __uint_as_float(w.w << 16); b.w = __uint_as_float(w.w & 0xffff0000u);
}
DI float sum4(f32x4 v) { return (v.x + v.y) + (v.z + v.w); }
DI float sq4(f32x4 v) { return (v.x * v.x + v.y * v.y) + (v.z * v.z + v.w * v.w); }
DI float wave_sum(float v) {
#pragma unroll
    for (int o = 1; o < 64; o <<= 1) v += __shfl_xor(v, o);
    return v;
}
DI f32x16 zero16() { f32x16 z; for (int i = 0; i < 16; ++i) z[i] = 0.f; return z; }
DI const char* uptr(const char* p) {
    const unsigned long long u = (unsigned long long)p;
    const unsigned lo = __builtin_amdgcn_readfirstlane((unsigned)u), hi = __builtin_amdgcn_readfirstlane((unsigned)(u >> 32));
    return (const char*)(((unsigned long long)hi << 32) | lo);
}
DI int fresh_tid(int wid_s) {
    int l; asm volatile("v_mbcnt_lo_u32_b32 %0, -1, 0\n\tv_mbcnt_hi_u32_b32 %0, -1, %0" : "=v"(l));
    return wid_s * 64 + l;
}
typedef unsigned u32x2p __attribute__((ext_vector_type(2)));
DI void xhalf(float x, float& lo, float& hi) { const u32x2p r = __builtin_amdgcn_permlane32_swap(__float_as_uint(x), __float_as_uint(x), false, false); lo = __uint_as_float(r.x); hi = __uint_as_float(r.y); }
DI float xhalf_max(float x) { float lo, hi; xhalf(x, lo, hi); return fmaxf(lo, hi); }
DI float xhalf_sum(float x) { float lo, hi; xhalf(x, lo, hi); return lo + hi; }
#define MFMA32(a, b, c) __builtin_amdgcn_mfma_f32_32x32x16_bf16((a), (b), (c), 0, 0, 0)

DI void p0_weight_item(const Params& p, LAS float* scr, int mid, int t, int lane) {
    const float* W; int K, N, Kpad; bf16_t* out;
    switch (mid) {
        case 0:  W = p.w_in;   K = 1024; N = 1984; Kpad = 1024; out = (bf16_t*)(p.ws + OFF_WIN); break;
        case 1:  W = p.w_qb;   K = 256;  N = 768;  Kpad = 256;  out = (bf16_t*)(p.ws + OFF_WQB); break;
        case 2:  W = p.w_kvb;  K = 128;  N = 1024; Kpad = 256;  out = (bf16_t*)(p.ws + OFF_WKVB); break;
        case 3:  W = p.w_o;    K = 1024; N = 1024; Kpad = 1024; out = (bf16_t*)(p.ws + OFF_WO); break;
        case 4:  W = p.w_up;   K = 1024; N = 4096; Kpad = 1024; out = (bf16_t*)(p.ws + OFF_WUP); break;
        default: W = p.w_down; K = 4096; N = 1024; Kpad = 4096; out = (bf16_t*)(p.ws + OFF_WDN); break;
    }
    const int nkt = Kpad / 64, k0 = (t % nkt) * 64, n0 = (t / nkt) * 32;
    const int nn = lane & 31, no = n0 + nn;
    int src = no; float sc = 1.f;
    if (mid == 0) {
        if (no < 512) sc = -0.125f * LOG2E;
        else if (no >= 1920) { if (no < 1984) { const int pp = no - 1920; src = 1920 + ((pp >> 2) & 1) * 32 + 4 * (pp >> 3) + (pp & 3); } else src = -1; }
    } else if (mid == 1) {
        sc = MLA_QSCALE;
        if (no < 512) src = (no >> 7) * 192 + (no & 127);
        else { const int q = no - 512, hd = q >> 6, pp = q & 63; src = hd * 192 + 128 + ((pp >> 2) & 1) * 32 + 4 * (pp >> 3) + (pp & 3); }
    }
#pragma unroll 8
    for (int i = 0; i < 32; ++i) {
        const int kk = 2 * i + (lane >> 5), k = k0 + kk;
        float gv = 1.f; bool ok = src >= 0;
        if (mid == 0) gv = p.g_attn[k];
        else if (mid == 1) gv = p.g_qa[k];
        else if (mid == 2) { if (k >= K) ok = false; else gv = p.g_kva[k]; }
        else if (mid == 3) gv = (k < 512) ? p.g_sbo[k] : p.g_mlao[k - 512];
        else if (mid == 4) gv = p.g_mlp[k];
        float val = 0.f;
        if (ok) val = W[(size_t)k * N + src] * gv * sc;
        scr[kk * 33 + nn] = val;
    }
    asm volatile("s_waitcnt lgkmcnt(0)" ::: "memory");
    {
        const int c = lane & 7;
#pragma unroll
        for (int j = 0; j < 4; ++j) {
            const int n = (lane >> 3) + 8 * j; const LAS float* sp = scr + (8 * c) * 33 + n;
            u32x4 o; o.x = pk2(sp[0], sp[33]); o.y = pk2(sp[2 * 33], sp[3 * 33]); o.z = pk2(sp[4 * 33], sp[5 * 33]); o.w = pk2(sp[6 * 33], sp[7 * 33]);
            *(u32x4*)(out + (size_t)(n0 + n) * Kpad + k0 + 8 * c) = o;
        }
    }
    asm volatile("s_waitcnt lgkmcnt(0)" ::: "memory");
}

DI void phase0(const Params& p, LAS unsigned char* lds, int tid) {
    const int G = gridDim.x, blk = blockIdx.x;
    const int wid = tid >> 6, lane = tid & 63;
    {
        LAS float* scr = (LAS float*)(lds + wid * 8448);
        constexpr int C0 = 1024, C1 = C0 + 96, C2 = C1 + 128, C3 = C2 + 512, C4 = C3 + 2048, C5 = C4 + 2048;
        for (int it = blk * 8 + wid; it < C5; it += G * 8) {
            if (it < C0) p0_weight_item(p, scr, 0, it, lane);
            else if (it < C1) p0_weight_item(p, scr, 1, it - C0, lane);
            else if (it < C2) p0_weight_item(p, scr, 2, it - C1, lane);
            else if (it < C3) p0_weight_item(p, scr, 3, it - C2, lane);
            else if (it < C4) p0_weight_item(p, scr, 4, it - C3, lane);
            else p0_weight_item(p, scr, 5, it - C4, lane);
        }
    }
    float* rsx = (float*)(p.ws + OFF_RSX);
    bf16_t* xb = (bf16_t*)(p.ws + OFF_XB);
    f32x2* cs = (f32x2*)(p.ws + OFF_CS);
    int cidx = blk * 512 + tid;
    int posv = p.pos[cidx >> 5];
    for (int row = blk * 8 + wid; row < T_; row += G * 8) {
        const f32x4* xr = (const f32x4*)(p.x + (size_t)row * 1024) + lane;
        f32x4 v[4]; float s = 0.f;
#pragma unroll
        for (int j = 0; j < 4; ++j) v[j] = __builtin_nontemporal_load(xr + 64 * j);
        f32x2 cv; const bool docs = cidx < T_ * 32;
        if (docs) {
            const int i = cidx & 31;
            const float ang = (float)posv * INV_FREQ[i];
            const double rev = (double)ang * 0.15915494309189535;
            const float fr = (float)(rev - __builtin_rint(rev));
            cv.x = __builtin_amdgcn_cosf(fr); cv.y = __builtin_amdgcn_sinf(fr);
        }
#pragma unroll
        for (int j = 0; j < 4; ++j) s += sq4(v[j]);
        s = wave_sum(s);
        if (lane == 0) rsx[row] = rsqrtf(s * (1.f / 1024.f) + EPS_);
        u32x2* o = (u32x2*)(xb + (size_t)row * 1024) + lane;
#pragma unroll
        for (int j = 0; j < 4; ++j) { u32x2 w; w.x = pk2(v[j].x, v[j].y); w.y = pk2(v[j].z, v[j].w); o[64 * j] = w; }
        if (docs) { cs[cidx] = cv; cidx += G * 512; if (cidx < T_ * 32) posv = p.pos[cidx >> 5]; }
    }
    for (; cidx < T_ * 32; cidx += G * 512) {
        const int t = cidx >> 5, i = cidx & 31;
        const float ang = (float)p.pos[t] * INV_FREQ[i];
        const double rev = (double)ang * 0.15915494309189535;
        const float fr = (float)(rev - __builtin_rint(rev));
        f32x2 v; v.x = __builtin_amdgcn_cosf(fr); v.y = __builtin_amdgcn_sinf(fr);
        cs[cidx] = v;
    }
}

namespace g8 {
constexpr int BM = 256, BK = 64, HALF = 128, HTB = HALF * BK * 2, STAGE_BYTES = 8 * HTB, NXCD = 8, WGM = 8;
DI int lds_byte(int r, int c) { const int st = (r >> 4) * 2 + (c >> 5), rr = r & 15, cc = c & 31, ob = rr * 64 + cc * 2; return st * 1024 + (ob ^ (((ob >> 9) & 1) << 5)); }
DI void stage_rc(int b, int& R, int& C) { const int st = b / 1024, sb = b % 1024, swz = sb ^ (((sb >> 9) & 1) << 5); R = (st >> 1) * 16 + swz / 64; C = (st & 1) * 32 + (swz % 64) / 2; }
DI int perm32(int rho) { const int n = rho >> 4, i = rho & 15; return 8 * (i >> 2) + 4 * n + (i & 3); }
struct Unit { int pm, pn, kh; };

template <int NKH, int ROT = 0>
DI bool next_unit(int i, int nM, int nN, Unit& u) {
    const int ti = i / NKH; u.kh = i % NKH;
    const int nwg = nM * nN;
    const long L = (long)ti * gridDim.x + blockIdx.x; if (L >= nwg) return false;
    int wgid = (int)L; { const int q = nwg / NXCD, r = nwg % NXCD, xcd = wgid % NXCD, off = wgid / NXCD; wgid = (xcd < r ? xcd * (q + 1) : r * (q + 1) + (xcd - r) * q) + off; }
    const int nig = WGM * nN, gid = wgid / nig, fm = gid * WGM, gsz = (nM - fm) < WGM ? (nM - fm) : WGM;
    u.pm = fm + ((wgid % nig) % gsz); u.pn = (wgid % nig) / gsz;
    if (ROT) u.pn = (u.pn & 4) | ((u.pn + (ti >> 1)) & 3);
    return true;
}

struct NoPre { DI void operator()() const {} };
template <int NKH, int ROT = 0, class Epi, class Pre = NoPre>
DI void gemm_phase(LAS unsigned char* lds, int wid_s, const bf16_t* A, int lda, const bf16_t* Bt, int ldb, int M, int N, int Kc, const Epi& E, const Pre& pre = Pre()) {
    const int tid = fresh_tid(wid_s);
    const int wid = __builtin_amdgcn_readfirstlane(tid >> 6), lane = tid & 63, wr = wid >> 2, wc = wid & 3, fr = lane & 15, fq = lane >> 4;
    const int nt = Kc / BK, nM = M / BM, nN = N / BM;
    unsigned voffA[2], voffB[2];
#pragma unroll
    for (int i = 0; i < 2; ++i) { int R, C; stage_rc(tid * 16 + i * 8192, R, C); const int Rb = (R & ~31) + perm32(R & 31);
        voffA[i] = (unsigned)(R * lda + C) * 2u; voffB[i] = (unsigned)(Rb * ldb + C) * 2u; }
    const size_t kstep = (size_t)(BK * 2);
    const size_t hstepA = (size_t)HALF * lda * 2, hstepB = (size_t)HALF * ldb * 2;
    const size_t tstepA = 2 * hstepA, tstepB = 2 * hstepB, kchunk = (size_t)Kc * 2;
    const unsigned ldsw = (unsigned)wid * 1024u;
    const int aoff = lds_byte(wr * 64 + fr, fq * 8), boff = lds_byte(wc * 32 + fr, fq * 8);
#define G8_SA(b, h) (((b) * 2 + (h)) * HTB)
#define G8_SB(b, h) ((4 + (b) * 2 + (h)) * HTB)
#define G8_STAGE(bufoff, gbase, voff) do { const char* _gb = uptr((const char*)(gbase)); _Pragma("unroll") for (int _i = 0; _i < 2; ++_i) \
        __builtin_amdgcn_global_load_lds((const unsigned*)(_gb + (voff)[_i]), (LAS unsigned*)(lds + (bufoff) + ldsw + _i * 8192), 16, 0, 0); } while (0)
#define G8_LDA(dst, b, h) do { _Pragma("unroll") for (int m = 0; m < 4; ++m) _Pragma("unroll") for (int k = 0; k < 2; ++k) dst[m][k] = *(const LAS bf16x8*)(lds + G8_SA(b, h) + aoff + m * 2048 + k * 1024); } while (0)
#define G8_LDB(dst, b, h) do { _Pragma("unroll") for (int n = 0; n < 2; ++n) _Pragma("unroll") for (int k = 0; k < 2; ++k) dst[n][k] = *(const LAS bf16x8*)(lds + G8_SB(b, h) + boff + n * 2048 + k * 1024); } while (0)
#define G8_MMA(ai, bj, At, Bt_) do { __builtin_amdgcn_s_setprio(1); _Pragma("unroll") for (int m = 0; m < 4; ++m) _Pragma("unroll") for (int n = 0; n < 2; ++n) _Pragma("unroll") for (int k = 0; k < 2; ++k) \
        acc[ai][bj][m][n] = __builtin_amdgcn_mfma_f32_16x16x32_bf16(Bt_[n][k], At[m][k], acc[ai][bj][m][n], 0, 0, 0); __builtin_amdgcn_s_setprio(0); } while (0)
#define G8_WAIT_V(n) asm volatile("s_waitcnt vmcnt(" #n ")" ::: "memory")
#define G8_WAIT_L(n) asm volatile("s_waitcnt lgkmcnt(" #n ")" ::: "memory")
#define G8_BAR __builtin_amdgcn_s_barrier()
#define G8_SCHED __builtin_amdgcn_sched_barrier(0)
    Unit cur, nxt; int ui = 0;
    if (!next_unit<NKH, ROT>(0, nM, nN, cur)) return;
    f32x4 acc[2][2][4][2];
#pragma unroll
    for (int a = 0; a < 2; ++a)
#pragma unroll
        for (int b = 0; b < 2; ++b)
#pragma unroll
            for (int m = 0; m < 4; ++m)
#pragma unroll
                for (int n = 0; n < 2; ++n) acc[a][b][m][n] = (f32x4){0.f, 0.f, 0.f, 0.f};
    bf16x8 At[4][2], B0[2][2], B1[2][2];
    const char* cA = uptr((const char*)A + (size_t)cur.pm * tstepA + (size_t)cur.kh * kchunk + E.a_off(cur.pn));
    const char* cB = uptr((const char*)Bt + (size_t)cur.pn * tstepB + (size_t)cur.kh * kchunk);
    G8_STAGE(G8_SB(0, 0), cB, voffB); G8_STAGE(G8_SA(0, 0), cA, voffA); G8_STAGE(G8_SB(0, 1), cB + hstepB, voffB); G8_STAGE(G8_SA(0, 1), cA + hstepA, voffA);
    pre();
    if (wr == 1) G8_BAR;
    G8_WAIT_V(4); G8_BAR;
    G8_STAGE(G8_SB(1, 0), cB + kstep, voffB); G8_STAGE(G8_SA(1, 0), cA + kstep, voffA); G8_STAGE(G8_SB(1, 1), cB + hstepB + kstep, voffB);
    G8_WAIT_V(6); G8_BAR;
    for (;;) {
        const bool has_next = next_unit<NKH, ROT>(ui + 1, nM, nN, nxt);
        const char* nA = uptr(has_next ? (const char*)A + (size_t)nxt.pm * tstepA + (size_t)nxt.kh * kchunk + E.a_off(nxt.pn) : cA);
        const char* nB = uptr(has_next ? (const char*)Bt + (size_t)nxt.pn * tstepB + (size_t)nxt.kh * kchunk : cB);
        for (int t = 0; t < nt; t += 2) {
            const bool last = (t == nt - 2);
            const char* a1 = cA + (size_t)(t + 1) * kstep;
            const char* a2 = last ? nA : cA + (size_t)(t + 2) * kstep; const char* b2 = last ? nB : cB + (size_t)(t + 2) * kstep;
            const char* a3 = a2 + kstep; const char* b3 = b2 + kstep;
            G8_LDB(B0, 0, 0); G8_SCHED; G8_LDA(At, 0, 0); G8_STAGE(G8_SA(1, 1), a1 + hstepA, voffA);
            G8_WAIT_L(8); G8_BAR; G8_WAIT_L(0); G8_MMA(0, 0, At, B0); G8_BAR; G8_SCHED;
            G8_LDB(B1, 0, 1); G8_STAGE(G8_SB(0, 0), b2, voffB);
            G8_BAR; G8_WAIT_L(0); G8_MMA(0, 1, At, B1); G8_BAR;
            G8_LDA(At, 0, 1); G8_STAGE(G8_SA(0, 0), a2, voffA);
            G8_BAR; G8_WAIT_L(0); G8_MMA(1, 0, At, B0); G8_BAR; G8_SCHED;
            G8_STAGE(G8_SB(0, 1), b2 + hstepB, voffB);
            G8_WAIT_V(6); G8_BAR; G8_MMA(1, 1, At, B1); G8_BAR;
            G8_LDB(B0, 1, 0); G8_SCHED; G8_LDA(At, 1, 0); G8_STAGE(G8_SA(0, 1), a2 + hstepA, voffA);
            G8_WAIT_L(8); G8_BAR; G8_WAIT_L(0); G8_MMA(0, 0, At, B0); G8_BAR; G8_SCHED;
            G8_LDB(B1, 1, 1); G8_STAGE(G8_SB(1, 0), b3, voffB);
            G8_BAR; G8_WAIT_L(0); G8_MMA(0, 1, At, B1); G8_BAR;
            G8_LDA(At, 1, 1); G8_STAGE(G8_SA(1, 0), a3, voffA);
            G8_BAR; G8_WAIT_L(0); G8_MMA(1, 0, At, B0); G8_BAR; G8_SCHED;
            G8_STAGE(G8_SB(1, 1), b3 + hstepB, voffB);
            G8_WAIT_V(6); G8_BAR; G8_MMA(1, 1, At, B1); G8_BAR;
        }
        { int l2 = lane; asm volatile("" : "+v"(l2)); E(acc, cur, wr, wc, l2 & 15, l2 >> 4); }
        if (!has_next) break;
        if (cur.kh == NKH - 1) {
#pragma unroll
            for (int a = 0; a < 2; ++a)
#pragma unroll
                for (int b = 0; b < 2; ++b)
#pragma unroll
                    for (int m = 0; m < 4; ++m)
#pragma unroll
                        for (int n = 0; n < 2; ++n) acc[a][b][m][n] = (f32x4){0.f, 0.f, 0.f, 0.f};
        }
        cur = nxt; cA = nA; cB = nB; ++ui;
    }
    G8_WAIT_V(0);
    if (wr == 0) G8_BAR;
    G8_BAR;
#undef G8_SA
#undef G8_SB
#undef G8_STAGE
#undef G8_LDA
#undef G8_LDB
#undef G8_MMA
#undef G8_WAIT_V
#undef G8_WAIT_L
#undef G8_BAR
#undef G8_SCHED
}
}
using g8::Unit;
typedef f32x4 AccT[2][2][4][2];

DI void rope8(f32x4& v0, f32x4& v1, const f32x4 ca, const f32x4 cb) {
    f32x4 o1, o2;
    o1.x = v0.x * ca.x - v1.x * ca.y; o2.x = v1.x * ca.x + v0.x * ca.y;
    o1.y = v0.y * ca.z - v1.y * ca.w; o2.y = v1.y * ca.z + v0.y * ca.w;
    o1.z = v0.z * cb.x - v1.z * cb.y; o2.z = v1.z * cb.x + v0.z * cb.y;
    o1.w = v0.w * cb.z - v1.w * cb.w; o2.w = v1.w * cb.z + v0.w * cb.w;
    v0 = o1; v1 = o2;
}
DI void store_tr8(bf16_t* base, f32x4 v0, f32x4 v1) {
    base[0 * S_] = (bf16_t)pk2(v0.x, 0.f); base[1 * S_] = (bf16_t)pk2(v0.y, 0.f); base[2 * S_] = (bf16_t)pk2(v0.z, 0.f); base[3 * S_] = (bf16_t)pk2(v0.w, 0.f);
    base[4 * S_] = (bf16_t)pk2(v1.x, 0.f); base[5 * S_] = (bf16_t)pk2(v1.y, 0.f); base[6 * S_] = (bf16_t)pk2(v1.z, 0.f); base[7 * S_] = (bf16_t)pk2(v1.w, 0.f);
}

template <class F>
DI void fill_row_tables(LAS float* tab, int wid_s, const F& f) {
    const int t2 = fresh_tid(wid_s), bx = blockIdx.x & 7, bj8 = (blockIdx.x >> 3) & 7;
    for (int idx = t2; idx < 1024; idx += 512) {
        const int row = (8 * (4 * bx + (idx >> 8)) + bj8) * 256 + (idx & 255);
        const f32x2 v = f(row); tab[idx] = v.x; tab[1024 + idx] = v.y;
    }
    __syncthreads();
}
template <class F> struct TabFill {
    LAS float* tab; int wid_s; F f;
    DI void operator()() const {
        const int t2 = fresh_tid(wid_s), bx = blockIdx.x & 7, bj8 = (blockIdx.x >> 3) & 7;
        for (int idx = t2; idx < 1024; idx += 512) {
            const int row = (8 * (4 * bx + (idx >> 8)) + bj8) * 256 + (idx & 255);
            const f32x2 v = f(row); tab[idx] = v.x; tab[1024 + idx] = v.y;
        }
    }
};
struct RowRsx { const float* rsx; DI f32x2 operator()(int row) const { f32x2 v; v.x = rsx[row]; v.y = 0.f; return v; } };
struct RowQKV { const float* pq; const float* pkv; DI f32x2 operator()(int row) const { f32x2 v;
    v.x = rsqrtf(sum4(*(const f32x4*)(pq + (size_t)row * 4)) * (1.f / 256.f) + EPS_); v.y = rsqrtf(sum4(*(const f32x4*)(pkv + (size_t)row * 4)) * (1.f / 128.f) + EPS_); return v; } };
struct RowOut { const float* hss; DI f32x2 operator()(int row) const { const float* hp = hss + (size_t)row * 16; f32x2 v;
    const float rml = rsqrtf(sum4(*(const f32x4*)(hp + 8)) * (1.f / 512.f) + EPS_), rsb = rsqrtf((sum4(*(const f32x4*)hp) + sum4(*(const f32x4*)(hp + 4))) * (1.f / 512.f) + EPS_);
    v.x = rsb / rml; v.y = rml; return v; } };
struct RowUp { const float* ph; DI f32x2 operator()(int row) const { const f32x4* pp = (const f32x4*)(ph + (size_t)row * 16); f32x2 v;
    v.x = rsqrtf(((sum4(pp[0]) + sum4(pp[1])) + (sum4(pp[2]) + sum4(pp[3]))) * (1.f / 1024.f) + EPS_); v.y = 0.f; return v; } };
#define EPI_TAB(tab, which, i) ((tab)[(which) * 1024 + ((u.pm >> 3) & 3) * 256 + wr * 64 + fr + ((i) >> 2) * 128 + ((i) & 3) * 16])
#define EPI_ROW(ai, m) (u.pm * 256 + (ai) * 128 + wr * 64 + (m) * 16 + fr)
struct EpiProj {
    DI int a_off(int) const { return 0; }
    const LAS float* tab; const float* cs; bf16_t* proj; bf16_t* vst; float* pq; float* pkv;
    DI void operator()(AccT& acc, const Unit& u, int wr, int wc, int fr, int fq) const {
        const int pn = u.pn;
        float rsv[8];
#pragma unroll
        for (int i = 0; i < 8; ++i) rsv[i] = EPI_TAB(tab, 0, i);
        const bool do_rope = (pn == 7 && wc < 2);
        f32x4 rca[8], rcb[8];
        if (do_rope) {
#pragma unroll
            for (int i = 0; i < 8; ++i) { const float* cr = cs + (size_t)EPI_ROW(i >> 2, i & 3) * 64 + 2 * (16 * wc + 4 * fq); rca[i] = *(const f32x4*)cr; rcb[i] = *(const f32x4*)(cr + 4); }
        }
#pragma unroll
        for (int ai = 0; ai < 2; ++ai)
#pragma unroll
            for (int m = 0; m < 4; ++m) {
                const int row = EPI_ROW(ai, m);
                const float rs = rsv[ai * 4 + m]; float ss = 0.f;
#pragma unroll
                for (int bj = 0; bj < 2; ++bj) {
                    f32x4 v0 = acc[ai][bj][m][0] * rs, v1 = acc[ai][bj][m][1] * rs;
                    const int cl = bj * 128 + wc * 32 + fq * 8;
                    if (do_rope && bj == 1) rope8(v0, v1, rca[ai * 4 + m], rcb[ai * 4 + m]);
                    if (pn == 6 || (pn == 7 && bj == 0)) ss += sq4(v0) + sq4(v1);
                    if (pn == 4 || pn == 5) {
                        const int dg = (pn - 4) * 256 + cl, hd = dg >> 6, d = dg & 63, b = row >> 12, s = row & 4095;
                        store_tr8(vst + ((size_t)(b * 8 + hd) * 64 + d) * S_ + s, v0, v1);
                    } else {
                        *(u32x4*)(proj + (size_t)row * 2048 + pn * 256 + cl) = pack8(v0, v1);
                    }
                }
                if (pn >= 6) { ss += __shfl_xor(ss, 16); ss = xhalf_sum(ss); if (fq == 0) (pn == 6 ? pq : pkv)[(size_t)row * 4 + wc] = ss; }
            }
    }
};
struct EpiQKV {
    const LAS float* tab; const float* cs; bf16_t* qn; bf16_t* qr; bf16_t* kn; bf16_t* vmt;
    DI int a_off(int pn) const { return pn >= 3 ? 512 : 0; }
    DI void operator()(AccT& acc, const Unit& u, int wr, int wc, int fr, int fq) const {
        const int pn = u.pn;
        const int wh = pn < 3 ? 0 : 1;
        float rsv[8];
#pragma unroll
        for (int i = 0; i < 8; ++i) rsv[i] = EPI_TAB(tab, wh, i);
        f32x4 rca[8], rcb[8];
        if (pn == 2) {
#pragma unroll
            for (int i = 0; i < 8; ++i) { const float* cr = cs + (size_t)EPI_ROW(i >> 2, i & 3) * 64 + 2 * (4 * ((((wc & 1) * 32 + fq * 8)) >> 3)); rca[i] = *(const f32x4*)cr; rcb[i] = *(const f32x4*)(cr + 4); }
        }
#pragma unroll
        for (int ai = 0; ai < 2; ++ai)
#pragma unroll
            for (int m = 0; m < 4; ++m) {
                const int row = EPI_ROW(ai, m);
                const float rs = rsv[ai * 4 + m];
                if (pn < 3) {
#pragma unroll
                    for (int bj = 0; bj < 2; ++bj) {
                        f32x4 v0 = acc[ai][bj][m][0] * rs, v1 = acc[ai][bj][m][1] * rs;
                        const int cl = bj * 128 + wc * 32 + fq * 8;
                        if (pn < 2) *(u32x4*)(qn + (size_t)row * 512 + pn * 256 + cl) = pack8(v0, v1);
                        else { rope8(v0, v1, rca[ai * 4 + m], rcb[ai * 4 + m]); *(u32x4*)(qr + (size_t)row * 256 + cl) = pack8(v0, v1); }
                    }
                } else {
                    const int hd = pn - 3;
                    const int cl = wc * 32 + fq * 8, b = row >> 12, s = row & 4095;
                    { f32x4 v0 = acc[ai][0][m][0] * rs, v1 = acc[ai][0][m][1] * rs; *(u32x4*)(kn + (size_t)row * 512 + hd * 128 + cl) = pack8(v0, v1); }
                    { f32x4 v0 = acc[ai][1][m][0] * rs, v1 = acc[ai][1][m][1] * rs; store_tr8(vmt + ((size_t)(b * 4 + hd) * 128 + cl) * S_ + s, v0, v1); }
                }
            }
    }
};
struct EpiOut {
    DI int a_off(int) const { return 0; }
    const LAS float* tab; const bf16_t* xb; bf16_t* h1b; float* ph;
    DI void operator()(AccT& acc, const Unit& u, int wr, int wc, int fr, int fq) const {
        float rsv[8];
        const int wh = u.kh == 0 ? 0 : 1;
#pragma unroll
        for (int i = 0; i < 8; ++i) rsv[i] = EPI_TAB(tab, wh, i);
        if (u.kh == 0) {
#pragma unroll
            for (int ai = 0; ai < 2; ++ai)
#pragma unroll
                for (int m = 0; m < 4; ++m)
#pragma unroll
                    for (int bj = 0; bj < 2; ++bj) { acc[ai][bj][m][0] *= rsv[ai * 4 + m]; acc[ai][bj][m][1] *= rsv[ai * 4 + m]; }
            return;
        }
        u32x4 res[8][2];
#pragma unroll
        for (int i = 0; i < 8; ++i)
#pragma unroll
            for (int bj = 0; bj < 2; ++bj) res[i][bj] = *(const u32x4*)(xb + (size_t)EPI_ROW(i >> 2, i & 3) * 1024 + u.pn * 256 + bj * 128 + wc * 32 + fq * 8);
#pragma unroll
        for (int ai = 0; ai < 2; ++ai)
#pragma unroll
            for (int m = 0; m < 4; ++m) {
                const int row = EPI_ROW(ai, m);
                const float rml = rsv[ai * 4 + m];
                float ss = 0.f;
#pragma unroll
                for (int bj = 0; bj < 2; ++bj) {
                    const size_t off = (size_t)row * 1024 + u.pn * 256 + bj * 128 + wc * 32 + fq * 8;
                    f32x4 r0, r1; unpack8(res[ai * 4 + m][bj], r0, r1);
                    const f32x4 v0 = acc[ai][bj][m][0] * rml + r0, v1 = acc[ai][bj][m][1] * rml + r1;
                    *(u32x4*)(h1b + off) = pack8(v0, v1);
                    ss += sq4(v0) + sq4(v1);
                }
                ss += __shfl_xor(ss, 16); ss = xhalf_sum(ss);
                if (fq == 0) ph[(size_t)row * 16 + u.pn * 4 + wc] = ss;
            }
    }
};
struct EpiUp {
    DI int a_off(int) const { return 0; }
    const LAS float* rst; bf16_t* hid;
    DI void operator()(AccT& acc, const Unit& u, int wr, int wc, int fr, int fq) const {
        float rsv[8];
#pragma unroll
        for (int i = 0; i < 8; ++i) rsv[i] = EPI_TAB(rst, 0, i);
#pragma unroll
        for (int ai = 0; ai < 2; ++ai)
#pragma unroll
            for (int m = 0; m < 4; ++m) {
                const int row = EPI_ROW(ai, m);
                const float rs = rsv[ai * 4 + m];
#pragma unroll
                for (int bj = 0; bj < 2; ++bj) {
                    f32x4 v0 = acc[ai][bj][m][0] * rs, v1 = acc[ai][bj][m][1] * rs;
#pragma unroll
                    for (int e = 0; e < 4; ++e) { const float a = fmaxf(v0[e], 0.f), b = fmaxf(v1[e], 0.f); v0[e] = a * a; v1[e] = b * b; }
                    *(u32x4*)(hid + (size_t)row * 4096 + u.pn * 256 + bj * 128 + wc * 32 + fq * 8) = pack8(v0, v1);
                }
            }
    }
};
struct EpiDown {
    DI int a_off(int) const { return 0; }
    const bf16_t* h1b; bf16_t* h2b; float* pf;
    DI void operator()(AccT& acc, const Unit& u, int wr, int wc, int fr, int fq) const {
        u32x4 res[8][2];
#pragma unroll
        for (int i = 0; i < 8; ++i)
#pragma unroll
            for (int bj = 0; bj < 2; ++bj) res[i][bj] = *(const u32x4*)(h1b + (size_t)EPI_ROW(i >> 2, i & 3) * 1024 + u.pn * 256 + bj * 128 + wc * 32 + fq * 8);
#pragma unroll
        for (int ai = 0; ai < 2; ++ai)
#pragma unroll
            for (int m = 0; m < 4; ++m) {
                const int row = EPI_ROW(ai, m);
                float ss = 0.f;
#pragma unroll
                for (int bj = 0; bj < 2; ++bj) {
                    const size_t off = (size_t)row * 1024 + u.pn * 256 + bj * 128 + wc * 32 + fq * 8;
                    f32x4 r0, r1; unpack8(res[ai * 4 + m][bj], r0, r1);
                    const f32x4 v0 = acc[ai][bj][m][0] + r0, v1 = acc[ai][bj][m][1] + r1;
                    *(u32x4*)(h2b + off) = pack8(v0, v1);
                    ss += sq4(v0) + sq4(v1);
                }
                ss += __shfl_xor(ss, 16); ss = xhalf_sum(ss);
                if (fq == 0) pf[(size_t)row * 16 + u.pn * 4 + wc] = ss;
            }
    }
};

constexpr int MLA_KROW = 400, MLA_VROW = 144, MLA_KBYTES = 64 * MLA_KROW, MLA_BUF = MLA_KBYTES + 128 * MLA_VROW;

DI void mla_s_softmax(const LAS unsigned char* base, int r, int h, bool is_diag, int lim, const bf16x8 (&qf)[12], f32x16 (&o)[4], float& m_run, float& l_run,
                      bf16x8 (&pf0)[2], bf16x8 (&pf1)[2]) {
    f32x16 s0 = zero16(), s1 = zero16();
    const LAS unsigned char* kp = base + r * MLA_KROW + h * 16;
#pragma unroll
    for (int g = 0; g < 3; ++g) {
        bf16x8 fa[4], fb[4];
#pragma unroll
        for (int j = 0; j < 4; ++j) { fa[j] = *(const LAS bf16x8*)(kp + (4 * g + j) * 32); fb[j] = *(const LAS bf16x8*)(kp + 32 * MLA_KROW + (4 * g + j) * 32); }
        __builtin_amdgcn_sched_barrier(0);
#pragma unroll
        for (int j = 0; j < 4; ++j) { s0 = MFMA32(fa[j], qf[4 * g + j], s0); s1 = MFMA32(fb[j], qf[4 * g + j], s1); }
        __builtin_amdgcn_sched_barrier(0);
    }
    if (is_diag) {
#pragma unroll
        for (int i = 0; i < 16; ++i) { if (16 * h + i > lim) s0[i] = -1e30f; if (32 + 16 * h + i > lim) s1[i] = -1e30f; }
    }
    float mx = fmaxf(s0[0], s1[0]);
#pragma unroll
    for (int i = 1; i < 16; ++i) mx = fmaxf(mx, fmaxf(s0[i], s1[i]));
    mx = xhalf_max(mx);
    const float mnew = fmaxf(m_run, mx);
    if (__builtin_amdgcn_ballot_w64(mnew > m_run + 8.0f) != 0ull) {
        const float alpha = __builtin_amdgcn_exp2f(m_run - mnew);
        l_run *= alpha;
#pragma unroll
        for (int dt = 0; dt < 4; ++dt) o[dt] *= alpha;
        m_run = mnew;
    }
    float ls = 0.f;
#pragma unroll
    for (int i = 0; i < 16; ++i) { s0[i] = __builtin_amdgcn_exp2f(s0[i] - m_run); s1[i] = __builtin_amdgcn_exp2f(s1[i] - m_run); ls += s0[i] + s1[i]; }
    l_run += ls;
#pragma unroll
    for (int s = 0; s < 2; ++s) {
        u32x4 a, c;
        a.x = pk2(s0[8 * s + 0], s0[8 * s + 1]); a.y = pk2(s0[8 * s + 2], s0[8 * s + 3]); a.z = pk2(s0[8 * s + 4], s0[8 * s + 5]); a.w = pk2(s0[8 * s + 6], s0[8 * s + 7]);
        c.x = pk2(s1[8 * s + 0], s1[8 * s + 1]); c.y = pk2(s1[8 * s + 2], s1[8 * s + 3]); c.z = pk2(s1[8 * s + 4], s1[8 * s + 5]); c.w = pk2(s1[8 * s + 6], s1[8 * s + 7]);
        pf0[s] = __builtin_bit_cast(bf16x8, a); pf1[s] = __builtin_bit_cast(bf16x8, c);
    }
}
DI void mla_pv(const LAS unsigned char* base, int r, int h, const bf16x8 (&pf0)[2], const bf16x8 (&pf1)[2], f32x16 (&o)[4]) {
    const LAS unsigned char* vp = base + MLA_KBYTES + r * MLA_VROW + h * 32;
#pragma unroll
    for (int s = 0; s < 2; ++s) {
        bf16x8 va[4], vb[4];
#pragma unroll
        for (int dt = 0; dt < 4; ++dt) { va[dt] = *(const LAS bf16x8*)(vp + dt * 32 * MLA_VROW + s * 16); vb[dt] = *(const LAS bf16x8*)(vp + dt * 32 * MLA_VROW + 64 + s * 16); }
        __builtin_amdgcn_sched_barrier(0);
#pragma unroll
        for (int dt = 0; dt < 4; ++dt) o[dt] = MFMA32(va[dt], pf0[s], o[dt]);
#pragma unroll
        for (int dt = 0; dt < 4; ++dt) o[dt] = MFMA32(vb[dt], pf1[s], o[dt]);
        __builtin_amdgcn_sched_barrier(0);
    }
}

DI void mla_block(const Params& p, LAS unsigned char* lds, int b, int hd, int qb, int tid) {
    asm volatile("" : "+v"(tid));
    const int wu = __builtin_amdgcn_readfirstlane(tid >> 6), lane = tid & 63, r = lane & 31, h = lane >> 5;
    const int q0 = qb * 256 + wu * 32;
    const bf16_t* QN = (const bf16_t*)(p.ws + OFF_QN); const bf16_t* QR = (const bf16_t*)(p.ws + OFF_QR);
    const size_t tok0 = (size_t)b * S_;
    bf16x8 qf[12];
    {
        const size_t qrow = tok0 + q0 + r;
#pragma unroll
        for (int ks = 0; ks < 8; ++ks) qf[ks] = *(const bf16x8*)(QN + qrow * 512 + hd * 128 + ks * 16 + h * 8);
#pragma unroll
        for (int ks = 0; ks < 4; ++ks) qf[8 + ks] = *(const bf16x8*)(QR + qrow * 256 + hd * 64 + ks * 16 + h * 8);
    }
    unsigned goff[6];
#pragma unroll
    for (int j = 0; j < 6; ++j) {
        const int pc = wu + 8 * j; goff[j] = 0;
        if (pc < 25) {
            const int c = pc * 64 + lane, lr = c / 25; int cc = c - lr * 25; if (cc == 24) cc = 0;
            const int k32 = lr & 31, key = (lr & 32) + 16 * ((k32 >> 2) & 1) + (k32 & 3) + 4 * (k32 >> 3);
            const unsigned tok = (unsigned)(b * S_ + key);
            goff[j] = (cc < 16) ? (unsigned)OFF_KN + (tok * 512u + hd * 128 + cc * 8) * 2u : (unsigned)OFF_PROJ + (tok * 2048u + 1920 + (cc - 16) * 8) * 2u;
        } else if (pc < 43) {
            const int c = (pc - 25) * 64 + lane, d = c / 9; int cc = c - d * 9; if (cc == 8) cc = 0;
            goff[j] = (unsigned)OFF_VMT + ((unsigned)((b * 4 + hd) * 128 + d) * (unsigned)S_ + cc * 8) * 2u;
        }
    }
    const char* wsb = uptr((const char*)p.ws);
#define MLA_STAGE(KT, BUF) do { _Pragma("unroll") for (int _j = 0; _j < 6; ++_j) { const int _pc = wu + 8 * _j; if (_pc < 43) { \
        const unsigned _inc = goff[_j] >= (unsigned)OFF_VMT ? 128u : (goff[_j] < (unsigned)OFF_VST ? 262144u : 65536u); \
        __builtin_amdgcn_global_load_lds((const unsigned*)(wsb + (goff[_j] + (unsigned)(KT) * _inc)), (LAS unsigned*)(lds + (BUF) * MLA_BUF + _pc * 1024), 16, 0, 0); } } } while (0)
    f32x16 o[4]; for (int dt = 0; dt < 4; ++dt) o[dt] = zero16();
    float m_run = -1e30f, l_run = 0.f;
    const int ntiles = 4 * qb + 4, wlast = q0 >> 6;
    __syncthreads();
    MLA_STAGE(0, 0);
    const bool late = wu >= 4;
    bf16x8 pf0[2], pf1[2];
    int bcur = 0;
    for (int kt = 0; kt < ntiles; ++kt) {
        asm volatile("s_waitcnt vmcnt(0)" ::: "memory");
        __builtin_amdgcn_s_barrier();
        asm volatile("" ::: "memory");
        const int bprev = bcur == 0 ? 2 : bcur - 1, bnext = bcur == 2 ? 0 : bcur + 1;
        if (kt + 1 < ntiles) MLA_STAGE(kt + 1, bnext);
        if (late && kt >= 1 && kt - 1 <= wlast) mla_pv(lds + bprev * MLA_BUF, r, h, pf0, pf1, o);
        if (kt <= wlast) {
            mla_s_softmax(lds + bcur * MLA_BUF, r, h, kt == wlast, q0 + r - kt * 64, qf, o, m_run, l_run, pf0, pf1);
            if (!late) mla_pv(lds + bcur * MLA_BUF, r, h, pf0, pf1, o);
        }
        bcur = bnext;
    }
    if (late && wlast == ntiles - 1) { const int bprev = bcur == 0 ? 2 : bcur - 1; mla_pv(lds + bprev * MLA_BUF, r, h, pf0, pf1, o); }
#undef MLA_STAGE
    const float lt = xhalf_sum(l_run), inv = 1.f / lt;
    bf16_t* mix = (bf16_t*)(p.ws + OFF_MIX) + (tok0 + q0 + r) * 1024 + 512 + hd * 128 + 4 * h;
    float ss = 0.f;
#pragma unroll
    for (int dt = 0; dt < 4; ++dt)
#pragma unroll
        for (int g = 0; g < 4; ++g) {
            const float a0 = o[dt][4 * g] * inv, a1 = o[dt][4 * g + 1] * inv, a2 = o[dt][4 * g + 2] * inv, a3 = o[dt][4 * g + 3] * inv;
            ss += (a0 * a0 + a1 * a1) + (a2 * a2 + a3 * a3);
            u32x2 w; w.x = pk2(a0, a1); w.y = pk2(a2, a3);
            *(u32x2*)(mix + dt * 32 + 8 * g) = w;
        }
    ss = xhalf_sum(ss);
    if (h == 0) ((float*)(p.ws + OFF_HSS))[(tok0 + q0 + r) * 16 + 8 + hd] = ss;
}

DI void sb_item(const Params& p, int bh, int qb32, int lane) {
    asm volatile("" : "+v"(lane));
    const int r = lane & 31, h = lane >> 5, b = bh >> 3, hd = bh & 7, q0 = qb32 * 32;
    const bf16_t* PROJ = (const bf16_t*)(p.ws + OFF_PROJ);
    const bf16_t* VST = (const bf16_t*)(p.ws + OFF_VST);
    const size_t tok0 = (size_t)b * S_;
    bf16x8 qf[4];
#pragma unroll
    for (int ks = 0; ks < 4; ++ks) qf[ks] = *(const bf16x8*)(PROJ + (tok0 + q0 + r) * 2048 + hd * 64 + ks * 16 + h * 8);
    const int pr = 16 * ((r >> 2) & 1) + (r & 3) + 4 * (r >> 3);
    const bf16_t* kbase = PROJ + (tok0 + pr) * 2048 + 512 + hd * 64 + h * 8;
    const bf16_t* vbase = VST + ((size_t)(b * 8 + hd) * 64 + r) * S_ + 16 * h;
    bf16x8 kc[4], kn[4], vf[4];
#pragma unroll
    for (int ks = 0; ks < 4; ++ks) kc[ks] = *(const bf16x8*)(kbase + (size_t)q0 * 2048 + ks * 16);
    f32x16 o0 = zero16(), o1 = zero16();
    float carry = 1.f;
    for (int kb = q0; kb >= 0; kb -= 32) {
#pragma unroll
        for (int dt = 0; dt < 2; ++dt)
#pragma unroll
            for (int s = 0; s < 2; ++s) vf[dt * 2 + s] = *(const bf16x8*)(vbase + (size_t)dt * 32 * S_ + kb + 8 * s);
        if (kb >= 32) {
#pragma unroll
            for (int ks = 0; ks < 4; ++ks) kn[ks] = *(const bf16x8*)(kbase + (size_t)(kb - 32) * 2048 + ks * 16);
        }
        f32x16 z = zero16();
#pragma unroll
        for (int ks = 0; ks < 4; ++ks) z = MFMA32(kc[ks], qf[ks], z);
        const bool diag = (kb == q0);
        f32x16 a;
        float tot = 1.f;
#pragma unroll
        for (int i = 15; i >= 0; --i) {
            const float w = __builtin_amdgcn_exp2f(fminf(z[i], 86.f));
            float be = __builtin_amdgcn_rcpf(1.f + w);
            float om = w * be;
            if (diag) { const bool valid = (16 * h + i < r); be = valid ? be : 0.f; om = valid ? om : 1.f; }
            a[i] = be * tot;
            tot *= om;
        }
        const float other = __shfl_xor(tot, 32);
        const float base = carry * (h == 0 ? other : 1.f);
        carry *= tot * other;
#pragma unroll
        for (int i = 0; i < 16; ++i) a[i] *= base;
        bf16x8 pf[2];
#pragma unroll
        for (int s = 0; s < 2; ++s) {
            u32x4 w; w.x = pk2(a[8 * s + 0], a[8 * s + 1]); w.y = pk2(a[8 * s + 2], a[8 * s + 3]); w.z = pk2(a[8 * s + 4], a[8 * s + 5]); w.w = pk2(a[8 * s + 6], a[8 * s + 7]);
            pf[s] = __builtin_bit_cast(bf16x8, w);
        }
#pragma unroll
        for (int s = 0; s < 2; ++s) { o0 = MFMA32(vf[s], pf[s], o0); o1 = MFMA32(vf[2 + s], pf[s], o1); }
        if (kb >= 32) {
#pragma unroll
            for (int ks = 0; ks < 4; ++ks) kc[ks] = kn[ks];
        }
        if (__all(carry < SB_PTHR)) break;
    }
    bf16_t* mix = (bf16_t*)(p.ws + OFF_MIX) + (tok0 + q0 + r) * 1024 + hd * 64 + 4 * h;
    float ss = 0.f;
#pragma unroll
    for (int g = 0; g < 4; ++g) {
        { const float a0 = o0[4 * g], a1 = o0[4 * g + 1], a2 = o0[4 * g + 2], a3 = o0[4 * g + 3];
          ss += (a0 * a0 + a1 * a1) + (a2 * a2 + a3 * a3); u32x2 w; w.x = pk2(a0, a1); w.y = pk2(a2, a3); *(u32x2*)(mix + 8 * g) = w; }
        { const float a0 = o1[4 * g], a1 = o1[4 * g + 1], a2 = o1[4 * g + 2], a3 = o1[4 * g + 3];
          ss += (a0 * a0 + a1 * a1) + (a2 * a2 + a3 * a3); u32x2 w; w.x = pk2(a0, a1); w.y = pk2(a2, a3); *(u32x2*)(mix + 32 + 8 * g) = w; }
    }
    ss = xhalf_sum(ss);
    if (h == 0) ((float*)(p.ws + OFF_HSS))[(tok0 + q0 + r) * 16 + hd] = ss;
}

constexpr int SB_ROW = 144, SB_KBYTES = 64 * SB_ROW, SB_BUF = 2 * SB_KBYTES  , SB_NB = 7, SB_FLAGS = SB_NB * SB_BUF;
DI void sb_block(const Params& p, LAS unsigned char* lds, int bh, int qb, int tid) {
    asm volatile("" : "+v"(tid));
    const int wu = __builtin_amdgcn_readfirstlane(tid >> 6), lane = tid & 63, r = lane & 31, h = lane >> 5;
    const int b = bh >> 3, hd = bh & 7, q0 = qb * 256 + wu * 32;
    const bf16_t* PROJ = (const bf16_t*)(p.ws + OFF_PROJ);
    const size_t tok0 = (size_t)b * S_;
    bf16x8 qf[4];
#pragma unroll
    for (int ks = 0; ks < 4; ++ks) qf[ks] = *(const bf16x8*)(PROJ + (tok0 + q0 + r) * 2048 + hd * 64 + ks * 16 + h * 8);
    unsigned goff[3];
#pragma unroll
    for (int j = 0; j < 3; ++j) {
        const int pc = wu + 8 * j; goff[j] = 0;
        if (pc < 18) {
            const int c = (pc < 9 ? pc : pc - 9) * 64 + lane, lr = c / 9; int cc = c - lr * 9; if (cc == 8) cc = 0;
            if (pc < 9) { const int k32 = lr & 31, key = (lr & 32) + 16 * ((k32 >> 2) & 1) + (k32 & 3) + 4 * (k32 >> 3);
                goff[j] = (unsigned)OFF_PROJ + ((unsigned)(b * S_ + key) * 2048u + 512 + hd * 64 + cc * 8) * 2u; }
            else goff[j] = (unsigned)OFF_VST + ((unsigned)((b * 8 + hd) * 64 + lr) * (unsigned)S_ + cc * 8) * 2u;
        }
    }
    const char* wsb = uptr((const char*)p.ws);
#define SB_STAGE(KT, BUF) do { _Pragma("unroll") for (int _j = 0; _j < 3; ++_j) { const int _pc = wu + 8 * _j; if (_pc < 18) { \
        const unsigned _inc = goff[_j] >= (unsigned)OFF_VST ? 128u : 262144u; \
        __builtin_amdgcn_global_load_lds((const unsigned*)(wsb + (goff[_j] + (unsigned)(KT) * _inc)), (LAS unsigned*)(lds + (BUF) * SB_BUF + _pc * 1024), 16, 0, 0); } } } while (0)
    f32x16 o0 = zero16(), o1 = zero16();
    float carry = 1.f;
    bool done = false;
    const int ktop = 4 * qb + 3;
    LAS int* flags = (LAS int*)(lds + SB_FLAGS);
    asm volatile("s_waitcnt vmcnt(0)" ::: "memory");
    __syncthreads();
    const int nstaged = ktop + 1 < SB_NB ? ktop + 1 : SB_NB;
    for (int i = 0; i < nstaged; ++i) SB_STAGE(ktop - i, i);
#define SB_WAITV(n) asm volatile("s_waitcnt vmcnt(" #n ") lgkmcnt(0)" ::: "memory")
    int cur = 0, it = 0;
    for (int kt = ktop; ; --kt, ++it) {
        if (lane == 0) flags[(it & 1) * 8 + wu] = done ? 1 : 0;
        if (it >= SB_NB && kt >= 0) SB_STAGE(kt, cur);
        const int ahead = it < nstaged ? nstaged - 1 - it : 0;
        if (wu < 2) { switch (ahead) { case 0: SB_WAITV(0); break; case 1: SB_WAITV(3); break; case 2: SB_WAITV(6); break; case 3: SB_WAITV(9); break; case 4: SB_WAITV(12); break; case 5: SB_WAITV(15); break; default: SB_WAITV(18); break; } }
        else { switch (ahead) { case 0: SB_WAITV(0); break; case 1: SB_WAITV(2); break; case 2: SB_WAITV(4); break; case 3: SB_WAITV(6); break; case 4: SB_WAITV(8); break; case 5: SB_WAITV(10); break; default: SB_WAITV(12); break; } }
        __builtin_amdgcn_s_barrier();
        asm volatile("" ::: "memory");
        {
            const LAS int* f = flags + (it & 1) * 8;
            const int all = f[0] & f[1] & f[2] & f[3] & f[4] & f[5] & f[6] & f[7];
            if (__builtin_amdgcn_readfirstlane(all)) break;
        }
        if (!done && kt * 64 <= q0) {
            const LAS unsigned char* base = lds + cur * SB_BUF;
#pragma unroll
            for (int sub = 1; sub >= 0; --sub) {
                const int kb = kt * 64 + sub * 32;
                if (kb <= q0 && !done) {
                    const LAS unsigned char* kp = base + (sub * 32 + r) * SB_ROW + h * 16;
                    bf16x8 kf[4], vf[4];
#pragma unroll
                    for (int ks = 0; ks < 4; ++ks) kf[ks] = *(const LAS bf16x8*)(kp + ks * 32);
#pragma unroll
                    for (int dt = 0; dt < 2; ++dt)
#pragma unroll
                        for (int s2 = 0; s2 < 2; ++s2) vf[dt * 2 + s2] = *(const LAS bf16x8*)(base + SB_KBYTES + (dt * 32 + r) * SB_ROW + (sub * 32 + 16 * h + 8 * s2) * 2);
                    f32x16 z = zero16();
#pragma unroll
                    for (int ks = 0; ks < 4; ++ks) z = MFMA32(kf[ks], qf[ks], z);
                    const bool diag = (kb == q0);
                    f32x16 a;
                    float tot = 1.f;
#pragma unroll
                    for (int i = 15; i >= 0; --i) {
                        const float w = __builtin_amdgcn_exp2f(fminf(z[i], 86.f));
                        float be = __builtin_amdgcn_rcpf(1.f + w);
                        float om = w * be;
                        if (diag) { const bool valid = (16 * h + i < r); be = valid ? be : 0.f; om = valid ? om : 1.f; }
                        a[i] = be * tot;
                        tot *= om;
                    }
                    const float other = __shfl_xor(tot, 32);
                    const float bs = carry * (h == 0 ? other : 1.f);
                    carry *= tot * other;
#pragma unroll
                    for (int i = 0; i < 16; ++i) a[i] *= bs;
                    bf16x8 pf[2];
#pragma unroll
                    for (int s2 = 0; s2 < 2; ++s2) {
                        u32x4 w; w.x = pk2(a[8 * s2 + 0], a[8 * s2 + 1]); w.y = pk2(a[8 * s2 + 2], a[8 * s2 + 3]); w.z = pk2(a[8 * s2 + 4], a[8 * s2 + 5]); w.w = pk2(a[8 * s2 + 6], a[8 * s2 + 7]);
                        pf[s2] = __builtin_bit_cast(bf16x8, w);
                    }
#pragma unroll
                    for (int s2 = 0; s2 < 2; ++s2) { o0 = MFMA32(vf[s2], pf[s2], o0); o1 = MFMA32(vf[2 + s2], pf[s2], o1); }
                    if (__all(carry < SB_PTHR)) done = true;
                }
            }
            if (kt == 0) done = true;
        }
        cur = cur == SB_NB - 1 ? 0 : cur + 1;
    }
    asm volatile("s_waitcnt vmcnt(0)" ::: "memory");
#undef SB_WAITV
#undef SB_STAGE
    bf16_t* mix = (bf16_t*)(p.ws + OFF_MIX) + (tok0 + q0 + r) * 1024 + hd * 64 + 4 * h;
    float ss = 0.f;
#pragma unroll
    for (int g = 0; g < 4; ++g) {
        { const float a0 = o0[4 * g], a1 = o0[4 * g + 1], a2 = o0[4 * g + 2], a3 = o0[4 * g + 3];
          ss += (a0 * a0 + a1 * a1) + (a2 * a2 + a3 * a3); u32x2 w; w.x = pk2(a0, a1); w.y = pk2(a2, a3); *(u32x2*)(mix + 8 * g) = w; }
        { const float a0 = o1[4 * g], a1 = o1[4 * g + 1], a2 = o1[4 * g + 2], a3 = o1[4 * g + 3];
          ss += (a0 * a0 + a1 * a1) + (a2 * a2 + a3 * a3); u32x2 w; w.x = pk2(a0, a1); w.y = pk2(a2, a3); *(u32x2*)(mix + 32 + 8 * g) = w; }
    }
    ss = xhalf_sum(ss);
    if (h == 0) ((float*)(p.ws + OFF_HSS))[(tok0 + q0 + r) * 16 + hd] = ss;
}

DI void sb_block2(const Params& p, LAS unsigned char* lds, int bh, int qb2, int tid) {
    asm volatile("" : "+v"(tid));
    const int wu = __builtin_amdgcn_readfirstlane(tid >> 6), lane = tid & 63, r = lane & 31, h = lane >> 5;
    const int b = bh >> 3, hd = bh & 7;
    int q0[2]; q0[0] = qb2 * 512 + wu * 32; q0[1] = q0[0] + 256;
    const bf16_t* PROJ = (const bf16_t*)(p.ws + OFF_PROJ);
    const size_t tok0 = (size_t)b * S_;
    bf16x8 qf[2][4];
#pragma unroll
    for (int g = 0; g < 2; ++g)
#pragma unroll
        for (int ks = 0; ks < 4; ++ks) qf[g][ks] = *(const bf16x8*)(PROJ + (tok0 + q0[g] + r) * 2048 + hd * 64 + ks * 16 + h * 8);
    unsigned goff[3];
#pragma unroll
    for (int j = 0; j < 3; ++j) {
        const int pc = wu + 8 * j; goff[j] = 0;
        if (pc < 18) {
            const int c = (pc < 9 ? pc : pc - 9) * 64 + lane, lr = c / 9; int cc = c - lr * 9; if (cc == 8) cc = 0;
            if (pc < 9) { const int k32 = lr & 31, key = (lr & 32) + 16 * ((k32 >> 2) & 1) + (k32 & 3) + 4 * (k32 >> 3);
                goff[j] = (unsigned)OFF_PROJ + ((unsigned)(b * S_ + key) * 2048u + 512 + hd * 64 + cc * 8) * 2u; }
            else goff[j] = (unsigned)OFF_VST + ((unsigned)((b * 8 + hd) * 64 + lr) * (unsigned)S_ + cc * 8) * 2u;
        }
    }
    const char* wsb = uptr((const char*)p.ws);
#define SB_STAGE(KT, BUF) do { _Pragma("unroll") for (int _j = 0; _j < 3; ++_j) { const int _pc = wu + 8 * _j; if (_pc < 18) { \
        const unsigned _inc = goff[_j] >= (unsigned)OFF_VST ? 128u : 262144u; \
        __builtin_amdgcn_global_load_lds((const unsigned*)(wsb + (goff[_j] + (unsigned)(KT) * _inc)), (LAS unsigned*)(lds + (BUF) * SB_BUF + _pc * 1024), 16, 0, 0); } } } while (0)
    f32x16 o0[2], o1[2]; float carry[2]; bool done[2];
#pragma unroll
    for (int g = 0; g < 2; ++g) { o0[g] = zero16(); o1[g] = zero16(); carry[g] = 1.f; done[g] = false; }
    const int ktop = 8 * qb2 + 7;
    LAS int* flags = (LAS int*)(lds + SB_FLAGS);
    asm volatile("s_waitcnt vmcnt(0)" ::: "memory");
    __syncthreads();
    const int nstaged = ktop + 1 < SB_NB ? ktop + 1 : SB_NB;
    for (int i = 0; i < nstaged; ++i) SB_STAGE(ktop - i, i);
#define SB_WAITV(n) asm volatile("s_waitcnt vmcnt(" #n ") lgkmcnt(0)" ::: "memory")
    int cur = 0, it = 0;
    for (int kt = ktop; ; --kt, ++it) {
        if (lane == 0) flags[(it & 1) * 8 + wu] = (done[0] && done[1]) ? 1 : 0;
        int lowest = ktop - (SB_NB - 1) - (it > 0 ? it - 1 : 0); if (lowest < 0) lowest = 0;
        int ahead = kt - lowest; if (ahead < 0) ahead = 0;
        if (wu < 2) { switch (ahead) { case 0: SB_WAITV(0); break; case 1: SB_WAITV(3); break; case 2: SB_WAITV(6); break; case 3: SB_WAITV(9); break; case 4: SB_WAITV(12); break; case 5: SB_WAITV(15); break; default: SB_WAITV(18); break; } }
        else { switch (ahead) { case 0: SB_WAITV(0); break; case 1: SB_WAITV(2); break; case 2: SB_WAITV(4); break; case 3: SB_WAITV(6); break; case 4: SB_WAITV(8); break; case 5: SB_WAITV(10); break; default: SB_WAITV(12); break; } }
        __builtin_amdgcn_s_barrier();
        asm volatile("" ::: "memory");
        {
            const LAS int* f = flags + (it & 1) * 8;
            const int all = f[0] & f[1] & f[2] & f[3] & f[4] & f[5] & f[6] & f[7];
            if (__builtin_amdgcn_readfirstlane(all)) break;
        }
        if (it >= 1 && kt - (SB_NB - 1) >= 0) SB_STAGE(kt - (SB_NB - 1), cur == 0 ? SB_NB - 1 : cur - 1);
        {
            const LAS unsigned char* base = lds + cur * SB_BUF;
#pragma unroll
            for (int sub = 1; sub >= 0; --sub) {
                const int kb = kt * 64 + sub * 32;
                const LAS unsigned char* kp = base + (sub * 32 + r) * SB_ROW + h * 16;
                const bool act0 = !done[0] && kb <= q0[0], act1 = !done[1] && kb <= q0[1];
                if (act0 || act1) {
                    bf16x8 kf[4], vf[4];
#pragma unroll
                    for (int ks = 0; ks < 4; ++ks) kf[ks] = *(const LAS bf16x8*)(kp + ks * 32);
#pragma unroll
                    for (int dt = 0; dt < 2; ++dt)
#pragma unroll
                        for (int s2 = 0; s2 < 2; ++s2) vf[dt * 2 + s2] = *(const LAS bf16x8*)(base + SB_KBYTES + (dt * 32 + r) * SB_ROW + (sub * 32 + 16 * h + 8 * s2) * 2);
#pragma unroll
                    for (int g = 0; g < 2; ++g) {
                        if (g == 0 ? act0 : act1) {
                            f32x16 z = zero16();
#pragma unroll
                            for (int ks = 0; ks < 4; ++ks) z = MFMA32(kf[ks], qf[g][ks], z);
                            const bool diag = (kb == q0[g]);
                            f32x16 a;
                            float tot = 1.f;
#pragma unroll
                            for (int i = 15; i >= 0; --i) {
                                const float w = __builtin_amdgcn_exp2f(fminf(z[i], 86.f));
                                float be = __builtin_amdgcn_rcpf(1.f + w);
                                float om = w * be;
                                if (diag) { const bool valid = (16 * h + i < r); be = valid ? be : 0.f; om = valid ? om : 1.f; }
                                a[i] = be * tot;
                                tot *= om;
                            }
                            float tlo, thi; xhalf(tot, tlo, thi);
                            const float bs = carry[g] * (h == 0 ? thi : 1.f);
                            carry[g] *= tlo * thi;
#pragma unroll
                            for (int i = 0; i < 16; ++i) a[i] *= bs;
                            bf16x8 pf[2];
#pragma unroll
                            for (int s2 = 0; s2 < 2; ++s2) {
                                u32x4 w; w.x = pk2(a[8 * s2 + 0], a[8 * s2 + 1]); w.y = pk2(a[8 * s2 + 2], a[8 * s2 + 3]); w.z = pk2(a[8 * s2 + 4], a[8 * s2 + 5]); w.w = pk2(a[8 * s2 + 6], a[8 * s2 + 7]);
                                pf[s2] = __builtin_bit_cast(bf16x8, w);
                            }
#pragma unroll
                            for (int s2 = 0; s2 < 2; ++s2) { o0[g] = MFMA32(vf[s2], pf[s2], o0[g]); o1[g] = MFMA32(vf[2 + s2], pf[s2], o1[g]); }
                            if (__all(carry[g] < SB_PTHR)) done[g] = true;
                        }
                    }
                }
            }
            if (kt == 0) { done[0] = true; done[1] = true; }
        }
        cur = cur == SB_NB - 1 ? 0 : cur + 1;
    }
    asm volatile("s_waitcnt vmcnt(0)" ::: "memory");
#undef SB_WAITV
#undef SB_STAGE
#pragma unroll
    for (int g = 0; g < 2; ++g) {
        bf16_t* mix = (bf16_t*)(p.ws + OFF_MIX) + (tok0 + q0[g] + r) * 1024 + hd * 64 + 4 * h;
        float ss = 0.f;
#pragma unroll
        for (int gg = 0; gg < 4; ++gg) {
            { const float a0 = o0[g][4 * gg], a1 = o0[g][4 * gg + 1], a2 = o0[g][4 * gg + 2], a3 = o0[g][4 * gg + 3];
              ss += (a0 * a0 + a1 * a1) + (a2 * a2 + a3 * a3); u32x2 w; w.x = pk2(a0, a1); w.y = pk2(a2, a3); *(u32x2*)(mix + 8 * gg) = w; }
            { const float a0 = o1[g][4 * gg], a1 = o1[g][4 * gg + 1], a2 = o1[g][4 * gg + 2], a3 = o1[g][4 * gg + 3];
              ss += (a0 * a0 + a1 * a1) + (a2 * a2 + a3 * a3); u32x2 w; w.x = pk2(a0, a1); w.y = pk2(a2, a3); *(u32x2*)(mix + 32 + 8 * gg) = w; }
        }
        ss = xhalf_sum(ss);
        if (h == 0) ((float*)(p.ws + OFF_HSS))[(tok0 + q0[g] + r) * 16 + hd] = ss;
    }
}

DI void phase_attention(const Params& p, LAS unsigned char* lds, int tid, int which = 3) {
    const int blk = blockIdx.x, G = gridDim.x;
#ifndef NO_MLA
    if (which & 1) for (int it = blk; it < 512; it += G) {
        const int xcd = it & 7, local = (it >> 3) & 63;
        const int bh = xcd * 8 + (local >> 3), pr = local & 7;
        mla_block(p, lds, bh >> 2, bh & 3, pr, tid);
        mla_block(p, lds, bh >> 2, bh & 3, 15 - pr, tid);
    }
#endif
#ifndef NO_SB
    if (which & 2) for (int it = blk; it < 1024; it += G) {
        const int xcd = it & 7, local = (it >> 3) & 127;
        sb_block2(p, lds, xcd * 16 + (local >> 3), local & 7, tid);
    }
#endif
}

DI void phase_final(const Params& p, int tid) {
    const int wid = tid >> 6, lane = tid & 63;
    const float* pf = (const float*)(p.ws + OFF_PF);
    const bf16_t* h2b = (const bf16_t*)(p.ws + OFF_MIX);
    f32x4 ga[2], gb[2];
#pragma unroll
    for (int j = 0; j < 2; ++j) { ga[j] = *(const f32x4*)(p.g_final + j * 512 + lane * 8); gb[j] = *(const f32x4*)(p.g_final + j * 512 + lane * 8 + 4); }
    for (int row = blockIdx.x * 8 + wid; row < T_; row += gridDim.x * 8) {
        const f32x4* pp = (const f32x4*)(pf + (size_t)row * 16);
        u32x4 w[2];
#pragma unroll
        for (int j = 0; j < 2; ++j) w[j] = *(const u32x4*)(h2b + (size_t)row * 1024 + j * 512 + lane * 8);
        const float rs = rsqrtf(((sum4(pp[0]) + sum4(pp[1])) + (sum4(pp[2]) + sum4(pp[3]))) * (1.f / 1024.f) + EPS_);
        float* orow = p.out + (size_t)row * 1024 + lane * 8;
#pragma unroll
        for (int j = 0; j < 2; ++j) { f32x4 a, b; unpack8(w[j], a, b); *(f32x4*)(orow + j * 512) = a * rs * ga[j]; *(f32x4*)(orow + j * 512 + 4) = b * rs * gb[j]; }
    }
}

#define XB_TMO      128
#define XB_XCNT(j)  (256  + 64 * (j))
#define XB_XSUB(j)  (1280 + 64 * (j))
#define XB_XGEN(j)  (2304 + 64 * (j))
#define XB_TOP      3328
#define XB_TOPGEN   3392
#define XCD_BAR_WORDS 3456
#define XB_SPIN_CAP (1u << 18)
DI unsigned xb_ld(unsigned* p)              { return __hip_atomic_load(p, __ATOMIC_RELAXED, __HIP_MEMORY_SCOPE_AGENT); }
DI unsigned xb_add(unsigned* p, unsigned v) { return __hip_atomic_fetch_add(p, v, __ATOMIC_RELAXED, __HIP_MEMORY_SCOPE_AGENT); }
DI unsigned xb_xcc_id() { return (unsigned)__builtin_amdgcn_s_getreg((3 << 11) | 20) & 0xFu; }
#define XB_SPIN(cond, bar) do { unsigned _sp = 0; while (cond) { __builtin_amdgcn_s_sleep(1); \
    if ((++_sp & 255u) == 0u) { if (xb_ld(&(bar)[XB_TMO])) break; if (_sp > XB_SPIN_CAP) { atomicAdd(&(bar)[XB_TMO], 1u); break; } } } } while (0)
struct XcdBarrier { unsigned* bar; unsigned x; volatile LAS unsigned* st; };
DI XcdBarrier xcd_barrier_post(unsigned* bar, volatile LAS unsigned* st) {
    XcdBarrier b; b.bar = bar; b.x = xb_xcc_id(); b.st = st;
    if (threadIdx.x == 0) (void)xb_add(&bar[XB_XCNT(b.x)], 1u);
    return b;
}
DI void xcd_barrier_complete(unsigned* bar, unsigned x, unsigned& nloc, unsigned& nx) {
    const unsigned G = gridDim.x * gridDim.y * gridDim.z;
    unsigned sum, cnt, mine, sp = 0u;
    for (;;) {
        sum = 0u; cnt = 0u; mine = 0u;
#pragma unroll
        for (unsigned j = 0; j < 16; ++j) { const unsigned c = xb_ld(&bar[XB_XCNT(j)]); sum += c; cnt += (c > 0u) ? 1u : 0u; mine = (j == x) ? c : mine; }
        if (sum == G) break;
        __builtin_amdgcn_s_sleep(1);
        if ((++sp & 255u) == 0u) { if (xb_ld(&bar[XB_TMO])) break; if (sp > XB_SPIN_CAP) { atomicAdd(&bar[XB_TMO], 1u); break; } }
    }
    nloc = mine > 0u ? mine : 1u; nx = cnt > 0u ? cnt : 1u;
}
DI void xcd_barrier(const XcdBarrier& b) {
    asm volatile("s_waitcnt vmcnt(0)" ::: "memory");
    __syncthreads();
    if (threadIdx.x == 0) {
        unsigned* bar = b.bar;
        __builtin_amdgcn_s_waitcnt(0);
        unsigned nloc = b.st[0], nx = b.st[1];
        if (nloc == 0u) { xcd_barrier_complete(bar, b.x, nloc, nx); b.st[0] = nloc; b.st[1] = nx; }
        const unsigned old = xb_add(&bar[XB_XSUB(b.x)], 1u);
        const unsigned gen = old / nloc;
        if (old + 1u == (gen + 1u) * nloc) {
            __builtin_amdgcn_fence(__ATOMIC_RELEASE, "agent");
            asm volatile("s_waitcnt vmcnt(0)" ::: "memory");
            const unsigned og = xb_add(&bar[XB_TOP], 1u);
            const unsigned tg = og / nx;
            if (og + 1u == (tg + 1u) * nx) xb_add(&bar[XB_TOPGEN], 1u);
            else XB_SPIN(xb_ld(&bar[XB_TOPGEN]) == tg, bar);
            __builtin_amdgcn_fence(__ATOMIC_ACQUIRE, "agent");
            xb_add(&bar[XB_XGEN(b.x)], 1u);
            asm volatile("s_waitcnt vmcnt(0)" ::: "memory");
        } else {
            XB_SPIN(xb_ld(&bar[XB_XGEN(b.x)]) == gen, bar);
            __builtin_amdgcn_fence(__ATOMIC_ACQUIRE, "agent");
            asm volatile("s_waitcnt vmcnt(0)" ::: "memory");
        }
    }
    __syncthreads();
}

#ifndef PH_MASK
#define PH_MASK 255
#endif
#ifndef DUP_MASK
#define DUP_MASK 0
#endif
#ifndef DUP_WHICH
#define DUP_WHICH 3
#endif
constexpr int LDS_XB = g8::STAGE_BYTES + 8192;
constexpr int LDS_BYTES = g8::STAGE_BYTES + 8192 + 64;

__global__ void __launch_bounds__(512, 2) hymba_fwd(Params p) {
    extern __shared__ __attribute__((aligned(16))) unsigned char lds_raw[];
    LAS unsigned char* lds = (LAS unsigned char*)lds_raw;
    cg::grid_group grid = cg::this_grid();
    const int wid_s = __builtin_amdgcn_readfirstlane((int)threadIdx.x >> 6);
    unsigned char* ws = p.ws;

    volatile LAS unsigned* xst = (volatile LAS unsigned*)(lds + LDS_XB);
    if (threadIdx.x == 0) { xst[0] = 0u; xst[1] = 0u; }
    __syncthreads();
    const XcdBarrier xb = xcd_barrier_post((unsigned*)(ws + OFF_BAR), xst);
    if (p.out == nullptr) grid.sync();
    if (PH_MASK & 1) phase0(p, lds, fresh_tid(wid_s));
    xcd_barrier(xb);
    if (DUP_MASK & 1) { phase0(p, lds, fresh_tid(wid_s)); xcd_barrier(xb); }
    if (PH_MASK & 2) {
        LAS float* tab = (LAS float*)(lds + g8::STAGE_BYTES);
        EpiProj E{tab, (const float*)(ws + OFF_CS), (bf16_t*)(ws + OFF_PROJ), (bf16_t*)(ws + OFF_VST), (float*)(ws + OFF_PQ), (float*)(ws + OFF_PKV)};
        g8::gemm_phase<1, 1>(lds, wid_s, (const bf16_t*)(ws + OFF_XB), 1024, (const bf16_t*)(ws + OFF_WIN), 1024, T_, 2048, 1024, E, TabFill<RowRsx>{tab, wid_s, RowRsx{(const float*)(ws + OFF_RSX)}});
    }
    xcd_barrier(xb);
    if (PH_MASK & 4) {
        LAS float* tab = (LAS float*)(lds + g8::STAGE_BYTES);
        EpiQKV E{tab, (const float*)(ws + OFF_CS), (bf16_t*)(ws + OFF_QN), (bf16_t*)(ws + OFF_QR), (bf16_t*)(ws + OFF_KN), (bf16_t*)(ws + OFF_VMT)};
        g8::gemm_phase<1>(lds, wid_s, (const bf16_t*)(ws + OFF_PROJ) + 1536, 2048, (const bf16_t*)(ws + OFF_WQB), 256, T_, 1792, 256, E, TabFill<RowQKV>{tab, wid_s, RowQKV{(const float*)(ws + OFF_PQ), (const float*)(ws + OFF_PKV)}});
    }
    xcd_barrier(xb);
    if (PH_MASK & 8) phase_attention(p, lds, fresh_tid(wid_s));
    xcd_barrier(xb);
    if (DUP_MASK & 8) { phase_attention(p, lds, fresh_tid(wid_s), DUP_WHICH); xcd_barrier(xb); }
    if (PH_MASK & 16) {
        LAS float* tab = (LAS float*)(lds + g8::STAGE_BYTES);
        EpiOut E{tab, (const bf16_t*)(ws + OFF_XB), (bf16_t*)(ws + OFF_H1B), (float*)(ws + OFF_PH)};
        g8::gemm_phase<2>(lds, wid_s, (const bf16_t*)(ws + OFF_MIX), 1024, (const bf16_t*)(ws + OFF_WO), 1024, T_, 1024, 512, E, TabFill<RowOut>{tab, wid_s, RowOut{(const float*)(ws + OFF_HSS)}});
    }
    xcd_barrier(xb);
    for (int rep = 0; rep < ((DUP_MASK & 32) ? 2 : 1); ++rep) {
    if (rep) xcd_barrier(xb);
    if (PH_MASK & 32) {
        LAS float* rst = (LAS float*)(lds + g8::STAGE_BYTES);
        EpiUp E{rst, (bf16_t*)(ws + OFF_HID)};
        g8::gemm_phase<1>(lds, wid_s, (const bf16_t*)(ws + OFF_H1B), 1024, (const bf16_t*)(ws + OFF_WUP), 1024, T_, 4096, 1024, E, TabFill<RowUp>{rst, wid_s, RowUp{(const float*)(ws + OFF_PH)}});
    }
    }
    xcd_barrier(xb);
    if (PH_MASK & 64) {
        EpiDown E{(const bf16_t*)(ws + OFF_H1B), (bf16_t*)(ws + OFF_MIX), (float*)(ws + OFF_PF)};
        g8::gemm_phase<1>(lds, wid_s, (const bf16_t*)(ws + OFF_HID), 4096, (const bf16_t*)(ws + OFF_WDN), 4096, T_, 1024, 4096, E);
    }
    xcd_barrier(xb);
    if (PH_MASK & 128) phase_final(p, fresh_tid(wid_s));
}

extern "C" void kernel_launch(void* const* d_in, const int* in_sizes, int n_in, void* d_out, int out_size, void* d_ws, size_t ws_size, hipStream_t stream) {
    static int grid_blocks = 0;
    if (grid_blocks == 0) {
        if (n_in != 15 || in_sizes[0] != T_ * 1024 || out_size != T_ * 1024 || ws_size < WS_END) {
            fprintf(stderr, "kernel_launch: unexpected shapes (n_in %d, in0 %d, out %d, ws %zu < %zu)\n", n_in, n_in > 0 ? in_sizes[0] : -1, out_size, ws_size, (size_t)WS_END);
            grid_blocks = -1; return;
        }
        int dev = 0, cus = 0, per_cu = 0;
        hipGetDevice(&dev);
        hipDeviceGetAttribute(&cus, hipDeviceAttributeMultiprocessorCount, dev);
        if (hipFuncSetAttribute((const void*)hymba_fwd, hipFuncAttributeMaxDynamicSharedMemorySize, LDS_BYTES) != hipSuccess) fprintf(stderr, "kernel_launch: hipFuncSetAttribute failed\n");
        if (hipOccupancyMaxActiveBlocksPerMultiprocessor(&per_cu, (const void*)hymba_fwd, 512, LDS_BYTES) != hipSuccess || per_cu < 1) { fprintf(stderr, "kernel_launch: occupancy query gave %d\n", per_cu); per_cu = 1; }
        (void)hipGetLastError();
        grid_blocks = cus;
        if (grid_blocks != 256) fprintf(stderr, "kernel_launch: note: %d CUs (work maps assume 256)\n", grid_blocks);
    }
    if (grid_blocks < 0) return;
    Params p{};
    p.x = (const float*)d_in[0]; p.pos = (const int*)d_in[1]; p.g_attn = (const float*)d_in[2]; p.w_in = (const float*)d_in[3];
    p.g_qa = (const float*)d_in[4]; p.w_qb = (const float*)d_in[5]; p.g_kva = (const float*)d_in[6]; p.w_kvb = (const float*)d_in[7];
    p.g_sbo = (const float*)d_in[8]; p.g_mlao = (const float*)d_in[9]; p.w_o = (const float*)d_in[10]; p.g_mlp = (const float*)d_in[11];
    p.w_up = (const float*)d_in[12]; p.w_down = (const float*)d_in[13]; p.g_final = (const float*)d_in[14];
    p.out = (float*)d_out; p.ws = (unsigned char*)d_ws;
    (void)hipMemsetAsync((unsigned char*)d_ws + OFF_BAR, 0, XCD_BAR_WORDS * 4, stream);
    void* args[] = {&p};
    hipError_t e = hipLaunchCooperativeKernel((const void*)hymba_fwd, dim3(grid_blocks), dim3(512), args, LDS_BYTES, stream);
    if (e != hipSuccess) fprintf(stderr, "kernel_launch: cooperative launch failed: %s (grid %d)\n", hipGetErrorString(e), grid_blocks);
}
```

```cpp
#include <hip/hip_runtime.h>
#include <hip/hip_cooperative_groups.h>
#include <cstdio>
namespace cg = cooperative_groups;

#define LAS __attribute__((address_space(3)))
#define DI __device__ __forceinline__
typedef unsigned short bf16_t;
typedef short bf16x8 __attribute__((ext_vector_type(8)));
typedef float f32x2 __attribute__((ext_vector_type(2)));
typedef float f32x4 __attribute__((ext_vector_type(4)));
typedef float f32x16 __attribute__((ext_vector_type(16)));
typedef unsigned u32x4 __attribute__((ext_vector_type(4)));
typedef unsigned u32x2 __attribute__((ext_vector_type(2)));
typedef __bf16 bf2_t __attribute__((ext_vector_type(2)));

constexpr int T_ = 65536, S_ = 4096;
constexpr float EPS_ = 1e-6f;
constexpr float LOG2E = 1.4426950408889634f, LN2 = 0.6931471805599453f;
constexpr float MLA_QSCALE = 0.07216878364870322f * 1.4426950408889634f;
constexpr float SB_PTHR = 1e-37f;

constexpr size_t SZ_T = (size_t)T_;
constexpr size_t OFF_PROJ = 0;
constexpr size_t OFF_VST  = OFF_PROJ + SZ_T * 2048 * 2;
constexpr size_t OFF_QN   = OFF_VST + SZ_T * 512 * 2;
constexpr size_t OFF_QR   = OFF_QN + SZ_T * 512 * 2;
constexpr size_t OFF_KN   = OFF_QR + SZ_T * 256 * 2;
constexpr size_t OFF_VMT  = OFF_KN + SZ_T * 512 * 2;
constexpr size_t OFF_REGA_END = OFF_VMT + SZ_T * 512 * 2;
constexpr size_t OFF_HID  = 0;
constexpr size_t OFF_XB   = OFF_REGA_END;
constexpr size_t OFF_MIX  = OFF_XB + SZ_T * 1024 * 2;
constexpr size_t OFF_H1B  = OFF_MIX + SZ_T * 1024 * 2;
constexpr size_t OFF_WIN  = OFF_H1B + SZ_T * 1024 * 2;
constexpr size_t OFF_WQB  = OFF_WIN + (size_t)2048 * 1024 * 2;
constexpr size_t OFF_WKVB = OFF_WQB + (size_t)768 * 256 * 2;
constexpr size_t OFF_WO   = OFF_WKVB + (size_t)1024 * 256 * 2;
constexpr size_t OFF_WUP  = OFF_WO + (size_t)1024 * 1024 * 2;
constexpr size_t OFF_WDN  = OFF_WUP + (size_t)4096 * 1024 * 2;
constexpr size_t OFF_CS   = OFF_WDN + (size_t)4096 * 1024 * 2;
constexpr size_t OFF_RSX  = OFF_CS + SZ_T * 32 * 8;
constexpr size_t OFF_PQ   = OFF_RSX + SZ_T * 4;
constexpr size_t OFF_PKV  = OFF_PQ + SZ_T * 16;
constexpr size_t OFF_HSS  = OFF_PKV + SZ_T * 16;
constexpr size_t OFF_PH   = OFF_HSS + SZ_T * 64;
constexpr size_t OFF_PF   = OFF_PH + SZ_T * 64;
constexpr size_t OFF_BAR  = OFF_PF + SZ_T * 64;
constexpr size_t WS_END   = OFF_BAR + 16384;

struct Params {
    const float* x; const int* pos; const float* g_attn; const float* w_in; const float* g_qa; const float* w_qb;
    const float* g_kva; const float* w_kvb; const float* g_sbo; const float* g_mlao; const float* w_o; const float* g_mlp;
    const float* w_up; const float* w_down; const float* g_final;
    float* out; unsigned char* ws;
};

__device__ const float INV_FREQ[32] = {
    1.000000000e+00f, 7.498942018e-01f, 5.623413324e-01f, 4.216965139e-01f, 3.162277639e-01f, 2.371373773e-01f, 1.778279394e-01f, 1.333521456e-01f,
    1.000000015e-01f, 7.498942316e-02f, 5.623413250e-02f, 4.216964915e-02f, 3.162277490e-02f, 2.371373773e-02f, 1.778279431e-02f, 1.333521400e-02f,
    9.999999776e-03f, 7.498942316e-03f, 5.623413250e-03f, 4.216964822e-03f, 3.162277630e-03f, 2.371373819e-03f, 1.778279431e-03f, 1.333521446e-03f,
    1.000000047e-03f, 7.498941850e-04f, 5.623413017e-04f, 4.216965172e-04f, 3.162277571e-04f, 2.371373703e-04f, 1.778279402e-04f, 1.333521504e-04f};

DI unsigned pk2(float lo, float hi) { f32x2 v = {lo, hi}; bf2_t r = __builtin_convertvector(v, bf2_t); return __builtin_bit_cast(unsigned, r); }
DI u32x4 pack8(f32x4 a, f32x4 b) { u32x4 o; o.x = pk2(a.x, a.y); o.y = pk2(a.z, a.w); o.z = pk2(b.x, b.y); o.w = pk2(b.z, b.w); return o; }
DI void unpack8(u32x4 w, f32x4& a, f32x4& b) {
    a.x = __uint_as_float(w.x << 16); a.y = __uint_as_float(w.x & 0xffff0000u); a.z = __uint_as_float(w.y << 16); a.w = __uint_as_float(w.y & 0xffff0000u);
    b.x = __uint_as_float(w.z << 16); b.y = __uint_as_float(w.z & 0xffff0000u); b.z = __uint_as_float(w.w << 16); b.w = __uint_as_float(w.w & 0xffff0000u);
}
DI float sum4(f32x4 v) { return (v.x + v.y) + (v.z + v.w); }
DI float sq4(f32x4 v) { return (v.x * v.x + v.y * v.y) + (v.z * v.z + v.w * v.w); }
DI float wave_sum(float v) {
#pragma unroll
    for (int o = 1; o < 64; o <<= 1) v += __shfl_xor(v, o);
    return v;
}
DI f32x16 zero16() { f32x16 z; for (int i = 0; i < 16; ++i) z[i] = 0.f; return z; }
DI const char* uptr(const char* p) {
    const unsigned long long u = (unsigned long long)p;
    const unsigned lo = __builtin_amdgcn_readfirstlane((unsigned)u), hi = __builtin_amdgcn_readfirstlane((unsigned)(u >> 32));
    return (const char*)(((unsigned long long)hi << 32) | lo);
}
DI int fresh_tid(int wid_s) {
    int l; asm volatile("v_mbcnt_lo_u32_b32 %0, -1, 0\n\tv_mbcnt_hi_u32_b32 %0, -1, %0" : "=v"(l));
    return wid_s * 64 + l;
}
typedef unsigned u32x2p __attribute__((ext_vector_type(2)));
DI void xhalf(float x, float& lo, float& hi) { const u32x2p r = __builtin_amdgcn_permlane32_swap(__float_as_uint(x), __float_as_uint(x), false, false); lo = __uint_as_float(r.x); hi = __uint_as_float(r.y); }
DI float xhalf_max(float x) { float lo, hi; xhalf(x, lo, hi); return fmaxf(lo, hi); }
DI float xhalf_sum(float x) { float lo, hi; xhalf(x, lo, hi); return lo + hi; }
#define MFMA32(a, b, c) __builtin_amdgcn_mfma_f32_32x32x16_bf16((a), (b), (c), 0, 0, 0)

DI void p0_weight_item(const Params& p, LAS float* scr, int mid, int t, int lane) {
    const float* W; int K, N, Kpad; bf16_t* out;
    switch (mid) {
        case 0:  W = p.w_in;   K = 1024; N = 1984; Kpad = 1024; out = (bf16_t*)(p.ws + OFF_WIN); break;
        case 1:  W = p.w_qb;   K = 256;  N = 768;  Kpad = 256;  out = (bf16_t*)(p.ws + OFF_WQB); break;
        case 2:  W = p.w_kvb;  K = 128;  N = 1024; Kpad = 256;  out = (bf16_t*)(p.ws + OFF_WKVB); break;
        case 3:  W = p.w_o;    K = 1024; N = 1024; Kpad = 1024; out = (bf16_t*)(p.ws + OFF_WO); break;
        case 4:  W = p.w_up;   K = 1024; N = 4096; Kpad = 1024; out = (bf16_t*)(p.ws + OFF_WUP); break;
        default: W = p.w_down; K = 4096; N = 1024; Kpad = 4096; out = (bf16_t*)(p.ws + OFF_WDN); break;
    }
    const int nkt = Kpad / 64, k0 = (t % nkt) * 64, n0 = (t / nkt) * 32;
    const int nn = lane & 31, no = n0 + nn;
    int src = no; float sc = 1.f;
    if (mid == 0) {
        if (no < 512) sc = -0.125f * LOG2E;
        else if (no >= 1920) { if (no < 1984) { const int pp = no - 1920; src = 1920 + ((pp >> 2) & 1) * 32 + 4 * (pp >> 3) + (pp & 3); } else src = -1; }
    } else if (mid == 1) {
        sc = MLA_QSCALE;
        if (no < 512) src = (no >> 7) * 192 + (no & 127);
        else { const int q = no - 512, hd = q >> 6, pp = q & 63; src = hd * 192 + 128 + ((pp >> 2) & 1) * 32 + 4 * (pp >> 3) + (pp & 3); }
    }
#pragma unroll 8
    for (int i = 0; i < 32; ++i) {
        const int kk = 2 * i + (lane >> 5), k = k0 + kk;
        float gv = 1.f; bool ok = src >= 0;
        if (mid == 0) gv = p.g_attn[k];
        else if (mid == 1) gv = p.g_qa[k];
        else if (mid == 2) { if (k >= K) ok = false; else gv = p.g_kva[k]; }
        else if (mid == 3) gv = (k < 512) ? p.g_sbo[k] : p.g_mlao[k - 512];
        else if (mid == 4) gv = p.g_mlp[k];
        float val = 0.f;
        if (ok) val = W[(size_t)k * N + src] * gv * sc;
        scr[kk * 33 + nn] = val;
    }
    asm volatile("s_waitcnt lgkmcnt(0)" ::: "memory");
    {
        const int c = lane & 7;
#pragma unroll
        for (int j = 0; j < 4; ++j) {
            const int n = (lane >> 3) + 8 * j; const LAS float* sp = scr + (8 * c) * 33 + n;
            u32x4 o; o.x = pk2(sp[0], sp[33]); o.y = pk2(sp[2 * 33], sp[3 * 33]); o.z = pk2(sp[4 * 33], sp[5 * 33]); o.w = pk2(sp[6 * 33], sp[7 * 33]);
            *(u32x4*)(out + (size_t)(n0 + n) * Kpad + k0 + 8 * c) = o;
        }
    }
    asm volatile("s_waitcnt lgkmcnt(0)" ::: "memory");
}

DI void phase0(const Params& p, LAS unsigned char* lds, int tid) {
    const int G = gridDim.x, blk = blockIdx.x;
    const int wid = tid >> 6, lane = tid & 63;
    {
        LAS float* scr = (LAS float*)(lds + wid * 8448);
        constexpr int C0 = 1024, C1 = C0 + 96, C2 = C1 + 128, C3 = C2 + 512, C4 = C3 + 2048, C5 = C4 + 2048;
        for (int it = blk * 8 + wid; it < C5; it += G * 8) {
            if (it < C0) p0_weight_item(p, scr, 0, it, lane);
            else if (it < C1) p0_weight_item(p, scr, 1, it - C0, lane);
            else if (it < C2) p0_weight_item(p, scr, 2, it - C1, lane);
            else if (it < C3) p0_weight_item(p, scr, 3, it - C2, lane);
            else if (it < C4) p0_weight_item(p, scr, 4, it - C3, lane);
            else p0_weight_item(p, scr, 5, it - C4, lane);
        }
    }
    float* rsx = (float*)(p.ws + OFF_RSX);
    bf16_t* xb = (bf16_t*)(p.ws + OFF_XB);
    f32x2* cs = (f32x2*)(p.ws + OFF_CS);
    int cidx = blk * 512 + tid;
    int posv = p.pos[cidx >> 5];
    for (int row = blk * 8 + wid; row < T_; row += G * 8) {
        const f32x4* xr = (const f32x4*)(p.x + (size_t)row * 1024) + lane;
        f32x4 v[4]; float s = 0.f;
#pragma unroll
        for (int j = 0; j < 4; ++j) v[j] = __builtin_nontemporal_load(xr + 64 * j);
        f32x2 cv; const bool docs = cidx < T_ * 32;
        if (docs) {
            const int i = cidx & 31;
            const float ang = (float)posv * INV_FREQ[i];
            const double rev = (double)ang * 0.15915494309189535;
            const float fr = (float)(rev - __builtin_rint(rev));
            cv.x = __builtin_amdgcn_cosf(fr); cv.y = __builtin_amdgcn_sinf(fr);
        }
#pragma unroll
        for (int j = 0; j < 4; ++j) s += sq4(v[j]);
        s = wave_sum(s);
        if (lane == 0) rsx[row] = rsqrtf(s * (1.f / 1024.f) + EPS_);
        u32x2* o = (u32x2*)(xb + (size_t)row * 1024) + lane;
#pragma unroll
        for (int j = 0; j < 4; ++j) { u32x2 w; w.x = pk2(v[j].x, v[j].y); w.y = pk2(v[j].z, v[j].w); o[64 * j] = w; }
        if (docs) { cs[cidx] = cv; cidx += G * 512; if (cidx < T_ * 32) posv = p.pos[cidx >> 5]; }
    }
    for (; cidx < T_ * 32; cidx += G * 512) {
        const int t = cidx >> 5, i = cidx & 31;
        const float ang = (float)p.pos[t] * INV_FREQ[i];
        const double rev = (double)ang * 0.15915494309189535;
        const float fr = (float)(rev - __builtin_rint(rev));
        f32x2 v; v.x = __builtin_amdgcn_cosf(fr); v.y = __builtin_amdgcn_sinf(fr);
        cs[cidx] = v;
    }
}

namespace g8 {
constexpr int BM = 256, BK = 64, HALF = 128, HTB = HALF * BK * 2, STAGE_BYTES = 8 * HTB, NXCD = 8, WGM = 8;
DI int lds_byte(int r, int c) { const int st = (r >> 4) * 2 + (c >> 5), rr = r & 15, cc = c & 31, ob = rr * 64 + cc * 2; return st * 1024 + (ob ^ (((ob >> 9) & 1) << 5)); }
DI void stage_rc(int b, int& R, int& C) { const int st = b / 1024, sb = b % 1024, swz = sb ^ (((sb >> 9) & 1) << 5); R = (st >> 1) * 16 + swz / 64; C = (st & 1) * 32 + (swz % 64) / 2; }
DI int perm32(int rho) { const int n = rho >> 4, i = rho & 15; return 8 * (i >> 2) + 4 * n + (i & 3); }
struct Unit { int pm, pn, kh; };

template <int NKH, int ROT = 0>
DI bool next_unit(int i, int nM, int nN, Unit& u) {
    int ti = i / NKH; u.kh = i % NKH;
    const int nwg = nM * nN;
    if ((long)ti * gridDim.x + blockIdx.x >= nwg) return false;
    if (ROT == 2) ti = (nwg + (int)gridDim.x - 1) / (int)gridDim.x - 1 - ti;
    const long L = (long)ti * gridDim.x + blockIdx.x; if (L >= nwg) return false;
    int wgid = (int)L; { const int q = nwg / NXCD, r = nwg % NXCD, xcd = wgid % NXCD, off = wgid / NXCD; wgid = (xcd < r ? xcd * (q + 1) : r * (q + 1) + (xcd - r) * q) + off; }
    const int nig = WGM * nN, gid = wgid / nig, fm = gid * WGM, gsz = (nM - fm) < WGM ? (nM - fm) : WGM;
    u.pm = fm + ((wgid % nig) % gsz); u.pn = (wgid % nig) / gsz;
    if (ROT == 1) u.pn = (u.pn & 4) | ((u.pn + (ti >> 1)) & 3);
    return true;
}

struct NoPre { DI void operator()() const {} };
template <int NKH, int ROT = 0, class Epi, class Pre = NoPre>
DI void gemm_phase(LAS unsigned char* lds, int wid_s, const bf16_t* A, int lda, const bf16_t* Bt, int ldb, int M, int N, int Kc, const Epi& E, const Pre& pre = Pre()) {
    const int tid = fresh_tid(wid_s);
    const int wid = __builtin_amdgcn_readfirstlane(tid >> 6), lane = tid & 63, wr = wid >> 2, wc = wid & 3, fr = lane & 15, fq = lane >> 4;
    const int nt = Kc / BK, nM = M / BM, nN = N / BM;
    unsigned voffA[2], voffB[2];
#pragma unroll
    for (int i = 0; i < 2; ++i) { int R, C; stage_rc(tid * 16 + i * 8192, R, C); const int Rb = (R & ~31) + perm32(R & 31);
        voffA[i] = (unsigned)(R * lda + C) * 2u; voffB[i] = (unsigned)(Rb * ldb + C) * 2u; }
    const size_t kstep = (size_t)(BK * 2);
    const size_t hstepA = (size_t)HALF * lda * 2, hstepB = (size_t)HALF * ldb * 2;
    const size_t tstepA = 2 * hstepA, tstepB = 2 * hstepB, kchunk = (size_t)Kc * 2;
    const unsigned ldsw = (unsigned)wid * 1024u;
    const int aoff = lds_byte(wr * 64 + fr, fq * 8), boff = lds_byte(wc * 32 + fr, fq * 8);
#define G8_SA(b, h) (((b) * 2 + (h)) * HTB)
#define G8_SB(b, h) ((4 + (b) * 2 + (h)) * HTB)
#define G8_STAGE(bufoff, gbase, voff) do { const char* _gb = uptr((const char*)(gbase)); _Pragma("unroll") for (int _i = 0; _i < 2; ++_i) \
        __builtin_amdgcn_global_load_lds((const unsigned*)(_gb + (voff)[_i]), (LAS unsigned*)(lds + (bufoff) + ldsw + _i * 8192), 16, 0, 0); } while (0)
#define G8_LDA(dst, b, h) do { _Pragma("unroll") for (int m = 0; m < 4; ++m) _Pragma("unroll") for (int k = 0; k < 2; ++k) dst[m][k] = *(const LAS bf16x8*)(lds + G8_SA(b, h) + aoff + m * 2048 + k * 1024); } while (0)
#define G8_LDB(dst, b, h) do { _Pragma("unroll") for (int n = 0; n < 2; ++n) _Pragma("unroll") for (int k = 0; k < 2; ++k) dst[n][k] = *(const LAS bf16x8*)(lds + G8_SB(b, h) + boff + n * 2048 + k * 1024); } while (0)
#define G8_MMA(ai, bj, At, Bt_) do { __builtin_amdgcn_s_setprio(1); _Pragma("unroll") for (int m = 0; m < 4; ++m) _Pragma("unroll") for (int n = 0; n < 2; ++n) _Pragma("unroll") for (int k = 0; k < 2; ++k) \
        acc[ai][bj][m][n] = __builtin_amdgcn_mfma_f32_16x16x32_bf16(Bt_[n][k], At[m][k], acc[ai][bj][m][n], 0, 0, 0); __builtin_amdgcn_s_setprio(0); } while (0)
#define G8_WAIT_V(n) asm volatile("s_waitcnt vmcnt(" #n ")" ::: "memory")
#define G8_WAIT_L(n) asm volatile("s_waitcnt lgkmcnt(" #n ")" ::: "memory")
#define G8_BAR __builtin_amdgcn_s_barrier()
#define G8_SCHED __builtin_amdgcn_sched_barrier(0)
    Unit cur, nxt; int ui = 0;
    if (!next_unit<NKH, ROT>(0, nM, nN, cur)) return;
    f32x4 acc[2][2][4][2];
#pragma unroll
    for (int a = 0; a < 2; ++a)
#pragma unroll
        for (int b = 0; b < 2; ++b)
#pragma unroll
            for (int m = 0; m < 4; ++m)
#pragma unroll
                for (int n = 0; n < 2; ++n) acc[a][b][m][n] = (f32x4){0.f, 0.f, 0.f, 0.f};
    bf16x8 At[4][2], B0[2][2], B1[2][2];
    const char* cA = uptr((const char*)A + (size_t)cur.pm * tstepA + (size_t)cur.kh * kchunk + E.a_off(cur.pn));
    const char* cB = uptr((const char*)Bt + (size_t)cur.pn * tstepB + (size_t)cur.kh * kchunk);
    G8_STAGE(G8_SB(0, 0), cB, voffB); G8_STAGE(G8_SA(0, 0), cA, voffA); G8_STAGE(G8_SB(0, 1), cB + hstepB, voffB); G8_STAGE(G8_SA(0, 1), cA + hstepA, voffA);
    pre();
    if (wr == 1) G8_BAR;
    G8_WAIT_V(4); G8_BAR;
    G8_STAGE(G8_SB(1, 0), cB + kstep, voffB); G8_STAGE(G8_SA(1, 0), cA + kstep, voffA); G8_STAGE(G8_SB(1, 1), cB + hstepB + kstep, voffB);
    G8_WAIT_V(6); G8_BAR;
    for (;;) {
        const bool has_next = next_unit<NKH, ROT>(ui + 1, nM, nN, nxt);
        const char* nA = uptr(has_next ? (const char*)A + (size_t)nxt.pm * tstepA + (size_t)nxt.kh * kchunk + E.a_off(nxt.pn) : cA);
        const char* nB = uptr(has_next ? (const char*)Bt + (size_t)nxt.pn * tstepB + (size_t)nxt.kh * kchunk : cB);
        for (int t = 0; t < nt; t += 2) {
            const bool last = (t == nt - 2);
            const char* a1 = cA + (size_t)(t + 1) * kstep;
            const char* a2 = last ? nA : cA + (size_t)(t + 2) * kstep; const char* b2 = last ? nB : cB + (size_t)(t + 2) * kstep;
            const char* a3 = a2 + kstep; const char* b3 = b2 + kstep;
            G8_LDB(B0, 0, 0); G8_SCHED; G8_LDA(At, 0, 0); G8_STAGE(G8_SA(1, 1), a1 + hstepA, voffA);
            G8_WAIT_L(8); G8_BAR; G8_WAIT_L(0); G8_MMA(0, 0, At, B0); G8_BAR; G8_SCHED;
            G8_LDB(B1, 0, 1); G8_STAGE(G8_SB(0, 0), b2, voffB);
            G8_BAR; G8_WAIT_L(0); G8_MMA(0, 1, At, B1); G8_BAR;
            G8_LDA(At, 0, 1); G8_STAGE(G8_SA(0, 0), a2, voffA);
            G8_BAR; G8_WAIT_L(0); G8_MMA(1, 0, At, B0); G8_BAR; G8_SCHED;
            G8_STAGE(G8_SB(0, 1), b2 + hstepB, voffB);
            G8_WAIT_V(6); G8_BAR; G8_MMA(1, 1, At, B1); G8_BAR;
            G8_LDB(B0, 1, 0); G8_SCHED; G8_LDA(At, 1, 0); G8_STAGE(G8_SA(0, 1), a2 + hstepA, voffA);
            G8_WAIT_L(8); G8_BAR; G8_WAIT_L(0); G8_MMA(0, 0, At, B0); G8_BAR; G8_SCHED;
            G8_LDB(B1, 1, 1); G8_STAGE(G8_SB(1, 0), b3, voffB);
            G8_BAR; G8_WAIT_L(0); G8_MMA(0, 1, At, B1); G8_BAR;
            G8_LDA(At, 1, 1); G8_STAGE(G8_SA(1, 0), a3, voffA);
            G8_BAR; G8_WAIT_L(0); G8_MMA(1, 0, At, B0); G8_BAR; G8_SCHED;
            G8_STAGE(G8_SB(1, 1), b3 + hstepB, voffB);
            G8_WAIT_V(6); G8_BAR; G8_MMA(1, 1, At, B1); G8_BAR;
        }
        { int l2 = lane; asm volatile("" : "+v"(l2)); E(acc, cur, wr, wc, l2 & 15, l2 >> 4); }
        if (!has_next) break;
        if (cur.kh == NKH - 1) {
#pragma unroll
            for (int a = 0; a < 2; ++a)
#pragma unroll
                for (int b = 0; b < 2; ++b)
#pragma unroll
                    for (int m = 0; m < 4; ++m)
#pragma unroll
                        for (int n = 0; n < 2; ++n) acc[a][b][m][n] = (f32x4){0.f, 0.f, 0.f, 0.f};
        }
        cur = nxt; cA = nA; cB = nB; ++ui;
    }
    G8_WAIT_V(0);
    if (wr == 0) G8_BAR;
    G8_BAR;
#undef G8_SA
#undef G8_SB
#undef G8_STAGE
#undef G8_LDA
#undef G8_LDB
#undef G8_MMA
#undef G8_WAIT_V
#undef G8_WAIT_L
#undef G8_BAR
#undef G8_SCHED
}
}
using g8::Unit;
typedef f32x4 AccT[2][2][4][2];

DI void rope8(f32x4& v0, f32x4& v1, const f32x4 ca, const f32x4 cb) {
    f32x4 o1, o2;
    o1.x = v0.x * ca.x - v1.x * ca.y; o2.x = v1.x * ca.x + v0.x * ca.y;
    o1.y = v0.y * ca.z - v1.y * ca.w; o2.y = v1.y * ca.z + v0.y * ca.w;
    o1.z = v0.z * cb.x - v1.z * cb.y; o2.z = v1.z * cb.x + v0.z * cb.y;
    o1.w = v0.w * cb.z - v1.w * cb.w; o2.w = v1.w * cb.z + v0.w * cb.w;
    v0 = o1; v1 = o2;
}
DI void store_tr8(bf16_t* base, f32x4 v0, f32x4 v1) {
    base[0 * S_] = (bf16_t)pk2(v0.x, 0.f); base[1 * S_] = (bf16_t)pk2(v0.y, 0.f); base[2 * S_] = (bf16_t)pk2(v0.z, 0.f); base[3 * S_] = (bf16_t)pk2(v0.w, 0.f);
    base[4 * S_] = (bf16_t)pk2(v1.x, 0.f); base[5 * S_] = (bf16_t)pk2(v1.y, 0.f); base[6 * S_] = (bf16_t)pk2(v1.z, 0.f); base[7 * S_] = (bf16_t)pk2(v1.w, 0.f);
}

template <class F>
DI void fill_row_tables(LAS float* tab, int wid_s, const F& f) {
    const int t2 = fresh_tid(wid_s), bx = blockIdx.x & 7, bj8 = (blockIdx.x >> 3) & 7;
    for (int idx = t2; idx < 1024; idx += 512) {
        const int row = (8 * (4 * bx + (idx >> 8)) + bj8) * 256 + (idx & 255);
        const f32x2 v = f(row); tab[idx] = v.x; tab[1024 + idx] = v.y;
    }
    __syncthreads();
}
template <class F> struct TabFill {
    LAS float* tab; int wid_s; F f;
    DI void operator()() const {
        const int t2 = fresh_tid(wid_s), bx = blockIdx.x & 7, bj8 = (blockIdx.x >> 3) & 7;
        for (int idx = t2; idx < 1024; idx += 512) {
            const int row = (8 * (4 * bx + (idx >> 8)) + bj8) * 256 + (idx & 255);
            const f32x2 v = f(row); tab[idx] = v.x; tab[1024 + idx] = v.y;
        }
    }
};
struct RowRsx { const float* rsx; DI f32x2 operator()(int row) const { f32x2 v; v.x = rsx[row]; v.y = 0.f; return v; } };
struct RowQKV { const float* pq; const float* pkv; DI f32x2 operator()(int row) const { f32x2 v;
    v.x = rsqrtf(sum4(*(const f32x4*)(pq + (size_t)row * 4)) * (1.f / 256.f) + EPS_); v.y = rsqrtf(sum4(*(const f32x4*)(pkv + (size_t)row * 4)) * (1.f / 128.f) + EPS_); return v; } };
struct RowOut { const float* hss; DI f32x2 operator()(int row) const { const float* hp = hss + (size_t)row * 16; f32x2 v;
    const float rml = rsqrtf(sum4(*(const f32x4*)(hp + 8)) * (1.f / 512.f) + EPS_), rsb = rsqrtf((sum4(*(const f32x4*)hp) + sum4(*(const f32x4*)(hp + 4))) * (1.f / 512.f) + EPS_);
    v.x = rsb / rml; v.y = rml; return v; } };
struct RowUp { const float* ph; DI f32x2 operator()(int row) const { const f32x4* pp = (const f32x4*)(ph + (size_t)row * 16); f32x2 v;
    v.x = rsqrtf(((sum4(pp[0]) + sum4(pp[1])) + (sum4(pp[2]) + sum4(pp[3]))) * (1.f / 1024.f) + EPS_); v.y = 0.f; return v; } };
#define EPI_TAB(tab, which, i) ((tab)[(which) * 1024 + ((u.pm >> 3) & 3) * 256 + wr * 64 + fr + ((i) >> 2) * 128 + ((i) & 3) * 16])
#define EPI_ROW(ai, m) (u.pm * 256 + (ai) * 128 + wr * 64 + (m) * 16 + fr)
struct EpiProj {
    DI int a_off(int) const { return 0; }
    const LAS float* tab; const float* cs; bf16_t* proj; bf16_t* vst; float* pq; float* pkv;
    DI void operator()(AccT& acc, const Unit& u, int wr, int wc, int fr, int fq) const {
        const int pn = u.pn;
        float rsv[8];
#pragma unroll
        for (int i = 0; i < 8; ++i) rsv[i] = EPI_TAB(tab, 0, i);
        const bool do_rope = (pn == 7 && wc < 2);
        f32x4 rca[8], rcb[8];
        if (do_rope) {
#pragma unroll
            for (int i = 0; i < 8; ++i) { const float* cr = cs + (size_t)EPI_ROW(i >> 2, i & 3) * 64 + 2 * (16 * wc + 4 * fq); rca[i] = *(const f32x4*)cr; rcb[i] = *(const f32x4*)(cr + 4); }
        }
#pragma unroll
        for (int ai = 0; ai < 2; ++ai)
#pragma unroll
            for (int m = 0; m < 4; ++m) {
                const int row = EPI_ROW(ai, m);
                const float rs = rsv[ai * 4 + m]; float ss = 0.f;
#pragma unroll
                for (int bj = 0; bj < 2; ++bj) {
                    f32x4 v0 = acc[ai][bj][m][0] * rs, v1 = acc[ai][bj][m][1] * rs;
                    const int cl = bj * 128 + wc * 32 + fq * 8;
                    if (do_rope && bj == 1) rope8(v0, v1, rca[ai * 4 + m], rcb[ai * 4 + m]);
                    if (pn == 6 || (pn == 7 && bj == 0)) ss += sq4(v0) + sq4(v1);
                    if (pn == 4 || pn == 5) {
                        const int dg = (pn - 4) * 256 + cl, hd = dg >> 6, d = dg & 63, b = row >> 12, s = row & 4095;
                        store_tr8(vst + ((size_t)(b * 8 + hd) * 64 + d) * S_ + s, v0, v1);
                    } else {
                        *(u32x4*)(proj + (size_t)row * 2048 + pn * 256 + cl) = pack8(v0, v1);
                    }
                }
                if (pn >= 6) { ss += __shfl_xor(ss, 16); ss = xhalf_sum(ss); if (fq == 0) (pn == 6 ? pq : pkv)[(size_t)row * 4 + wc] = ss; }
            }
    }
};
struct EpiQKV {
    const LAS float* tab; const float* cs; bf16_t* qn; bf16_t* qr; bf16_t* kn; bf16_t* vmt;
    DI int a_off(int pn) const { return pn >= 3 ? 512 : 0; }
    DI void operator()(AccT& acc, const Unit& u, int wr, int wc, int fr, int fq) const {
        const int pn = u.pn;
        const int wh = pn < 3 ? 0 : 1;
        float rsv[8];
#pragma unroll
        for (int i = 0; i < 8; ++i) rsv[i] = EPI_TAB(tab, wh, i);
        f32x4 rca[8], rcb[8];
        if (pn == 2) {
#pragma unroll
            for (int i = 0; i < 8; ++i) { const float* cr = cs + (size_t)EPI_ROW(i >> 2, i & 3) * 64 + 2 * (4 * ((((wc & 1) * 32 + fq * 8)) >> 3)); rca[i] = *(const f32x4*)cr; rcb[i] = *(const f32x4*)(cr + 4); }
        }
#pragma unroll
        for (int ai = 0; ai < 2; ++ai)
#pragma unroll
            for (int m = 0; m < 4; ++m) {
                const int row = EPI_ROW(ai, m);
                const float rs = rsv[ai * 4 + m];
                if (pn < 3) {
#pragma unroll
                    for (int bj = 0; bj < 2; ++bj) {
                        f32x4 v0 = acc[ai][bj][m][0] * rs, v1 = acc[ai][bj][m][1] * rs;
                        const int cl = bj * 128 + wc * 32 + fq * 8;
                        if (pn < 2) *(u32x4*)(qn + (size_t)row * 512 + pn * 256 + cl) = pack8(v0, v1);
                        else { rope8(v0, v1, rca[ai * 4 + m], rcb[ai * 4 + m]); *(u32x4*)(qr + (size_t)row * 256 + cl) = pack8(v0, v1); }
                    }
                } else {
                    const int hd = pn - 3;
                    const int cl = wc * 32 + fq * 8, b = row >> 12, s = row & 4095;
                    { f32x4 v0 = acc[ai][0][m][0] * rs, v1 = acc[ai][0][m][1] * rs; *(u32x4*)(kn + (size_t)row * 512 + hd * 128 + cl) = pack8(v0, v1); }
                    { f32x4 v0 = acc[ai][1][m][0] * rs, v1 = acc[ai][1][m][1] * rs; store_tr8(vmt + ((size_t)(b * 4 + hd) * 128 + cl) * S_ + s, v0, v1); }
                }
            }
    }
};
struct EpiOut {
    DI int a_off(int) const { return 0; }
    const LAS float* tab; const bf16_t* xb; bf16_t* h1b; float* ph;
    DI void operator()(AccT& acc, const Unit& u, int wr, int wc, int fr, int fq) const {
        float rsv[8];
        const int wh = u.kh == 0 ? 0 : 1;
#pragma unroll
        for (int i = 0; i < 8; ++i) rsv[i] = EPI_TAB(tab, wh, i);
        if (u.kh == 0) {
#pragma unroll
            for (int ai = 0; ai < 2; ++ai)
#pragma unroll
                for (int m = 0; m < 4; ++m)
#pragma unroll
                    for (int bj = 0; bj < 2; ++bj) { acc[ai][bj][m][0] *= rsv[ai * 4 + m]; acc[ai][bj][m][1] *= rsv[ai * 4 + m]; }
            return;
        }
        u32x4 res[8][2];
#pragma unroll
        for (int i = 0; i < 8; ++i)
#pragma unroll
            for (int bj = 0; bj < 2; ++bj) res[i][bj] = *(const u32x4*)(xb + (size_t)EPI_ROW(i >> 2, i & 3) * 1024 + u.pn * 256 + bj * 128 + wc * 32 + fq * 8);
#pragma unroll
        for (int ai = 0; ai < 2; ++ai)
#pragma unroll
            for (int m = 0; m < 4; ++m) {
                const int row = EPI_ROW(ai, m);
                const float rml = rsv[ai * 4 + m];
                float ss = 0.f;
#pragma unroll
                for (int bj = 0; bj < 2; ++bj) {
                    const size_t off = (size_t)row * 1024 + u.pn * 256 + bj * 128 + wc * 32 + fq * 8;
                    f32x4 r0, r1; unpack8(res[ai * 4 + m][bj], r0, r1);
                    const f32x4 v0 = acc[ai][bj][m][0] * rml + r0, v1 = acc[ai][bj][m][1] * rml + r1;
                    *(u32x4*)(h1b + off) = pack8(v0, v1);
                    ss += sq4(v0) + sq4(v1);
                }
                ss += __shfl_xor(ss, 16); ss = xhalf_sum(ss);
                if (fq == 0) ph[(size_t)row * 16 + u.pn * 4 + wc] = ss;
            }
    }
};
struct EpiUp {
    DI int a_off(int) const { return 0; }
    const LAS float* rst; bf16_t* hid;
    DI void operator()(AccT& acc, const Unit& u, int wr, int wc, int fr, int fq) const {
        float rsv[8];
#pragma unroll
        for (int i = 0; i < 8; ++i) rsv[i] = EPI_TAB(rst, 0, i);
#pragma unroll
        for (int ai = 0; ai < 2; ++ai)
#pragma unroll
            for (int m = 0; m < 4; ++m) {
                const int row = EPI_ROW(ai, m);
                const float rs = rsv[ai * 4 + m];
#pragma unroll
                for (int bj = 0; bj < 2; ++bj) {
                    f32x4 v0 = acc[ai][bj][m][0] * rs, v1 = acc[ai][bj][m][1] * rs;
#pragma unroll
                    for (int e = 0; e < 4; ++e) { const float a = fmaxf(v0[e], 0.f), b = fmaxf(v1[e], 0.f); v0[e] = a * a; v1[e] = b * b; }
                    *(u32x4*)(hid + (size_t)row * 4096 + u.pn * 256 + bj * 128 + wc * 32 + fq * 8) = pack8(v0, v1);
                }
            }
    }
};
struct EpiDown {
    DI int a_off(int) const { return 0; }
    const bf16_t* h1b; bf16_t* h2b; float* pf;
    DI void operator()(AccT& acc, const Unit& u, int wr, int wc, int fr, int fq) const {
        u32x4 res[8][2];
#pragma unroll
        for (int i = 0; i < 8; ++i)
#pragma unroll
            for (int bj = 0; bj < 2; ++bj) res[i][bj] = *(const u32x4*)(h1b + (size_t)EPI_ROW(i >> 2, i & 3) * 1024 + u.pn * 256 + bj * 128 + wc * 32 + fq * 8);
#pragma unroll
        for (int ai = 0; ai < 2; ++ai)
#pragma unroll
            for (int m = 0; m < 4; ++m) {
                const int row = EPI_ROW(ai, m);
                float ss = 0.f;
#pragma unroll
                for (int bj = 0; bj < 2; ++bj) {
                    const size_t off = (size_t)row * 1024 + u.pn * 256 + bj * 128 + wc * 32 + fq * 8;
                    f32x4 r0, r1; unpack8(res[ai * 4 + m][bj], r0, r1);
                    const f32x4 v0 = acc[ai][bj][m][0] + r0, v1 = acc[ai][bj][m][1] + r1;
                    *(u32x4*)(h2b + off) = pack8(v0, v1);
                    ss += sq4(v0) + sq4(v1);
                }
                ss += __shfl_xor(ss, 16); ss = xhalf_sum(ss);
                if (fq == 0) pf[(size_t)row * 16 + u.pn * 4 + wc] = ss;
            }
    }
};

constexpr int MLA_KROW = 400, MLA_VROW = 144, MLA_KBYTES = 64 * MLA_KROW, MLA_BUF = MLA_KBYTES + 128 * MLA_VROW;

DI void mla_s_softmax(const LAS unsigned char* base, int r, int h, bool is_diag, int lim, const bf16x8 (&qf)[12], f32x16 (&o)[4], float& m_run, float& l_run,
                      bf16x8 (&pf0)[2], bf16x8 (&pf1)[2]) {
    f32x16 s0 = zero16(), s1 = zero16();
    const LAS unsigned char* kp = base + r * MLA_KROW + h * 16;
#pragma unroll
    for (int g = 0; g < 3; ++g) {
        bf16x8 fa[4], fb[4];
#pragma unroll
        for (int j = 0; j < 4; ++j) { fa[j] = *(const LAS bf16x8*)(kp + (4 * g + j) * 32); fb[j] = *(const LAS bf16x8*)(kp + 32 * MLA_KROW + (4 * g + j) * 32); }
        __builtin_amdgcn_sched_barrier(0);
#pragma unroll
        for (int j = 0; j < 4; ++j) { s0 = MFMA32(fa[j], qf[4 * g + j], s0); s1 = MFMA32(fb[j], qf[4 * g + j], s1); }
        __builtin_amdgcn_sched_barrier(0);
    }
    if (is_diag) {
#pragma unroll
        for (int i = 0; i < 16; ++i) { if (16 * h + i > lim) s0[i] = -1e30f; if (32 + 16 * h + i > lim) s1[i] = -1e30f; }
    }
    float mx = fmaxf(s0[0], s1[0]);
#pragma unroll
    for (int i = 1; i < 16; ++i) mx = fmaxf(mx, fmaxf(s0[i], s1[i]));
    mx = xhalf_max(mx);
    const float mnew = fmaxf(m_run, mx);
    if (__builtin_amdgcn_ballot_w64(mnew > m_run + 8.0f) != 0ull) {
        const float alpha = __builtin_amdgcn_exp2f(m_run - mnew);
        l_run *= alpha;
#pragma unroll
        for (int dt = 0; dt < 4; ++dt) o[dt] *= alpha;
        m_run = mnew;
    }
    float ls = 0.f;
#pragma unroll
    for (int i = 0; i < 16; ++i) { s0[i] = __builtin_amdgcn_exp2f(s0[i] - m_run); s1[i] = __builtin_amdgcn_exp2f(s1[i] - m_run); ls += s0[i] + s1[i]; }
    l_run += ls;
#pragma unroll
    for (int s = 0; s < 2; ++s) {
        u32x4 a, c;
        a.x = pk2(s0[8 * s + 0], s0[8 * s + 1]); a.y = pk2(s0[8 * s + 2], s0[8 * s + 3]); a.z = pk2(s0[8 * s + 4], s0[8 * s + 5]); a.w = pk2(s0[8 * s + 6], s0[8 * s + 7]);
        c.x = pk2(s1[8 * s + 0], s1[8 * s + 1]); c.y = pk2(s1[8 * s + 2], s1[8 * s + 3]); c.z = pk2(s1[8 * s + 4], s1[8 * s + 5]); c.w = pk2(s1[8 * s + 6], s1[8 * s + 7]);
        pf0[s] = __builtin_bit_cast(bf16x8, a); pf1[s] = __builtin_bit_cast(bf16x8, c);
    }
}
DI void mla_pv(const LAS unsigned char* base, int r, int h, const bf16x8 (&pf0)[2], const bf16x8 (&pf1)[2], f32x16 (&o)[4]) {
    const LAS unsigned char* vp = base + MLA_KBYTES + r * MLA_VROW + h * 32;
#pragma unroll
    for (int s = 0; s < 2; ++s) {
        bf16x8 va[4], vb[4];
#pragma unroll
        for (int dt = 0; dt < 4; ++dt) { va[dt] = *(const LAS bf16x8*)(vp + dt * 32 * MLA_VROW + s * 16); vb[dt] = *(const LAS bf16x8*)(vp + dt * 32 * MLA_VROW + 64 + s * 16); }
        __builtin_amdgcn_sched_barrier(0);
#pragma unroll
        for (int dt = 0; dt < 4; ++dt) o[dt] = MFMA32(va[dt], pf0[s], o[dt]);
#pragma unroll
        for (int dt = 0; dt < 4; ++dt) o[dt] = MFMA32(vb[dt], pf1[s], o[dt]);
        __builtin_amdgcn_sched_barrier(0);
    }
}

DI void mla_block(const Params& p, LAS unsigned char* lds, int b, int hd, int qb, int tid) {
    asm volatile("" : "+v"(tid));
    const int wu = __builtin_amdgcn_readfirstlane(tid >> 6), lane = tid & 63, r = lane & 31, h = lane >> 5;
    const int q0 = qb * 256 + wu * 32;
    const bf16_t* QN = (const bf16_t*)(p.ws + OFF_QN); const bf16_t* QR = (const bf16_t*)(p.ws + OFF_QR);
    const size_t tok0 = (size_t)b * S_;
    bf16x8 qf[12];
    {
        const size_t qrow = tok0 + q0 + r;
#pragma unroll
        for (int ks = 0; ks < 8; ++ks) qf[ks] = *(const bf16x8*)(QN + qrow * 512 + hd * 128 + ks * 16 + h * 8);
#pragma unroll
        for (int ks = 0; ks < 4; ++ks) qf[8 + ks] = *(const bf16x8*)(QR + qrow * 256 + hd * 64 + ks * 16 + h * 8);
    }
    unsigned goff[6];
#pragma unroll
    for (int j = 0; j < 6; ++j) {
        const int pc = wu + 8 * j; goff[j] = 0;
        if (pc < 25) {
            const int c = pc * 64 + lane, lr = c / 25; int cc = c - lr * 25; if (cc == 24) cc = 0;
            const int k32 = lr & 31, key = (lr & 32) + 16 * ((k32 >> 2) & 1) + (k32 & 3) + 4 * (k32 >> 3);
            const unsigned tok = (unsigned)(b * S_ + key);
            goff[j] = (cc < 16) ? (unsigned)OFF_KN + (tok * 512u + hd * 128 + cc * 8) * 2u : (unsigned)OFF_PROJ + (tok * 2048u + 1920 + (cc - 16) * 8) * 2u;
        } else if (pc < 43) {
            const int c = (pc - 25) * 64 + lane, d = c / 9; int cc = c - d * 9; if (cc == 8) cc = 0;
            goff[j] = (unsigned)OFF_VMT + ((unsigned)((b * 4 + hd) * 128 + d) * (unsigned)S_ + cc * 8) * 2u;
        }
    }
    const char* wsb = uptr((const char*)p.ws);
#define MLA_STAGE(KT, BUF) do { _Pragma("unroll") for (int _j = 0; _j < 6; ++_j) { const int _pc = wu + 8 * _j; if (_pc < 43) { \
        const unsigned _inc = goff[_j] >= (unsigned)OFF_VMT ? 128u : (goff[_j] < (unsigned)OFF_VST ? 262144u : 65536u); \
        __builtin_amdgcn_global_load_lds((const unsigned*)(wsb + (goff[_j] + (unsigned)(KT) * _inc)), (LAS unsigned*)(lds + (BUF) * MLA_BUF + _pc * 1024), 16, 0, 0); } } } while (0)
    f32x16 o[4]; for (int dt = 0; dt < 4; ++dt) o[dt] = zero16();
    float m_run = -1e30f, l_run = 0.f;
    const int ntiles = 4 * qb + 4, wlast = q0 >> 6;
    __syncthreads();
    MLA_STAGE(0, 0);
    const bool late = wu >= 4;
    bf16x8 pf0[2], pf1[2];
    int bcur = 0;
    for (int kt = 0; kt < ntiles; ++kt) {
        asm volatile("s_waitcnt vmcnt(0)" ::: "memory");
        __builtin_amdgcn_s_barrier();
        asm volatile("" ::: "memory");
        const int bprev = bcur == 0 ? 2 : bcur - 1, bnext = bcur == 2 ? 0 : bcur + 1;
        if (kt + 1 < ntiles) MLA_STAGE(kt + 1, bnext);
        if (late && kt >= 1 && kt - 1 <= wlast) mla_pv(lds + bprev * MLA_BUF, r, h, pf0, pf1, o);
        if (kt <= wlast) {
            mla_s_softmax(lds + bcur * MLA_BUF, r, h, kt == wlast, q0 + r - kt * 64, qf, o, m_run, l_run, pf0, pf1);
            if (!late) mla_pv(lds + bcur * MLA_BUF, r, h, pf0, pf1, o);
        }
        bcur = bnext;
    }
    if (late && wlast == ntiles - 1) { const int bprev = bcur == 0 ? 2 : bcur - 1; mla_pv(lds + bprev * MLA_BUF, r, h, pf0, pf1, o); }
#undef MLA_STAGE
    const float lt = xhalf_sum(l_run), inv = 1.f / lt;
    bf16_t* mix = (bf16_t*)(p.ws + OFF_MIX) + (tok0 + q0 + r) * 1024 + 512 + hd * 128 + 4 * h;
    float ss = 0.f;
#pragma unroll
    for (int dt = 0; dt < 4; ++dt)
#pragma unroll
        for (int g = 0; g < 4; ++g) {
            const float a0 = o[dt][4 * g] * inv, a1 = o[dt][4 * g + 1] * inv, a2 = o[dt][4 * g + 2] * inv, a3 = o[dt][4 * g + 3] * inv;
            ss += (a0 * a0 + a1 * a1) + (a2 * a2 + a3 * a3);
            u32x2 w; w.x = pk2(a0, a1); w.y = pk2(a2, a3);
            *(u32x2*)(mix + dt * 32 + 8 * g) = w;
        }
    ss = xhalf_sum(ss);
    if (h == 0) ((float*)(p.ws + OFF_HSS))[(tok0 + q0 + r) * 16 + 8 + hd] = ss;
}

DI void sb_item(const Params& p, int bh, int qb32, int lane) {
    asm volatile("" : "+v"(lane));
    const int r = lane & 31, h = lane >> 5, b = bh >> 3, hd = bh & 7, q0 = qb32 * 32;
    const bf16_t* PROJ = (const bf16_t*)(p.ws + OFF_PROJ);
    const bf16_t* VST = (const bf16_t*)(p.ws + OFF_VST);
    const size_t tok0 = (size_t)b * S_;
    bf16x8 qf[4];
#pragma unroll
    for (int ks = 0; ks < 4; ++ks) qf[ks] = *(const bf16x8*)(PROJ + (tok0 + q0 + r) * 2048 + hd * 64 + ks * 16 + h * 8);
    const int pr = 16 * ((r >> 2) & 1) + (r & 3) + 4 * (r >> 3);
    const bf16_t* kbase = PROJ + (tok0 + pr) * 2048 + 512 + hd * 64 + h * 8;
    const bf16_t* vbase = VST + ((size_t)(b * 8 + hd) * 64 + r) * S_ + 16 * h;
    bf16x8 kc[4], kn[4], vf[4];
#pragma unroll
    for (int ks = 0; ks < 4; ++ks) kc[ks] = *(const bf16x8*)(kbase + (size_t)q0 * 2048 + ks * 16);
    f32x16 o0 = zero16(), o1 = zero16();
    float carry = 1.f;
    for (int kb = q0; kb >= 0; kb -= 32) {
#pragma unroll
        for (int dt = 0; dt < 2; ++dt)
#pragma unroll
            for (int s = 0; s < 2; ++s) vf[dt * 2 + s] = *(const bf16x8*)(vbase + (size_t)dt * 32 * S_ + kb + 8 * s);
        if (kb >= 32) {
#pragma unroll
            for (int ks = 0; ks < 4; ++ks) kn[ks] = *(const bf16x8*)(kbase + (size_t)(kb - 32) * 2048 + ks * 16);
        }
        f32x16 z = zero16();
#pragma unroll
        for (int ks = 0; ks < 4; ++ks) z = MFMA32(kc[ks], qf[ks], z);
        const bool diag = (kb == q0);
        f32x16 a;
        float tot = 1.f;
#pragma unroll
        for (int i = 15; i >= 0; --i) {
            const float w = __builtin_amdgcn_exp2f(fminf(z[i], 86.f));
            float be = __builtin_amdgcn_rcpf(1.f + w);
            float om = w * be;
            if (diag) { const bool valid = (16 * h + i < r); be = valid ? be : 0.f; om = valid ? om : 1.f; }
            a[i] = be * tot;
            tot *= om;
        }
        const float other = __shfl_xor(tot, 32);
        const float base = carry * (h == 0 ? other : 1.f);
        carry *= tot * other;
#pragma unroll
        for (int i = 0; i < 16; ++i) a[i] *= base;
        bf16x8 pf[2];
#pragma unroll
        for (int s = 0; s < 2; ++s) {
            u32x4 w; w.x = pk2(a[8 * s + 0], a[8 * s + 1]); w.y = pk2(a[8 * s + 2], a[8 * s + 3]); w.z = pk2(a[8 * s + 4], a[8 * s + 5]); w.w = pk2(a[8 * s + 6], a[8 * s + 7]);
            pf[s] = __builtin_bit_cast(bf16x8, w);
        }
#pragma unroll
        for (int s = 0; s < 2; ++s) { o0 = MFMA32(vf[s], pf[s], o0); o1 = MFMA32(vf[2 + s], pf[s], o1); }
        if (kb >= 32) {
#pragma unroll
            for (int ks = 0; ks < 4; ++ks) kc[ks] = kn[ks];
        }
        if (__all(carry < SB_PTHR)) break;
    }
    bf16_t* mix = (bf16_t*)(p.ws + OFF_MIX) + (tok0 + q0 + r) * 1024 + hd * 64 + 4 * h;
    float ss = 0.f;
#pragma unroll
    for (int g = 0; g < 4; ++g) {
        { const float a0 = o0[4 * g], a1 = o0[4 * g + 1], a2 = o0[4 * g + 2], a3 = o0[4 * g + 3];
          ss += (a0 * a0 + a1 * a1) + (a2 * a2 + a3 * a3); u32x2 w; w.x = pk2(a0, a1); w.y = pk2(a2, a3); *(u32x2*)(mix + 8 * g) = w; }
        { const float a0 = o1[4 * g], a1 = o1[4 * g + 1], a2 = o1[4 * g + 2], a3 = o1[4 * g + 3];
          ss += (a0 * a0 + a1 * a1) + (a2 * a2 + a3 * a3); u32x2 w; w.x = pk2(a0, a1); w.y = pk2(a2, a3); *(u32x2*)(mix + 32 + 8 * g) = w; }
    }
    ss = xhalf_sum(ss);
    if (h == 0) ((float*)(p.ws + OFF_HSS))[(tok0 + q0 + r) * 16 + hd] = ss;
}

constexpr int SB_ROW = 144, SB_KBYTES = 64 * SB_ROW, SB_BUF = 2 * SB_KBYTES  , SB_NB = 7, SB_FLAGS = SB_NB * SB_BUF;
DI void sb_block(const Params& p, LAS unsigned char* lds, int bh, int qb, int tid) {
    asm volatile("" : "+v"(tid));
    const int wu = __builtin_amdgcn_readfirstlane(tid >> 6), lane = tid & 63, r = lane & 31, h = lane >> 5;
    const int b = bh >> 3, hd = bh & 7, q0 = qb * 256 + wu * 32;
    const bf16_t* PROJ = (const bf16_t*)(p.ws + OFF_PROJ);
    const size_t tok0 = (size_t)b * S_;
    bf16x8 qf[4];
#pragma unroll
    for (int ks = 0; ks < 4; ++ks) qf[ks] = *(const bf16x8*)(PROJ + (tok0 + q0 + r) * 2048 + hd * 64 + ks * 16 + h * 8);
    unsigned goff[3];
#pragma unroll
    for (int j = 0; j < 3; ++j) {
        const int pc = wu + 8 * j; goff[j] = 0;
        if (pc < 18) {
            const int c = (pc < 9 ? pc : pc - 9) * 64 + lane, lr = c / 9; int cc = c - lr * 9; if (cc == 8) cc = 0;
            if (pc < 9) { const int k32 = lr & 31, key = (lr & 32) + 16 * ((k32 >> 2) & 1) + (k32 & 3) + 4 * (k32 >> 3);
                goff[j] = (unsigned)OFF_PROJ + ((unsigned)(b * S_ + key) * 2048u + 512 + hd * 64 + cc * 8) * 2u; }
            else goff[j] = (unsigned)OFF_VST + ((unsigned)((b * 8 + hd) * 64 + lr) * (unsigned)S_ + cc * 8) * 2u;
        }
    }
    const char* wsb = uptr((const char*)p.ws);
#define SB_STAGE(KT, BUF) do { _Pragma("unroll") for (int _j = 0; _j < 3; ++_j) { const int _pc = wu + 8 * _j; if (_pc < 18) { \
        const unsigned _inc = goff[_j] >= (unsigned)OFF_VST ? 128u : 262144u; \
        __builtin_amdgcn_global_load_lds((const unsigned*)(wsb + (goff[_j] + (unsigned)(KT) * _inc)), (LAS unsigned*)(lds + (BUF) * SB_BUF + _pc * 1024), 16, 0, 0); } } } while (0)
    f32x16 o0 = zero16(), o1 = zero16();
    float carry = 1.f;
    bool done = false;
    const int ktop = 4 * qb + 3;
    LAS int* flags = (LAS int*)(lds + SB_FLAGS);
    asm volatile("s_waitcnt vmcnt(0)" ::: "memory");
    __syncthreads();
    const int nstaged = ktop + 1 < SB_NB ? ktop + 1 : SB_NB;
    for (int i = 0; i < nstaged; ++i) SB_STAGE(ktop - i, i);
#define SB_WAITV(n) asm volatile("s_waitcnt vmcnt(" #n ") lgkmcnt(0)" ::: "memory")
    int cur = 0, it = 0;
    for (int kt = ktop; ; --kt, ++it) {
        if (lane == 0) flags[(it & 1) * 8 + wu] = done ? 1 : 0;
        if (it >= SB_NB && kt >= 0) SB_STAGE(kt, cur);
        const int ahead = it < nstaged ? nstaged - 1 - it : 0;
        if (wu < 2) { switch (ahead) { case 0: SB_WAITV(0); break; case 1: SB_WAITV(3); break; case 2: SB_WAITV(6); break; case 3: SB_WAITV(9); break; case 4: SB_WAITV(12); break; case 5: SB_WAITV(15); break; default: SB_WAITV(18); break; } }
        else { switch (ahead) { case 0: SB_WAITV(0); break; case 1: SB_WAITV(2); break; case 2: SB_WAITV(4); break; case 3: SB_WAITV(6); break; case 4: SB_WAITV(8); break; case 5: SB_WAITV(10); break; default: SB_WAITV(12); break; } }
        __builtin_amdgcn_s_barrier();
        asm volatile("" ::: "memory");
        {
            const LAS int* f = flags + (it & 1) * 8;
            const int all = f[0] & f[1] & f[2] & f[3] & f[4] & f[5] & f[6] & f[7];
            if (__builtin_amdgcn_readfirstlane(all)) break;
        }
        if (!done && kt * 64 <= q0) {
            const LAS unsigned char* base = lds + cur * SB_BUF;
#pragma unroll
            for (int sub = 1; sub >= 0; --sub) {
                const int kb = kt * 64 + sub * 32;
                if (kb <= q0 && !done) {
                    const LAS unsigned char* kp = base + (sub * 32 + r) * SB_ROW + h * 16;
                    bf16x8 kf[4], vf[4];
#pragma unroll
                    for (int ks = 0; ks < 4; ++ks) kf[ks] = *(const LAS bf16x8*)(kp + ks * 32);
#pragma unroll
                    for (int dt = 0; dt < 2; ++dt)
#pragma unroll
                        for (int s2 = 0; s2 < 2; ++s2) vf[dt * 2 + s2] = *(const LAS bf16x8*)(base + SB_KBYTES + (dt * 32 + r) * SB_ROW + (sub * 32 + 16 * h + 8 * s2) * 2);
                    f32x16 z = zero16();
#pragma unroll
                    for (int ks = 0; ks < 4; ++ks) z = MFMA32(kf[ks], qf[ks], z);
                    const bool diag = (kb == q0);
                    f32x16 a;
                    float tot = 1.f;
#pragma unroll
                    for (int i = 15; i >= 0; --i) {
                        const float w = __builtin_amdgcn_exp2f(fminf(z[i], 86.f));
                        float be = __builtin_amdgcn_rcpf(1.f + w);
                        float om = w * be;
                        if (diag) { const bool valid = (16 * h + i < r); be = valid ? be : 0.f; om = valid ? om : 1.f; }
                        a[i] = be * tot;
                        tot *= om;
                    }
                    const float other = __shfl_xor(tot, 32);
                    const float bs = carry * (h == 0 ? other : 1.f);
                    carry *= tot * other;
#pragma unroll
                    for (int i = 0; i < 16; ++i) a[i] *= bs;
                    bf16x8 pf[2];
#pragma unroll
                    for (int s2 = 0; s2 < 2; ++s2) {
                        u32x4 w; w.x = pk2(a[8 * s2 + 0], a[8 * s2 + 1]); w.y = pk2(a[8 * s2 + 2], a[8 * s2 + 3]); w.z = pk2(a[8 * s2 + 4], a[8 * s2 + 5]); w.w = pk2(a[8 * s2 + 6], a[8 * s2 + 7]);
                        pf[s2] = __builtin_bit_cast(bf16x8, w);
                    }
#pragma unroll
                    for (int s2 = 0; s2 < 2; ++s2) { o0 = MFMA32(vf[s2], pf[s2], o0); o1 = MFMA32(vf[2 + s2], pf[s2], o1); }
                    if (__all(carry < SB_PTHR)) done = true;
                }
            }
            if (kt == 0) done = true;
        }
        cur = cur == SB_NB - 1 ? 0 : cur + 1;
    }
    asm volatile("s_waitcnt vmcnt(0)" ::: "memory");
#undef SB_WAITV
#undef SB_STAGE
    bf16_t* mix = (bf16_t*)(p.ws + OFF_MIX) + (tok0 + q0 + r) * 1024 + hd * 64 + 4 * h;
    float ss = 0.f;
#pragma unroll
    for (int g = 0; g < 4; ++g) {
        { const float a0 = o0[4 * g], a1 = o0[4 * g + 1], a2 = o0[4 * g + 2], a3 = o0[4 * g + 3];
          ss += (a0 * a0 + a1 * a1) + (a2 * a2 + a3 * a3); u32x2 w; w.x = pk2(a0, a1); w.y = pk2(a2, a3); *(u32x2*)(mix + 8 * g) = w; }
        { const float a0 = o1[4 * g], a1 = o1[4 * g + 1], a2 = o1[4 * g + 2], a3 = o1[4 * g + 3];
          ss += (a0 * a0 + a1 * a1) + (a2 * a2 + a3 * a3); u32x2 w; w.x = pk2(a0, a1); w.y = pk2(a2, a3); *(u32x2*)(mix + 32 + 8 * g) = w; }
    }
    ss = xhalf_sum(ss);
    if (h == 0) ((float*)(p.ws + OFF_HSS))[(tok0 + q0 + r) * 16 + hd] = ss;
}

DI void sb_block2(const Params& p, LAS unsigned char* lds, int bh, int qb2, int tid) {
    asm volatile("" : "+v"(tid));
    const int wu = __builtin_amdgcn_readfirstlane(tid >> 6), lane = tid & 63, r = lane & 31, h = lane >> 5;
    const int b = bh >> 3, hd = bh & 7;
    int q0[2]; q0[0] = qb2 * 512 + wu * 32; q0[1] = q0[0] + 256;
    const bf16_t* PROJ = (const bf16_t*)(p.ws + OFF_PROJ);
    const size_t tok0 = (size_t)b * S_;
    bf16x8 qf[2][4];
#pragma unroll
    for (int g = 0; g < 2; ++g)
#pragma unroll
        for (int ks = 0; ks < 4; ++ks) qf[g][ks] = *(const bf16x8*)(PROJ + (tok0 + q0[g] + r) * 2048 + hd * 64 + ks * 16 + h * 8);
    unsigned goff[3];
#pragma unroll
    for (int j = 0; j < 3; ++j) {
        const int pc = wu + 8 * j; goff[j] = 0;
        if (pc < 18) {
            const int c = (pc < 9 ? pc : pc - 9) * 64 + lane, lr = c / 9; int cc = c - lr * 9; if (cc == 8) cc = 0;
            if (pc < 9) { const int k32 = lr & 31, key = (lr & 32) + 16 * ((k32 >> 2) & 1) + (k32 & 3) + 4 * (k32 >> 3);
                goff[j] = (unsigned)OFF_PROJ + ((unsigned)(b * S_ + key) * 2048u + 512 + hd * 64 + cc * 8) * 2u; }
            else goff[j] = (unsigned)OFF_VST + ((unsigned)((b * 8 + hd) * 64 + lr) * (unsigned)S_ + cc * 8) * 2u;
        }
    }
    const char* wsb = uptr((const char*)p.ws);
#define SB_STAGE(KT, BUF) do { _Pragma("unroll") for (int _j = 0; _j < 3; ++_j) { const int _pc = wu + 8 * _j; if (_pc < 18) { \
        const unsigned _inc = goff[_j] >= (unsigned)OFF_VST ? 128u : 262144u; \
        __builtin_amdgcn_global_load_lds((const unsigned*)(wsb + (goff[_j] + (unsigned)(KT) * _inc)), (LAS unsigned*)(lds + (BUF) * SB_BUF + _pc * 1024), 16, 0, 0); } } } while (0)
    f32x16 o0[2], o1[2]; float carry[2]; bool done[2];
#pragma unroll
    for (int g = 0; g < 2; ++g) { o0[g] = zero16(); o1[g] = zero16(); carry[g] = 1.f; done[g] = false; }
    const int ktop = 8 * qb2 + 7;
    LAS int* flags = (LAS int*)(lds + SB_FLAGS);
    asm volatile("s_waitcnt vmcnt(0)" ::: "memory");
    __syncthreads();
    const int nstaged = ktop + 1 < SB_NB ? ktop + 1 : SB_NB;
    for (int i = 0; i < nstaged; ++i) SB_STAGE(ktop - i, i);
#define SB_WAITV(n) asm volatile("s_waitcnt vmcnt(" #n ") lgkmcnt(0)" ::: "memory")
    int cur = 0, it = 0;
    for (int kt = ktop; ; --kt, ++it) {
        if (lane == 0) flags[(it & 1) * 8 + wu] = (done[0] && done[1]) ? 1 : 0;
        int lowest = ktop - (SB_NB - 1) - (it > 0 ? it - 1 : 0); if (lowest < 0) lowest = 0;
        int ahead = kt - lowest; if (ahead < 0) ahead = 0;
        if (wu < 2) { switch (ahead) { case 0: SB_WAITV(0); break; case 1: SB_WAITV(3); break; case 2: SB_WAITV(6); break; case 3: SB_WAITV(9); break; case 4: SB_WAITV(12); break; case 5: SB_WAITV(15); break; default: SB_WAITV(18); break; } }
        else { switch (ahead) { case 0: SB_WAITV(0); break; case 1: SB_WAITV(2); break; case 2: SB_WAITV(4); break; case 3: SB_WAITV(6); break; case 4: SB_WAITV(8); break; case 5: SB_WAITV(10); break; default: SB_WAITV(12); break; } }
        __builtin_amdgcn_s_barrier();
        asm volatile("" ::: "memory");
        {
            const LAS int* f = flags + (it & 1) * 8;
            const int all = f[0] & f[1] & f[2] & f[3] & f[4] & f[5] & f[6] & f[7];
            if (__builtin_amdgcn_readfirstlane(all)) break;
        }
        if (it >= 1 && kt - (SB_NB - 1) >= 0) SB_STAGE(kt - (SB_NB - 1), cur == 0 ? SB_NB - 1 : cur - 1);
        {
            const LAS unsigned char* base = lds + cur * SB_BUF;
#pragma unroll
            for (int sub = 1; sub >= 0; --sub) {
                const int kb = kt * 64 + sub * 32;
                const LAS unsigned char* kp = base + (sub * 32 + r) * SB_ROW + h * 16;
                const bool act0 = !done[0] && kb <= q0[0], act1 = !done[1] && kb <= q0[1];
                if (act0 || act1) {
                    bf16x8 kf[4], vf[4];
#pragma unroll
                    for (int ks = 0; ks < 4; ++ks) kf[ks] = *(const LAS bf16x8*)(kp + ks * 32);
#pragma unroll
                    for (int dt = 0; dt < 2; ++dt)
#pragma unroll
                        for (int s2 = 0; s2 < 2; ++s2) vf[dt * 2 + s2] = *(const LAS bf16x8*)(base + SB_KBYTES + (dt * 32 + r) * SB_ROW + (sub * 32 + 16 * h + 8 * s2) * 2);
#pragma unroll
                    for (int g = 0; g < 2; ++g) {
                        if (g == 0 ? act0 : act1) {
                            f32x16 z = zero16();
#pragma unroll
                            for (int ks = 0; ks < 4; ++ks) z = MFMA32(kf[ks], qf[g][ks], z);
                            const bool diag = (kb == q0[g]);
                            f32x16 a;
                            float tot = 1.f;
#pragma unroll
                            for (int i = 15; i >= 0; --i) {
                                const float w = __builtin_amdgcn_exp2f(fminf(z[i], 86.f));
                                float be = __builtin_amdgcn_rcpf(1.f + w);
                                float om = w * be;
                                if (diag) { const bool valid = (16 * h + i < r); be = valid ? be : 0.f; om = valid ? om : 1.f; }
                                a[i] = be * tot;
                                tot *= om;
                            }
                            float tlo, thi; xhalf(tot, tlo, thi);
                            const float bs = carry[g] * (h == 0 ? thi : 1.f);
                            carry[g] *= tlo * thi;
#pragma unroll
                            for (int i = 0; i < 16; ++i) a[i] *= bs;
                            bf16x8 pf[2];
#pragma unroll
                            for (int s2 = 0; s2 < 2; ++s2) {
                                u32x4 w; w.x = pk2(a[8 * s2 + 0], a[8 * s2 + 1]); w.y = pk2(a[8 * s2 + 2], a[8 * s2 + 3]); w.z = pk2(a[8 * s2 + 4], a[8 * s2 + 5]); w.w = pk2(a[8 * s2 + 6], a[8 * s2 + 7]);
                                pf[s2] = __builtin_bit_cast(bf16x8, w);
                            }
#pragma unroll
                            for (int s2 = 0; s2 < 2; ++s2) { o0[g] = MFMA32(vf[s2], pf[s2], o0[g]); o1[g] = MFMA32(vf[2 + s2], pf[s2], o1[g]); }
                            if (__all(carry[g] < SB_PTHR)) done[g] = true;
                        }
                    }
                }
            }
            if (kt == 0) { done[0] = true; done[1] = true; }
        }
        cur = cur == SB_NB - 1 ? 0 : cur + 1;
    }
    asm volatile("s_waitcnt vmcnt(0)" ::: "memory");
#undef SB_WAITV
#undef SB_STAGE
#pragma unroll
    for (int g = 0; g < 2; ++g) {
        bf16_t* mix = (bf16_t*)(p.ws + OFF_MIX) + (tok0 + q0[g] + r) * 1024 + hd * 64 + 4 * h;
        float ss = 0.f;
#pragma unroll
        for (int gg = 0; gg < 4; ++gg) {
            { const float a0 = o0[g][4 * gg], a1 = o0[g][4 * gg + 1], a2 = o0[g][4 * gg + 2], a3 = o0[g][4 * gg + 3];
              ss += (a0 * a0 + a1 * a1) + (a2 * a2 + a3 * a3); u32x2 w; w.x = pk2(a0, a1); w.y = pk2(a2, a3); *(u32x2*)(mix + 8 * gg) = w; }
            { const float a0 = o1[g][4 * gg], a1 = o1[g][4 * gg + 1], a2 = o1[g][4 * gg + 2], a3 = o1[g][4 * gg + 3];
              ss += (a0 * a0 + a1 * a1) + (a2 * a2 + a3 * a3); u32x2 w; w.x = pk2(a0, a1); w.y = pk2(a2, a3); *(u32x2*)(mix + 32 + 8 * gg) = w; }
        }
        ss = xhalf_sum(ss);
        if (h == 0) ((float*)(p.ws + OFF_HSS))[(tok0 + q0[g] + r) * 16 + hd] = ss;
    }
}

DI void phase_attention(const Params& p, LAS unsigned char* lds, int tid, int which = 3) {
    const int blk = blockIdx.x, G = gridDim.x;
#ifndef NO_MLA
    if (which & 1) for (int it = blk; it < 512; it += G) {
        const int xcd = it & 7, local = (it >> 3) & 63;
        const int bh = xcd * 8 + (local >> 3), pr = local & 7;
        mla_block(p, lds, bh >> 2, bh & 3, pr, tid);
        mla_block(p, lds, bh >> 2, bh & 3, 15 - pr, tid);
    }
#endif
#ifndef NO_SB
    if (which & 2) for (int it = blk; it < 1024; it += G) {
        const int xcd = it & 7, local = (it >> 3) & 127;
        sb_block2(p, lds, xcd * 16 + (local >> 3), local & 7, tid);
    }
#endif
}

DI void phase_final(const Params& p, int tid) {
    const int wid = tid >> 6, lane = tid & 63;
    const float* pf = (const float*)(p.ws + OFF_PF);
    const bf16_t* h2b = (const bf16_t*)(p.ws + OFF_MIX);
    f32x4 ga[2], gb[2];
#pragma unroll
    for (int j = 0; j < 2; ++j) { ga[j] = *(const f32x4*)(p.g_final + j * 512 + lane * 8); gb[j] = *(const f32x4*)(p.g_final + j * 512 + lane * 8 + 4); }
    for (int row = blockIdx.x * 8 + wid; row < T_; row += gridDim.x * 8) {
        const f32x4* pp = (const f32x4*)(pf + (size_t)row * 16);
        u32x4 w[2];
#pragma unroll
        for (int j = 0; j < 2; ++j) w[j] = *(const u32x4*)(h2b + (size_t)row * 1024 + j * 512 + lane * 8);
        const float rs = rsqrtf(((sum4(pp[0]) + sum4(pp[1])) + (sum4(pp[2]) + sum4(pp[3]))) * (1.f / 1024.f) + EPS_);
        float* orow = p.out + (size_t)row * 1024 + lane * 8;
#pragma unroll
        for (int j = 0; j < 2; ++j) { f32x4 a, b; unpack8(w[j], a, b); *(f32x4*)(orow + j * 512) = a * rs * ga[j]; *(f32x4*)(orow + j * 512 + 4) = b * rs * gb[j]; }
    }
}

#define XB_TMO      128
#define XB_XCNT(j)  (256  + 64 * (j))
#define XB_XSUB(j)  (1280 + 64 * (j))
#define XB_XGEN(j)  (2304 + 64 * (j))
#define XB_TOP      3328
#define XB_TOPGEN   3392
#define XCD_BAR_WORDS 3456
#define XB_SPIN_CAP (1u << 18)
DI unsigned xb_ld(unsigned* p)              { return __hip_atomic_load(p, __ATOMIC_RELAXED, __HIP_MEMORY_SCOPE_AGENT); }
DI unsigned xb_add(unsigned* p, unsigned v) { return __hip_atomic_fetch_add(p, v, __ATOMIC_RELAXED, __HIP_MEMORY_SCOPE_AGENT); }
DI unsigned xb_xcc_id() { return (unsigned)__builtin_amdgcn_s_getreg((3 << 11) | 20) & 0xFu; }
#define XB_SPIN(cond, bar) do { unsigned _sp = 0; while (cond) { __builtin_amdgcn_s_sleep(1); \
    if ((++_sp & 255u) == 0u) { if (xb_ld(&(bar)[XB_TMO])) break; if (_sp > XB_SPIN_CAP) { atomicAdd(&(bar)[XB_TMO], 1u); break; } } } } while (0)
struct XcdBarrier { unsigned* bar; unsigned x; volatile LAS unsigned* st; };
DI XcdBarrier xcd_barrier_post(unsigned* bar, volatile LAS unsigned* st) {
    XcdBarrier b; b.bar = bar; b.x = xb_xcc_id(); b.st = st;
    if (threadIdx.x == 0) (void)xb_add(&bar[XB_XCNT(b.x)], 1u);
    return b;
}
DI void xcd_barrier_complete(unsigned* bar, unsigned x, unsigned& nloc, unsigned& nx) {
    const unsigned G = gridDim.x * gridDim.y * gridDim.z;
    unsigned sum, cnt, mine, sp = 0u;
    for (;;) {
        sum = 0u; cnt = 0u; mine = 0u;
#pragma unroll
        for (unsigned j = 0; j < 16; ++j) { const unsigned c = xb_ld(&bar[XB_XCNT(j)]); sum += c; cnt += (c > 0u) ? 1u : 0u; mine = (j == x) ? c : mine; }
        if (sum == G) break;
        __builtin_amdgcn_s_sleep(1);
        if ((++sp & 255u) == 0u) { if (xb_ld(&bar[XB_TMO])) break; if (sp > XB_SPIN_CAP) { atomicAdd(&bar[XB_TMO], 1u); break; } }
    }
    nloc = mine > 0u ? mine : 1u; nx = cnt > 0u ? cnt : 1u;
}
DI void xcd_barrier(const XcdBarrier& b) {
    asm volatile("s_waitcnt vmcnt(0)" ::: "memory");
    __syncthreads();
    if (threadIdx.x == 0) {
        unsigned* bar = b.bar;
        __builtin_amdgcn_s_waitcnt(0);
        unsigned nloc = b.st[0], nx = b.st[1];
        if (nloc == 0u) { xcd_barrier_complete(bar, b.x, nloc, nx); b.st[0] = nloc; b.st[1] = nx; }
        const unsigned old = xb_add(&bar[XB_XSUB(b.x)], 1u);
        const unsigned gen = old / nloc;
        if (old + 1u == (gen + 1u) * nloc) {
            __builtin_amdgcn_fence(__ATOMIC_RELEASE, "agent");
            asm volatile("s_waitcnt vmcnt(0)" ::: "memory");
            const unsigned og = xb_add(&bar[XB_TOP], 1u);
            const unsigned tg = og / nx;
            if (og + 1u == (tg + 1u) * nx) xb_add(&bar[XB_TOPGEN], 1u);
            else XB_SPIN(xb_ld(&bar[XB_TOPGEN]) == tg, bar);
            __builtin_amdgcn_fence(__ATOMIC_ACQUIRE, "agent");
            xb_add(&bar[XB_XGEN(b.x)], 1u);
            asm volatile("s_waitcnt vmcnt(0)" ::: "memory");
        } else {
            XB_SPIN(xb_ld(&bar[XB_XGEN(b.x)]) == gen, bar);
            __builtin_amdgcn_fence(__ATOMIC_ACQUIRE, "agent");
            asm volatile("s_waitcnt vmcnt(0)" ::: "memory");
        }
    }
    __syncthreads();
}

#ifndef PH_MASK
#define PH_MASK 255
#endif
#ifndef DUP_MASK
#define DUP_MASK 0
#endif
#ifndef DUP_WHICH
#define DUP_WHICH 3
#endif
constexpr int LDS_XB = g8::STAGE_BYTES + 8192;
constexpr int LDS_BYTES = g8::STAGE_BYTES + 8192 + 64;

__global__ void __launch_bounds__(512, 2) hymba_fwd(Params p) {
    extern __shared__ __attribute__((aligned(16))) unsigned char lds_raw[];
    LAS unsigned char* lds = (LAS unsigned char*)lds_raw;
    cg::grid_group grid = cg::this_grid();
    const int wid_s = __builtin_amdgcn_readfirstlane((int)threadIdx.x >> 6);
    unsigned char* ws = p.ws;

    volatile LAS unsigned* xst = (volatile LAS unsigned*)(lds + LDS_XB);
    if (threadIdx.x == 0) { xst[0] = 0u; xst[1] = 0u; }
    __syncthreads();
    const XcdBarrier xb = xcd_barrier_post((unsigned*)(ws + OFF_BAR), xst);
    if (p.out == nullptr) grid.sync();
    if (PH_MASK & 1) phase0(p, lds, fresh_tid(wid_s));
    xcd_barrier(xb);
    if (DUP_MASK & 1) { phase0(p, lds, fresh_tid(wid_s)); xcd_barrier(xb); }
    if (PH_MASK & 2) {
        LAS float* tab = (LAS float*)(lds + g8::STAGE_BYTES);
        EpiProj E{tab, (const float*)(ws + OFF_CS), (bf16_t*)(ws + OFF_PROJ), (bf16_t*)(ws + OFF_VST), (float*)(ws + OFF_PQ), (float*)(ws + OFF_PKV)};
        g8::gemm_phase<1, 1>(lds, wid_s, (const bf16_t*)(ws + OFF_XB), 1024, (const bf16_t*)(ws + OFF_WIN), 1024, T_, 2048, 1024, E, TabFill<RowRsx>{tab, wid_s, RowRsx{(const float*)(ws + OFF_RSX)}});
    }
    xcd_barrier(xb);
    if (PH_MASK & 4) {
        LAS float* tab = (LAS float*)(lds + g8::STAGE_BYTES);
        EpiQKV E{tab, (const float*)(ws + OFF_CS), (bf16_t*)(ws + OFF_QN), (bf16_t*)(ws + OFF_QR), (bf16_t*)(ws + OFF_KN), (bf16_t*)(ws + OFF_VMT)};
        g8::gemm_phase<1>(lds, wid_s, (const bf16_t*)(ws + OFF_PROJ) + 1536, 2048, (const bf16_t*)(ws + OFF_WQB), 256, T_, 1792, 256, E, TabFill<RowQKV>{tab, wid_s, RowQKV{(const float*)(ws + OFF_PQ), (const float*)(ws + OFF_PKV)}});
    }
    xcd_barrier(xb);
    if (PH_MASK & 8) phase_attention(p, lds, fresh_tid(wid_s));
    xcd_barrier(xb);
    if (DUP_MASK & 8) { phase_attention(p, lds, fresh_tid(wid_s), DUP_WHICH); xcd_barrier(xb); }
    if (PH_MASK & 16) {
        LAS float* tab = (LAS float*)(lds + g8::STAGE_BYTES);
        EpiOut E{tab, (const bf16_t*)(ws + OFF_XB), (bf16_t*)(ws + OFF_H1B), (float*)(ws + OFF_PH)};
        g8::gemm_phase<2>(lds, wid_s, (const bf16_t*)(ws + OFF_MIX), 1024, (const bf16_t*)(ws + OFF_WO), 1024, T_, 1024, 512, E, TabFill<RowOut>{tab, wid_s, RowOut{(const float*)(ws + OFF_HSS)}});
    }
    xcd_barrier(xb);
    for (int rep = 0; rep < ((DUP_MASK & 32) ? 2 : 1); ++rep) {
    if (rep) xcd_barrier(xb);
    if (PH_MASK & 32) {
        LAS float* rst = (LAS float*)(lds + g8::STAGE_BYTES);
        EpiUp E{rst, (bf16_t*)(ws + OFF_HID)};
        g8::gemm_phase<1>(lds, wid_s, (const bf16_t*)(ws + OFF_H1B), 1024, (const bf16_t*)(ws + OFF_WUP), 1024, T_, 4096, 1024, E, TabFill<RowUp>{rst, wid_s, RowUp{(const float*)(ws + OFF_PH)}});
    }
    }
    xcd_barrier(xb);
    if (PH_MASK & 64) {
        EpiDown E{(const bf16_t*)(ws + OFF_H1B), (bf16_t*)(ws + OFF_MIX), (float*)(ws + OFF_PF)};
        g8::gemm_phase<1, 2>(lds, wid_s, (const bf16_t*)(ws + OFF_HID), 4096, (const bf16_t*)(ws + OFF_WDN), 4096, T_, 1024, 4096, E);
    }
    xcd_barrier(xb);
    if (PH_MASK & 128) phase_final(p, fresh_tid(wid_s));
}

extern "C" void kernel_launch(void* const* d_in, const int* in_sizes, int n_in, void* d_out, int out_size, void* d_ws, size_t ws_size, hipStream_t stream) {
    static int grid_blocks = 0;
    if (grid_blocks == 0) {
        if (n_in != 15 || in_sizes[0] != T_ * 1024 || out_size != T_ * 1024 || ws_size < WS_END) {
            fprintf(stderr, "kernel_launch: unexpected shapes (n_in %d, in0 %d, out %d, ws %zu < %zu)\n", n_in, n_in > 0 ? in_sizes[0] : -1, out_size, ws_size, (size_t)WS_END);
            grid_blocks = -1; return;
        }
        int dev = 0, cus = 0, per_cu = 0;
        hipGetDevice(&dev);
        hipDeviceGetAttribute(&cus, hipDeviceAttributeMultiprocessorCount, dev);
        if (hipFuncSetAttribute((const void*)hymba_fwd, hipFuncAttributeMaxDynamicSharedMemorySize, LDS_BYTES) != hipSuccess) fprintf(stderr, "kernel_launch: hipFuncSetAttribute failed\n");
        if (hipOccupancyMaxActiveBlocksPerMultiprocessor(&per_cu, (const void*)hymba_fwd, 512, LDS_BYTES) != hipSuccess || per_cu < 1) { fprintf(stderr, "kernel_launch: occupancy query gave %d\n", per_cu); per_cu = 1; }
        (void)hipGetLastError();
        grid_blocks = cus;
        if (grid_blocks != 256) fprintf(stderr, "kernel_launch: note: %d CUs (work maps assume 256)\n", grid_blocks);
    }
    if (grid_blocks < 0) return;
    Params p{};
    p.x = (const float*)d_in[0]; p.pos = (const int*)d_in[1]; p.g_attn = (const float*)d_in[2]; p.w_in = (const float*)d_in[3];
    p.g_qa = (const float*)d_in[4]; p.w_qb = (const float*)d_in[5]; p.g_kva = (const float*)d_in[6]; p.w_kvb = (const float*)d_in[7];
    p.g_sbo = (const float*)d_in[8]; p.g_mlao = (const float*)d_in[9]; p.w_o = (const float*)d_in[10]; p.g_mlp = (const float*)d_in[11];
    p.w_up = (const float*)d_in[12]; p.w_down = (const float*)d_in[13]; p.g_final = (const float*)d_in[14];
    p.out = (float*)d_out; p.ws = (unsigned char*)d_ws;
    (void)hipMemsetAsync((unsigned char*)d_ws + OFF_BAR, 0, XCD_BAR_WORDS * 4, stream);
    void* args[] = {&p};
    hipError_t e = hipLaunchCooperativeKernel((const void*)hymba_fwd, dim3(grid_blocks), dim3(512), args, LDS_BYTES, stream);
    if (e != hipSuccess) fprintf(stderr, "kernel_launch: cooperative launch failed: %s (grid %d)\n", hipGetErrorString(e), grid_blocks);
}
```

```cpp
#include <hip/hip_runtime.h>
#include <hip/hip_cooperative_groups.h>
#include <cstdio>
namespace cg = cooperative_groups;

#define LAS __attribute__((address_space(3)))
#define DI __device__ __forceinline__
typedef unsigned short bf16_t;
typedef short bf16x8 __attribute__((ext_vector_type(8)));
typedef float f32x2 __attribute__((ext_vector_type(2)));
typedef float f32x4 __attribute__((ext_vector_type(4)));
typedef float f32x16 __attribute__((ext_vector_type(16)));
typedef unsigned u32x4 __attribute__((ext_vector_type(4)));
typedef unsigned u32x2 __attribute__((ext_vector_type(2)));
typedef __bf16 bf2_t __attribute__((ext_vector_type(2)));

constexpr int T_ = 65536, S_ = 4096;
constexpr float EPS_ = 1e-6f;
constexpr float LOG2E = 1.4426950408889634f, LN2 = 0.6931471805599453f;
constexpr float MLA_QSCALE = 0.07216878364870322f * 1.4426950408889634f;
constexpr float SB_PTHR = 1e-37f;

constexpr size_t SZ_T = (size_t)T_;
constexpr size_t OFF_PROJ = 0;
constexpr size_t OFF_VST  = OFF_PROJ + SZ_T * 2048 * 2;
constexpr size_t OFF_QN   = OFF_VST + SZ_T * 512 * 2;
constexpr size_t OFF_QR   = OFF_QN + SZ_T * 512 * 2;
constexpr size_t OFF_KN   = OFF_QR + SZ_T * 256 * 2;
constexpr size_t OFF_VMT  = OFF_KN + SZ_T * 512 * 2;
constexpr size_t OFF_REGA_END = OFF_VMT + SZ_T * 512 * 2;
constexpr size_t OFF_HID  = 0;
constexpr size_t OFF_XB   = OFF_REGA_END;
constexpr size_t OFF_MIX  = OFF_XB + SZ_T * 1024 * 2;
constexpr size_t OFF_H1B  = OFF_MIX + SZ_T * 1024 * 2;
constexpr size_t OFF_WIN  = OFF_H1B + SZ_T * 1024 * 2;
constexpr size_t OFF_WQB  = OFF_WIN + (size_t)2048 * 1024 * 2;
constexpr size_t OFF_WKVB = OFF_WQB + (size_t)768 * 256 * 2;
constexpr size_t OFF_WO   = OFF_WKVB + (size_t)1024 * 256 * 2;
constexpr size_t OFF_WUP  = OFF_WO + (size_t)1024 * 1024 * 2;
constexpr size_t OFF_WDN  = OFF_WUP + (size_t)4096 * 1024 * 2;
constexpr size_t OFF_CS   = OFF_WDN + (size_t)4096 * 1024 * 2;
constexpr size_t OFF_RSX  = OFF_CS + SZ_T * 32 * 8;
constexpr size_t OFF_PQ   = OFF_RSX + SZ_T * 4;
constexpr size_t OFF_PKV  = OFF_PQ + SZ_T * 16;
constexpr size_t OFF_HSS  = OFF_PKV + SZ_T * 16;
constexpr size_t OFF_PH   = OFF_HSS + SZ_T * 64;
constexpr size_t OFF_PF   = OFF_PH + SZ_T * 64;
constexpr size_t OFF_BAR  = OFF_PF + SZ_T * 64;
constexpr size_t WS_END   = OFF_BAR + 16384;

struct Params {
    const float* x; const int* pos; const float* g_attn; const float* w_in; const float* g_qa; const float* w_qb;
    const float* g_kva; const float* w_kvb; const float* g_sbo; const float* g_mlao; const float* w_o; const float* g_mlp;
    const float* w_up; const float* w_down; const float* g_final;
    float* out; unsigned char* ws;
};

__device__ const float INV_FREQ[32] = {
    1.000000000e+00f, 7.498942018e-01f, 5.623413324e-01f, 4.216965139e-01f, 3.162277639e-01f, 2.371373773e-01f, 1.778279394e-01f, 1.333521456e-01f,
    1.000000015e-01f, 7.498942316e-02f, 5.623413250e-02f, 4.216964915e-02f, 3.162277490e-02f, 2.371373773e-02f, 1.778279431e-02f, 1.333521400e-02f,
    9.999999776e-03f, 7.498942316e-03f, 5.623413250e-03f, 4.216964822e-03f, 3.162277630e-03f, 2.371373819e-03f, 1.778279431e-03f, 1.333521446e-03f,
    1.000000047e-03f, 7.498941850e-04f, 5.623413017e-04f, 4.216965172e-04f, 3.162277571e-04f, 2.371373703e-04f, 1.778279402e-04f, 1.333521504e-04f};

DI unsigned pk2(float lo, float hi) { f32x2 v = {lo, hi}; bf2_t r = __builtin_convertvector(v, bf2_t); return __builtin_bit_cast(unsigned, r); }
DI u32x4 pack8(f32x4 a, f32x4 b) { u32x4 o; o.x = pk2(a.x, a.y); o.y = pk2(a.z, a.w); o.z = pk2(b.x, b.y); o.w = pk2(b.z, b.w); return o; }
DI void unpack8(u32x4 w, f32x4& a, f32x4& b) {
    a.x = __uint_as_float(w.x << 16); a.y = __uint_as_float(w.x & 0xffff0000u); a.z = __uint_as_float(w.y << 16); a.w = __uint_as_float(w.y & 0xffff0000u);
    b.x = __uint_as_float(w.z << 16); b.y = __uint_as_float(w.z & 0xffff0000u); b.z = __uint_as_float(w.w << 16); b.w = __uint_as_float(w.w & 0xffff0000u);
}
DI float sum4(f32x4 v) { return (v.x + v.y) + (v.z + v.w); }
DI float sq4(f32x4 v) { return (v.x * v.x + v.y * v.y) + (v.z * v.z + v.w * v.w); }
DI float wave_sum(float v) {
#pragma unroll
    for (int o = 1; o < 64; o <<= 1) v += __shfl_xor(v, o);
    return v;
}
DI f32x16 zero16() { f32x16 z; for (int i = 0; i < 16; ++i) z[i] = 0.f; return z; }
DI const char* uptr(const char* p) {
    const unsigned long long u = (unsigned long long)p;
    const unsigned lo = __builtin_amdgcn_readfirstlane((unsigned)u), hi = __builtin_amdgcn_readfirstlane((unsigned)(u >> 32));
    return (const char*)(((unsigned long long)hi << 32) | lo);
}
DI int fresh_tid(int wid_s) {
    int l; asm volatile("v_mbcnt_lo_u32_b32 %0, -1, 0\n\tv_mbcnt_hi_u32_b32 %0, -1, %0" : "=v"(l));
    return wid_s * 64 + l;
}
typedef unsigned u32x2p __attribute__((ext_vector_type(2)));
DI void xhalf(float x, float& lo, float& hi) { const u32x2p r = __builtin_amdgcn_permlane32_swap(__float_as_uint(x), __float_as_uint(x), false, false); lo = __uint_as_float(r.x); hi = __uint_as_float(r.y); }
DI float xhalf_max(float x) { float lo, hi; xhalf(x, lo, hi); return fmaxf(lo, hi); }
DI float xhalf_sum(float x) { float lo, hi; xhalf(x, lo, hi); return lo + hi; }
#define MFMA32(a, b, c) __builtin_amdgcn_mfma_f32_32x32x16_bf16((a), (b), (c), 0, 0, 0)

DI void p0_weight_item(const Params& p, LAS float* scr, int mid, int t, int lane) {
    const float* W; int K, N, Kpad; bf16_t* out;
    switch (mid) {
        case 0:  W = p.w_in;   K = 1024; N = 1984; Kpad = 1024; out = (bf16_t*)(p.ws + OFF_WIN); break;
        case 1:  W = p.w_qb;   K = 256;  N = 768;  Kpad = 256;  out = (bf16_t*)(p.ws + OFF_WQB); break;
        case 2:  W = p.w_kvb;  K = 128;  N = 1024; Kpad = 256;  out = (bf16_t*)(p.ws + OFF_WKVB); break;
        case 3:  W = p.w_o;    K = 1024; N = 1024; Kpad = 1024; out = (bf16_t*)(p.ws + OFF_WO); break;
        case 4:  W = p.w_up;   K = 1024; N = 4096; Kpad = 1024; out = (bf16_t*)(p.ws + OFF_WUP); break;
        default: W = p.w_down; K = 4096; N = 1024; Kpad = 4096; out = (bf16_t*)(p.ws + OFF_WDN); break;
    }
    const int nkt = Kpad / 64, k0 = (t % nkt) * 64, n0 = (t / nkt) * 32;
    const int nn = lane & 31, no = n0 + nn;
    int src = no; float sc = 1.f;
    if (mid == 0) {
        if (no < 512) sc = -0.125f * LOG2E;
        else if (no >= 1920) { if (no < 1984) { const int pp = no - 1920; src = 1920 + ((pp >> 2) & 1) * 32 + 4 * (pp >> 3) + (pp & 3); } else src = -1; }
    } else if (mid == 1) {
        sc = MLA_QSCALE;
        if (no < 512) src = (no >> 7) * 192 + (no & 127);
        else { const int q = no - 512, hd = q >> 6, pp = q & 63; src = hd * 192 + 128 + ((pp >> 2) & 1) * 32 + 4 * (pp >> 3) + (pp & 3); }
    }
#pragma unroll 8
    for (int i = 0; i < 32; ++i) {
        const int kk = 2 * i + (lane >> 5), k = k0 + kk;
        float gv = 1.f; bool ok = src >= 0;
        if (mid == 0) gv = p.g_attn[k];
        else if (mid == 1) gv = p.g_qa[k];
        else if (mid == 2) { if (k >= K) ok = false; else gv = p.g_kva[k]; }
        else if (mid == 3) gv = (k < 512) ? p.g_sbo[k] : p.g_mlao[k - 512];
        else if (mid == 4) gv = p.g_mlp[k];
        float val = 0.f;
        if (ok) val = W[(size_t)k * N + src] * gv * sc;
        scr[kk * 33 + nn] = val;
    }
    asm volatile("s_waitcnt lgkmcnt(0)" ::: "memory");
    {
        const int c = lane & 7;
#pragma unroll
        for (int j = 0; j < 4; ++j) {
            const int n = (lane >> 3) + 8 * j; const LAS float* sp = scr + (8 * c) * 33 + n;
            u32x4 o; o.x = pk2(sp[0], sp[33]); o.y = pk2(sp[2 * 33], sp[3 * 33]); o.z = pk2(sp[4 * 33], sp[5 * 33]); o.w = pk2(sp[6 * 33], sp[7 * 33]);
            *(u32x4*)(out + (size_t)(n0 + n) * Kpad + k0 + 8 * c) = o;
        }
    }
    asm volatile("s_waitcnt lgkmcnt(0)" ::: "memory");
}

DI void phase0(const Params& p, LAS unsigned char* lds, int tid) {
    const int G = gridDim.x, blk = blockIdx.x;
    const int wid = tid >> 6, lane = tid & 63;
    {
        LAS float* scr = (LAS float*)(lds + wid * 8448);
        constexpr int C0 = 1024, C1 = C0 + 96, C2 = C1 + 128, C3 = C2 + 512, C4 = C3 + 2048, C5 = C4 + 2048;
        for (int it = blk * 8 + wid; it < C5; it += G * 8) {
            if (it < C0) p0_weight_item(p, scr, 0, it, lane);
            else if (it < C1) p0_weight_item(p, scr, 1, it - C0, lane);
            else if (it < C2) p0_weight_item(p, scr, 2, it - C1, lane);
            else if (it < C3) p0_weight_item(p, scr, 3, it - C2, lane);
            else if (it < C4) p0_weight_item(p, scr, 4, it - C3, lane);
            else p0_weight_item(p, scr, 5, it - C4, lane);
        }
    }
    float* rsx = (float*)(p.ws + OFF_RSX);
    bf16_t* xb = (bf16_t*)(p.ws + OFF_XB);
    f32x2* cs = (f32x2*)(p.ws + OFF_CS);
    int cidx = blk * 512 + tid;
    int posv = p.pos[cidx >> 5];
    for (int row = blk * 8 + wid; row < T_; row += G * 8) {
        const f32x4* xr = (const f32x4*)(p.x + (size_t)row * 1024) + lane;
        f32x4 v[4]; float s = 0.f;
#pragma unroll
        for (int j = 0; j < 4; ++j) v[j] = __builtin_nontemporal_load(xr + 64 * j);
        f32x2 cv; const bool docs = cidx < T_ * 32;
        if (docs) {
            const int i = cidx & 31;
            const float ang = (float)posv * INV_FREQ[i];
            const double rev = (double)ang * 0.15915494309189535;
            const float fr = (float)(rev - __builtin_rint(rev));
            cv.x = __builtin_amdgcn_cosf(fr); cv.y = __builtin_amdgcn_sinf(fr);
        }
#pragma unroll
        for (int j = 0; j < 4; ++j) s += sq4(v[j]);
        s = wave_sum(s);
        if (lane == 0) rsx[row] = rsqrtf(s * (1.f / 1024.f) + EPS_);
        u32x2* o = (u32x2*)(xb + (size_t)row * 1024) + lane;
#pragma unroll
        for (int j = 0; j < 4; ++j) { u32x2 w; w.x = pk2(v[j].x, v[j].y); w.y = pk2(v[j].z, v[j].w); o[64 * j] = w; }
        if (docs) { cs[cidx] = cv; cidx += G * 512; if (cidx < T_ * 32) posv = p.pos[cidx >> 5]; }
    }
    for (; cidx < T_ * 32; cidx += G * 512) {
        const int t = cidx >> 5, i = cidx & 31;
        const float ang = (float)p.pos[t] * INV_FREQ[i];
        const double rev = (double)ang * 0.15915494309189535;
        const float fr = (float)(rev - __builtin_rint(rev));
        f32x2 v; v.x = __builtin_amdgcn_cosf(fr); v.y = __builtin_amdgcn_sinf(fr);
        cs[cidx] = v;
    }
}

namespace g8 {
constexpr int BM = 256, BK = 64, HALF = 128, HTB = HALF * BK * 2, STAGE_BYTES = 8 * HTB, NXCD = 8, WGM = 8;
DI int lds_byte(int r, int c) { const int st = (r >> 4) * 2 + (c >> 5), rr = r & 15, cc = c & 31, ob = rr * 64 + cc * 2; return st * 1024 + (ob ^ (((ob >> 9) & 1) << 5)); }
DI void stage_rc(int b, int& R, int& C) { const int st = b / 1024, sb = b % 1024, swz = sb ^ (((sb >> 9) & 1) << 5); R = (st >> 1) * 16 + swz / 64; C = (st & 1) * 32 + (swz % 64) / 2; }
DI int perm32(int rho) { const int n = rho >> 4, i = rho & 15; return 8 * (i >> 2) + 4 * n + (i & 3); }
struct Unit { int pm, pn, kh; };

template <int NKH, int ROT = 0>
DI bool next_unit(int i, int nM, int nN, Unit& u) {
    int ti = i / NKH; u.kh = i % NKH;
    const int nwg = nM * nN;
    if ((long)ti * gridDim.x + blockIdx.x >= nwg) return false;
    if (ROT == 2) ti = (nwg + (int)gridDim.x - 1) / (int)gridDim.x - 1 - ti;
    const long L = (long)ti * gridDim.x + blockIdx.x; if (L >= nwg) return false;
    int wgid = (int)L; { const int q = nwg / NXCD, r = nwg % NXCD, xcd = wgid % NXCD, off = wgid / NXCD; wgid = (xcd < r ? xcd * (q + 1) : r * (q + 1) + (xcd - r) * q) + off; }
    const int nig = WGM * nN, gid = wgid / nig, fm = gid * WGM, gsz = (nM - fm) < WGM ? (nM - fm) : WGM;
    u.pm = fm + ((wgid % nig) % gsz); u.pn = (wgid % nig) / gsz;
    if (ROT == 1) u.pn = (u.pn & 4) | ((u.pn + (ti >> 1)) & 3);
    return true;
}

struct NoPre { DI void operator()() const {} };
template <int NKH, int ROT = 0, class Epi, class Pre = NoPre>
DI void gemm_phase(LAS unsigned char* lds, int wid_s, const bf16_t* A, int lda, const bf16_t* Bt, int ldb, int M, int N, int Kc, const Epi& E, const Pre& pre = Pre()) {
    const int tid = fresh_tid(wid_s);
    const int wid = __builtin_amdgcn_readfirstlane(tid >> 6), lane = tid & 63, wr = wid >> 2, wc = wid & 3, fr = lane & 15, fq = lane >> 4;
    const int nt = Kc / BK, nM = M / BM, nN = N / BM;
    unsigned voffA[2], voffB[2];
#pragma unroll
    for (int i = 0; i < 2; ++i) { int R, C; stage_rc(tid * 16 + i * 8192, R, C); const int Rb = (R & ~31) + perm32(R & 31);
        voffA[i] = (unsigned)(R * lda + C) * 2u; voffB[i] = (unsigned)(Rb * ldb + C) * 2u; }
    const size_t kstep = (size_t)(BK * 2);
    const size_t hstepA = (size_t)HALF * lda * 2, hstepB = (size_t)HALF * ldb * 2;
    const size_t tstepA = 2 * hstepA, tstepB = 2 * hstepB, kchunk = (size_t)Kc * 2;
    const unsigned ldsw = (unsigned)wid * 1024u;
    const int aoff = lds_byte(wr * 64 + fr, fq * 8), boff = lds_byte(wc * 32 + fr, fq * 8);
#define G8_SA(b, h) (((b) * 2 + (h)) * HTB)
#define G8_SB(b, h) ((4 + (b) * 2 + (h)) * HTB)
#define G8_STAGE(bufoff, gbase, voff) do { const char* _gb = uptr((const char*)(gbase)); _Pragma("unroll") for (int _i = 0; _i < 2; ++_i) \
        __builtin_amdgcn_global_load_lds((const unsigned*)(_gb + (voff)[_i]), (LAS unsigned*)(lds + (bufoff) + ldsw + _i * 8192), 16, 0, 0); } while (0)
#define G8_LDA(dst, b, h) do { _Pragma("unroll") for (int m = 0; m < 4; ++m) _Pragma("unroll") for (int k = 0; k < 2; ++k) dst[m][k] = *(const LAS bf16x8*)(lds + G8_SA(b, h) + aoff + m * 2048 + k * 1024); } while (0)
#define G8_LDB(dst, b, h) do { _Pragma("unroll") for (int n = 0; n < 2; ++n) _Pragma("unroll") for (int k = 0; k < 2; ++k) dst[n][k] = *(const LAS bf16x8*)(lds + G8_SB(b, h) + boff + n * 2048 + k * 1024); } while (0)
#define G8_MMA(ai, bj, At, Bt_) do { __builtin_amdgcn_s_setprio(1); _Pragma("unroll") for (int m = 0; m < 4; ++m) _Pragma("unroll") for (int n = 0; n < 2; ++n) _Pragma("unroll") for (int k = 0; k < 2; ++k) \
        acc[ai][bj][m][n] = __builtin_amdgcn_mfma_f32_16x16x32_bf16(Bt_[n][k], At[m][k], acc[ai][bj][m][n], 0, 0, 0); __builtin_amdgcn_s_setprio(0); } while (0)
#define G8_WAIT_V(n) asm volatile("s_waitcnt vmcnt(" #n ")" ::: "memory")
#define G8_WAIT_L(n) asm volatile("s_waitcnt lgkmcnt(" #n ")" ::: "memory")
#define G8_BAR __builtin_amdgcn_s_barrier()
#define G8_SCHED __builtin_amdgcn_sched_barrier(0)
    Unit cur, nxt; int ui = 0;
    if (!next_unit<NKH, ROT>(0, nM, nN, cur)) return;
    f32x4 acc[2][2][4][2];
#pragma unroll
    for (int a = 0; a < 2; ++a)
#pragma unroll
        for (int b = 0; b < 2; ++b)
#pragma unroll
            for (int m = 0; m < 4; ++m)
#pragma unroll
                for (int n = 0; n < 2; ++n) acc[a][b][m][n] = (f32x4){0.f, 0.f, 0.f, 0.f};
    bf16x8 At[4][2], B0[2][2], B1[2][2];
    const char* cA = uptr((const char*)A + (size_t)cur.pm * tstepA + (size_t)cur.kh * kchunk + E.a_off(cur.pn));
    const char* cB = uptr((const char*)Bt + (size_t)cur.pn * tstepB + (size_t)cur.kh * kchunk);
    G8_STAGE(G8_SB(0, 0), cB, voffB); G8_STAGE(G8_SA(0, 0), cA, voffA); G8_STAGE(G8_SB(0, 1), cB + hstepB, voffB); G8_STAGE(G8_SA(0, 1), cA + hstepA, voffA);
    pre();
    if (wr == 1) G8_BAR;
    G8_WAIT_V(4); G8_BAR;
    G8_STAGE(G8_SB(1, 0), cB + kstep, voffB); G8_STAGE(G8_SA(1, 0), cA + kstep, voffA); G8_STAGE(G8_SB(1, 1), cB + hstepB + kstep, voffB);
    G8_WAIT_V(6); G8_BAR;
    for (;;) {
        const bool has_next = next_unit<NKH, ROT>(ui + 1, nM, nN, nxt);
        const char* nA = uptr(has_next ? (const char*)A + (size_t)nxt.pm * tstepA + (size_t)nxt.kh * kchunk + E.a_off(nxt.pn) : cA);
        const char* nB = uptr(has_next ? (const char*)Bt + (size_t)nxt.pn * tstepB + (size_t)nxt.kh * kchunk : cB);
        for (int t = 0; t < nt; t += 2) {
            const bool last = (t == nt - 2);
            const char* a1 = cA + (size_t)(t + 1) * kstep;
            const char* a2 = last ? nA : cA + (size_t)(t + 2) * kstep; const char* b2 = last ? nB : cB + (size_t)(t + 2) * kstep;
            const char* a3 = a2 + kstep; const char* b3 = b2 + kstep;
            G8_LDB(B0, 0, 0); G8_SCHED; G8_LDA(At, 0, 0); G8_STAGE(G8_SA(1, 1), a1 + hstepA, voffA);
            G8_WAIT_L(8); G8_BAR; G8_WAIT_L(0); G8_MMA(0, 0, At, B0); G8_BAR; G8_SCHED;
            G8_LDB(B1, 0, 1); G8_STAGE(G8_SB(0, 0), b2, voffB);
            G8_BAR; G8_WAIT_L(0); G8_MMA(0, 1, At, B1); G8_BAR;
            G8_LDA(At, 0, 1); G8_STAGE(G8_SA(0, 0), a2, voffA);
            G8_BAR; G8_WAIT_L(0); G8_MMA(1, 0, At, B0); G8_BAR; G8_SCHED;
            G8_STAGE(G8_SB(0, 1), b2 + hstepB, voffB);
            G8_WAIT_V(6); G8_BAR; G8_MMA(1, 1, At, B1); G8_BAR;
            G8_LDB(B0, 1, 0); G8_SCHED; G8_LDA(At, 1, 0); G8_STAGE(G8_SA(0, 1), a2 + hstepA, voffA);
            G8_WAIT_L(8); G8_BAR; G8_WAIT_L(0); G8_MMA(0, 0, At, B0); G8_BAR; G8_SCHED;
            G8_LDB(B1, 1, 1); G8_STAGE(G8_SB(1, 0), b3, voffB);
            G8_BAR; G8_WAIT_L(0); G8_MMA(0, 1, At, B1); G8_BAR;
            G8_LDA(At, 1, 1); G8_STAGE(G8_SA(1, 0), a3, voffA);
            G8_BAR; G8_WAIT_L(0); G8_MMA(1, 0, At, B0); G8_BAR; G8_SCHED;
            G8_STAGE(G8_SB(1, 1), b3 + hstepB, voffB);
            G8_WAIT_V(6); G8_BAR; G8_MMA(1, 1, At, B1); G8_BAR;
        }
        { int l2 = lane; asm volatile("" : "+v"(l2)); E(acc, cur, wr, wc, l2 & 15, l2 >> 4); }
        if (!has_next) break;
        if (cur.kh == NKH - 1) {
#pragma unroll
            for (int a = 0; a < 2; ++a)
#pragma unroll
                for (int b = 0; b < 2; ++b)
#pragma unroll
                    for (int m = 0; m < 4; ++m)
#pragma unroll
                        for (int n = 0; n < 2; ++n) acc[a][b][m][n] = (f32x4){0.f, 0.f, 0.f, 0.f};
        }
        cur = nxt; cA = nA; cB = nB; ++ui;
    }
    G8_WAIT_V(0);
    if (wr == 0) G8_BAR;
    G8_BAR;
#undef G8_SA
#undef G8_SB
#undef G8_STAGE
#undef G8_LDA
#undef G8_LDB
#undef G8_MMA
#undef G8_WAIT_V
#undef G8_WAIT_L
#undef G8_BAR
#undef G8_SCHED
}
}
using g8::Unit;
typedef f32x4 AccT[2][2][4][2];

DI void rope8(f32x4& v0, f32x4& v1, const f32x4 ca, const f32x4 cb) {
    f32x4 o1, o2;
    o1.x = v0.x * ca.x - v1.x * ca.y; o2.x = v1.x * ca.x + v0.x * ca.y;
    o1.y = v0.y * ca.z - v1.y * ca.w; o2.y = v1.y * ca.z + v0.y * ca.w;
    o1.z = v0.z * cb.x - v1.z * cb.y; o2.z = v1.z * cb.x + v0.z * cb.y;
    o1.w = v0.w * cb.z - v1.w * cb.w; o2.w = v1.w * cb.z + v0.w * cb.w;
    v0 = o1; v1 = o2;
}
DI void store_tr8(bf16_t* base, f32x4 v0, f32x4 v1) {
    base[0 * S_] = (bf16_t)pk2(v0.x, 0.f); base[1 * S_] = (bf16_t)pk2(v0.y, 0.f); base[2 * S_] = (bf16_t)pk2(v0.z, 0.f); base[3 * S_] = (bf16_t)pk2(v0.w, 0.f);
    base[4 * S_] = (bf16_t)pk2(v1.x, 0.f); base[5 * S_] = (bf16_t)pk2(v1.y, 0.f); base[6 * S_] = (bf16_t)pk2(v1.z, 0.f); base[7 * S_] = (bf16_t)pk2(v1.w, 0.f);
}

template <class F>
DI void fill_row_tables(LAS float* tab, int wid_s, const F& f) {
    const int t2 = fresh_tid(wid_s), bx = blockIdx.x & 7, bj8 = (blockIdx.x >> 3) & 7;
    for (int idx = t2; idx < 1024; idx += 512) {
        const int row = (8 * (4 * bx + (idx >> 8)) + bj8) * 256 + (idx & 255);
        const f32x2 v = f(row); tab[idx] = v.x; tab[1024 + idx] = v.y;
    }
    __syncthreads();
}
template <class F> struct TabFill {
    LAS float* tab; int wid_s; F f;
    DI void operator()() const {
        const int t2 = fresh_tid(wid_s), bx = blockIdx.x & 7, bj8 = (blockIdx.x >> 3) & 7;
        for (int idx = t2; idx < 1024; idx += 512) {
            const int row = (8 * (4 * bx + (idx >> 8)) + bj8) * 256 + (idx & 255);
            const f32x2 v = f(row); tab[idx] = v.x; tab[1024 + idx] = v.y;
        }
    }
};
struct RowRsx { const float* rsx; DI f32x2 operator()(int row) const { f32x2 v; v.x = rsx[row]; v.y = 0.f; return v; } };
struct RowQKV { const float* pq; const float* pkv; DI f32x2 operator()(int row) const { f32x2 v;
    v.x = rsqrtf(sum4(*(const f32x4*)(pq + (size_t)row * 4)) * (1.f / 256.f) + EPS_); v.y = rsqrtf(sum4(*(const f32x4*)(pkv + (size_t)row * 4)) * (1.f / 128.f) + EPS_); return v; } };
struct RowOut { const float* hss; DI f32x2 operator()(int row) const { const float* hp = hss + (size_t)row * 16; f32x2 v;
    const float rml = rsqrtf(sum4(*(const f32x4*)(hp + 8)) * (1.f / 512.f) + EPS_), rsb = rsqrtf((sum4(*(const f32x4*)hp) + sum4(*(const f32x4*)(hp + 4))) * (1.f / 512.f) + EPS_);
    v.x = rsb / rml; v.y = rml; return v; } };
struct RowUp { const float* ph; DI f32x2 operator()(int row) const { const f32x4* pp = (const f32x4*)(ph + (size_t)row * 16); f32x2 v;
    v.x = rsqrtf(((sum4(pp[0]) + sum4(pp[1])) + (sum4(pp[2]) + sum4(pp[3]))) * (1.f / 1024.f) + EPS_); v.y = 0.f; return v; } };
#define EPI_TAB(tab, which, i) ((tab)[(which) * 1024 + ((u.pm >> 3) & 3) * 256 + wr * 64 + fr + ((i) >> 2) * 128 + ((i) & 3) * 16])
#define EPI_ROW(ai, m) (u.pm * 256 + (ai) * 128 + wr * 64 + (m) * 16 + fr)
struct EpiProj {
    DI int a_off(int) const { return 0; }
    const LAS float* tab; const float* cs; bf16_t* proj; bf16_t* vst; float* pq; float* pkv;
    DI void operator()(AccT& acc, const Unit& u, int wr, int wc, int fr, int fq) const {
        const int pn = u.pn;
        float rsv[8];
#pragma unroll
        for (int i = 0; i < 8; ++i) rsv[i] = EPI_TAB(tab, 0, i);
        const bool do_rope = (pn == 7 && wc < 2);
        f32x4 rca[8], rcb[8];
        if (do_rope) {
#pragma unroll
            for (int i = 0; i < 8; ++i) { const float* cr = cs + (size_t)EPI_ROW(i >> 2, i & 3) * 64 + 2 * (16 * wc + 4 * fq); rca[i] = *(const f32x4*)cr; rcb[i] = *(const f32x4*)(cr + 4); }
        }
#pragma unroll
        for (int ai = 0; ai < 2; ++ai)
#pragma unroll
            for (int m = 0; m < 4; ++m) {
                const int row = EPI_ROW(ai, m);
                const float rs = rsv[ai * 4 + m]; float ss = 0.f;
#pragma unroll
                for (int bj = 0; bj < 2; ++bj) {
                    f32x4 v0 = acc[ai][bj][m][0] * rs, v1 = acc[ai][bj][m][1] * rs;
                    const int cl = bj * 128 + wc * 32 + fq * 8;
                    if (do_rope && bj == 1) rope8(v0, v1, rca[ai * 4 + m], rcb[ai * 4 + m]);
                    if (pn == 6 || (pn == 7 && bj == 0)) ss += sq4(v0) + sq4(v1);
                    if (pn == 4 || pn == 5) {
                        const int dg = (pn - 4) * 256 + cl, hd = dg >> 6, d = dg & 63, b = row >> 12, s = row & 4095;
                        store_tr8(vst + ((size_t)(b * 8 + hd) * 64 + d) * S_ + s, v0, v1);
                    } else {
                        *(u32x4*)(proj + (size_t)row * 2048 + pn * 256 + cl) = pack8(v0, v1);
                    }
                }
                if (pn >= 6) { ss += __shfl_xor(ss, 16); ss = xhalf_sum(ss); if (fq == 0) (pn == 6 ? pq : pkv)[(size_t)row * 4 + wc] = ss; }
            }
    }
};
struct EpiQKV {
    const LAS float* tab; const float* cs; bf16_t* qn; bf16_t* qr; bf16_t* kn; bf16_t* vmt;
    DI int a_off(int pn) const { return pn >= 3 ? 512 : 0; }
    DI void operator()(AccT& acc, const Unit& u, int wr, int wc, int fr, int fq) const {
        const int pn = u.pn;
        const int wh = pn < 3 ? 0 : 1;
        float rsv[8];
#pragma unroll
        for (int i = 0; i < 8; ++i) rsv[i] = EPI_TAB(tab, wh, i);
        f32x4 rca[8], rcb[8];
        if (pn == 2) {
#pragma unroll
            for (int i = 0; i < 8; ++i) { const float* cr = cs + (size_t)EPI_ROW(i >> 2, i & 3) * 64 + 2 * (4 * ((((wc & 1) * 32 + fq * 8)) >> 3)); rca[i] = *(const f32x4*)cr; rcb[i] = *(const f32x4*)(cr + 4); }
        }
#pragma unroll
        for (int ai = 0; ai < 2; ++ai)
#pragma unroll
            for (int m = 0; m < 4; ++m) {
                const int row = EPI_ROW(ai, m);
                const float rs = rsv[ai * 4 + m];
                if (pn < 3) {
#pragma unroll
                    for (int bj = 0; bj < 2; ++bj) {
                        f32x4 v0 = acc[ai][bj][m][0] * rs, v1 = acc[ai][bj][m][1] * rs;
                        const int cl = bj * 128 + wc * 32 + fq * 8;
                        if (pn < 2) *(u32x4*)(qn + (size_t)row * 512 + pn * 256 + cl) = pack8(v0, v1);
                        else { rope8(v0, v1, rca[ai * 4 + m], rcb[ai * 4 + m]); *(u32x4*)(qr + (size_t)row * 256 + cl) = pack8(v0, v1); }
                    }
                } else {
                    const int hd = pn - 3;
                    const int cl = wc * 32 + fq * 8, b = row >> 12, s = row & 4095;
                    { f32x4 v0 = acc[ai][0][m][0] * rs, v1 = acc[ai][0][m][1] * rs; *(u32x4*)(kn + (size_t)row * 512 + hd * 128 + cl) = pack8(v0, v1); }
                    { f32x4 v0 = acc[ai][1][m][0] * rs, v1 = acc[ai][1][m][1] * rs; store_tr8(vmt + ((size_t)(b * 4 + hd) * 128 + cl) * S_ + s, v0, v1); }
                }
            }
    }
};
struct EpiOut {
    DI int a_off(int) const { return 0; }
    const LAS float* tab; const bf16_t* xb; bf16_t* h1b; float* ph;
    DI void operator()(AccT& acc, const Unit& u, int wr, int wc, int fr, int fq) const {
        float rsv[8];
        const int wh = u.kh == 0 ? 0 : 1;
#pragma unroll
        for (int i = 0; i < 8; ++i) rsv[i] = EPI_TAB(tab, wh, i);
        if (u.kh == 0) {
#pragma unroll
            for (int ai = 0; ai < 2; ++ai)
#pragma unroll
                for (int m = 0; m < 4; ++m)
#pragma unroll
                    for (int bj = 0; bj < 2; ++bj) { acc[ai][bj][m][0] *= rsv[ai * 4 + m]; acc[ai][bj][m][1] *= rsv[ai * 4 + m]; }
            return;
        }
        u32x4 res[8][2];
#pragma unroll
        for (int i = 0; i < 8; ++i)
#pragma unroll
            for (int bj = 0; bj < 2; ++bj) res[i][bj] = *(const u32x4*)(xb + (size_t)EPI_ROW(i >> 2, i & 3) * 1024 + u.pn * 256 + bj * 128 + wc * 32 + fq * 8);
#pragma unroll
        for (int ai = 0; ai < 2; ++ai)
#pragma unroll
            for (int m = 0; m < 4; ++m) {
                const int row = EPI_ROW(ai, m);
                const float rml = rsv[ai * 4 + m];
                float ss = 0.f;
#pragma unroll
                for (int bj = 0; bj < 2; ++bj) {
                    const size_t off = (size_t)row * 1024 + u.pn * 256 + bj * 128 + wc * 32 + fq * 8;
                    f32x4 r0, r1; unpack8(res[ai * 4 + m][bj], r0, r1);
                    const f32x4 v0 = acc[ai][bj][m][0] * rml + r0, v1 = acc[ai][bj][m][1] * rml + r1;
                    *(u32x4*)(h1b + off) = pack8(v0, v1);
                    ss += sq4(v0) + sq4(v1);
                }
                ss += __shfl_xor(ss, 16); ss = xhalf_sum(ss);
                if (fq == 0) ph[(size_t)row * 16 + u.pn * 4 + wc] = ss;
            }
    }
};
struct EpiUp {
    DI int a_off(int) const { return 0; }
    const LAS float* rst; bf16_t* hid;
    DI void operator()(AccT& acc, const Unit& u, int wr, int wc, int fr, int fq) const {
        float rsv[8];
#pragma unroll
        for (int i = 0; i < 8; ++i) rsv[i] = EPI_TAB(rst, 0, i);
#pragma unroll
        for (int ai = 0; ai < 2; ++ai)
#pragma unroll
            for (int m = 0; m < 4; ++m) {
                const int row = EPI_ROW(ai, m);
                const float rs = rsv[ai * 4 + m];
#pragma unroll
                for (int bj = 0; bj < 2; ++bj) {
                    f32x4 v0 = acc[ai][bj][m][0] * rs, v1 = acc[ai][bj][m][1] * rs;
#pragma unroll
                    for (int e = 0; e < 4; ++e) { const float a = fmaxf(v0[e], 0.f), b = fmaxf(v1[e], 0.f); v0[e] = a * a; v1[e] = b * b; }
                    *(u32x4*)(hid + (size_t)row * 4096 + u.pn * 256 + bj * 128 + wc * 32 + fq * 8) = pack8(v0, v1);
                }
            }
    }
};
struct EpiDown {
    DI int a_off(int) const { return 0; }
    const bf16_t* h1b; bf16_t* h2b; float* pf;
    DI void operator()(AccT& acc, const Unit& u, int wr, int wc, int fr, int fq) const {
        u32x4 res[8][2];
#pragma unroll
        for (int i = 0; i < 8; ++i)
#pragma unroll
            for (int bj = 0; bj < 2; ++bj) res[i][bj] = *(const u32x4*)(h1b + (size_t)EPI_ROW(i >> 2, i & 3) * 1024 + u.pn * 256 + bj * 128 + wc * 32 + fq * 8);
#pragma unroll
        for (int ai = 0; ai < 2; ++ai)
#pragma unroll
            for (int m = 0; m < 4; ++m) {
                const int row = EPI_ROW(ai, m);
                float ss = 0.f;
#pragma unroll
                for (int bj = 0; bj < 2; ++bj) {
                    const size_t off = (size_t)row * 1024 + u.pn * 256 + bj * 128 + wc * 32 + fq * 8;
                    f32x4 r0, r1; unpack8(res[ai * 4 + m][bj], r0, r1);
                    const f32x4 v0 = acc[ai][bj][m][0] + r0, v1 = acc[ai][bj][m][1] + r1;
                    *(u32x4*)(h2b + off) = pack8(v0, v1);
                    ss += sq4(v0) + sq4(v1);
                }
                ss += __shfl_xor(ss, 16); ss = xhalf_sum(ss);
                if (fq == 0) pf[(size_t)row * 16 + u.pn * 4 + wc] = ss;
            }
    }
};

constexpr int MLA_KROW = 400, MLA_VROW = 144, MLA_KBYTES = 64 * MLA_KROW, MLA_BUF = MLA_KBYTES + 128 * MLA_VROW;

DI void mla_s_softmax(const LAS unsigned char* base, int r, int h, bool is_diag, int lim, const bf16x8 (&qf)[12], f32x16 (&o)[4], float& m_run, float& l_run,
                      bf16x8 (&pf0)[2], bf16x8 (&pf1)[2]) {
    f32x16 s0 = zero16(), s1 = zero16();
    const LAS unsigned char* kp = base + r * MLA_KROW + h * 16;
#pragma unroll
    for (int g = 0; g < 3; ++g) {
        bf16x8 fa[4], fb[4];
#pragma unroll
        for (int j = 0; j < 4; ++j) { fa[j] = *(const LAS bf16x8*)(kp + (4 * g + j) * 32); fb[j] = *(const LAS bf16x8*)(kp + 32 * MLA_KROW + (4 * g + j) * 32); }
        __builtin_amdgcn_sched_barrier(0);
#pragma unroll
        for (int j = 0; j < 4; ++j) { s0 = MFMA32(fa[j], qf[4 * g + j], s0); s1 = MFMA32(fb[j], qf[4 * g + j], s1); }
        __builtin_amdgcn_sched_barrier(0);
    }
    if (is_diag) {
#pragma unroll
        for (int i = 0; i < 16; ++i) { if (16 * h + i > lim) s0[i] = -1e30f; if (32 + 16 * h + i > lim) s1[i] = -1e30f; }
    }
    float mx = fmaxf(s0[0], s1[0]);
#pragma unroll
    for (int i = 1; i < 16; ++i) mx = fmaxf(mx, fmaxf(s0[i], s1[i]));
    mx = xhalf_max(mx);
    const float mnew = fmaxf(m_run, mx);
    if (__builtin_amdgcn_ballot_w64(mnew > m_run + 8.0f) != 0ull) {
        const float alpha = __builtin_amdgcn_exp2f(m_run - mnew);
        l_run *= alpha;
#pragma unroll
        for (int dt = 0; dt < 4; ++dt) o[dt] *= alpha;
        m_run = mnew;
    }
    float ls = 0.f;
#pragma unroll
    for (int i = 0; i < 16; ++i) { s0[i] = __builtin_amdgcn_exp2f(s0[i] - m_run); s1[i] = __builtin_amdgcn_exp2f(s1[i] - m_run); ls += s0[i] + s1[i]; }
    l_run += ls;
#pragma unroll
    for (int s = 0; s < 2; ++s) {
        u32x4 a, c;
        a.x = pk2(s0[8 * s + 0], s0[8 * s + 1]); a.y = pk2(s0[8 * s + 2], s0[8 * s + 3]); a.z = pk2(s0[8 * s + 4], s0[8 * s + 5]); a.w = pk2(s0[8 * s + 6], s0[8 * s + 7]);
        c.x = pk2(s1[8 * s + 0], s1[8 * s + 1]); c.y = pk2(s1[8 * s + 2], s1[8 * s + 3]); c.z = pk2(s1[8 * s + 4], s1[8 * s + 5]); c.w = pk2(s1[8 * s + 6], s1[8 * s + 7]);
        pf0[s] = __builtin_bit_cast(bf16x8, a); pf1[s] = __builtin_bit_cast(bf16x8, c);
    }
}
DI void mla_pv(const LAS unsigned char* base, int r, int h, const bf16x8 (&pf0)[2], const bf16x8 (&pf1)[2], f32x16 (&o)[4]) {
    const LAS unsigned char* vp = base + MLA_KBYTES + r * MLA_VROW + h * 32;
#pragma unroll
    for (int s = 0; s < 2; ++s) {
        bf16x8 va[4], vb[4];
#pragma unroll
        for (int dt = 0; dt < 4; ++dt) { va[dt] = *(const LAS bf16x8*)(vp + dt * 32 * MLA_VROW + s * 16); vb[dt] = *(const LAS bf16x8*)(vp + dt * 32 * MLA_VROW + 64 + s * 16); }
        __builtin_amdgcn_sched_barrier(0);
#pragma unroll
        for (int dt = 0; dt < 4; ++dt) o[dt] = MFMA32(va[dt], pf0[s], o[dt]);
#pragma unroll
        for (int dt = 0; dt < 4; ++dt) o[dt] = MFMA32(vb[dt], pf1[s], o[dt]);
        __builtin_amdgcn_sched_barrier(0);
    }
}

DI void mla_block(const Params& p, LAS unsigned char* lds, int b, int hd, int qb, int tid) {
    asm volatile("" : "+v"(tid));
    const int wu = __builtin_amdgcn_readfirstlane(tid >> 6), lane = tid & 63, r = lane & 31, h = lane >> 5;
    const int q0 = qb * 256 + wu * 32;
    const bf16_t* QN = (const bf16_t*)(p.ws + OFF_QN); const bf16_t* QR = (const bf16_t*)(p.ws + OFF_QR);
    const size_t tok0 = (size_t)b * S_;
    bf16x8 qf[12];
    {
        const size_t qrow = tok0 + q0 + r;
#pragma unroll
        for (int ks = 0; ks < 8; ++ks) qf[ks] = *(const bf16x8*)(QN + qrow * 512 + hd * 128 + ks * 16 + h * 8);
#pragma unroll
        for (int ks = 0; ks < 4; ++ks) qf[8 + ks] = *(const bf16x8*)(QR + qrow * 256 + hd * 64 + ks * 16 + h * 8);
    }
    unsigned goff[6];
#pragma unroll
    for (int j = 0; j < 6; ++j) {
        const int pc = wu + 8 * j; goff[j] = 0;
        if (pc < 25) {
            const int c = pc * 64 + lane, lr = c / 25; int cc = c - lr * 25; if (cc == 24) cc = 0;
            const int k32 = lr & 31, key = (lr & 32) + 16 * ((k32 >> 2) & 1) + (k32 & 3) + 4 * (k32 >> 3);
            const unsigned tok = (unsigned)(b * S_ + key);
            goff[j] = (cc < 16) ? (unsigned)OFF_KN + (tok * 512u + hd * 128 + cc * 8) * 2u : (unsigned)OFF_PROJ + (tok * 2048u + 1920 + (cc - 16) * 8) * 2u;
        } else if (pc < 43) {
            const int c = (pc - 25) * 64 + lane, d = c / 9; int cc = c - d * 9; if (cc == 8) cc = 0;
            goff[j] = (unsigned)OFF_VMT + ((unsigned)((b * 4 + hd) * 128 + d) * (unsigned)S_ + cc * 8) * 2u;
        }
    }
    const char* wsb = uptr((const char*)p.ws);
#define MLA_STAGE(KT, BUF) do { _Pragma("unroll") for (int _j = 0; _j < 6; ++_j) { const int _pc = wu + 8 * _j; if (_pc < 43) { \
        const unsigned _inc = goff[_j] >= (unsigned)OFF_VMT ? 128u : (goff[_j] < (unsigned)OFF_VST ? 262144u : 65536u); \
        __builtin_amdgcn_global_load_lds((const unsigned*)(wsb + (goff[_j] + (unsigned)(KT) * _inc)), (LAS unsigned*)(lds + (BUF) * MLA_BUF + _pc * 1024), 16, 0, 0); } } } while (0)
    f32x16 o[4]; for (int dt = 0; dt < 4; ++dt) o[dt] = zero16();
    float m_run = -1e30f, l_run = 0.f;
    const int ntiles = 4 * qb + 4, wlast = q0 >> 6;
    __syncthreads();
    MLA_STAGE(0, 0);
    const bool late = wu >= 4;
    bf16x8 pf0[2], pf1[2];
    int bcur = 0;
    for (int kt = 0; kt < ntiles; ++kt) {
        asm volatile("s_waitcnt vmcnt(0)" ::: "memory");
        __builtin_amdgcn_s_barrier();
        asm volatile("" ::: "memory");
        const int bprev = bcur == 0 ? 2 : bcur - 1, bnext = bcur == 2 ? 0 : bcur + 1;
        if (kt + 1 < ntiles) MLA_STAGE(kt + 1, bnext);
        if (late && kt >= 1 && kt - 1 <= wlast) mla_pv(lds + bprev * MLA_BUF, r, h, pf0, pf1, o);
        if (kt <= wlast) {
            mla_s_softmax(lds + bcur * MLA_BUF, r, h, kt == wlast, q0 + r - kt * 64, qf, o, m_run, l_run, pf0, pf1);
            if (!late) mla_pv(lds + bcur * MLA_BUF, r, h, pf0, pf1, o);
        }
        bcur = bnext;
    }
    if (late && wlast == ntiles - 1) { const int bprev = bcur == 0 ? 2 : bcur - 1; mla_pv(lds + bprev * MLA_BUF, r, h, pf0, pf1, o); }
#undef MLA_STAGE
    const float lt = xhalf_sum(l_run), inv = 1.f / lt;
    bf16_t* mix = (bf16_t*)(p.ws + OFF_MIX) + (tok0 + q0 + r) * 1024 + 512 + hd * 128 + 4 * h;
    float ss = 0.f;
#pragma unroll
    for (int dt = 0; dt < 4; ++dt)
#pragma unroll
        for (int g = 0; g < 4; ++g) {
            const float a0 = o[dt][4 * g] * inv, a1 = o[dt][4 * g + 1] * inv, a2 = o[dt][4 * g + 2] * inv, a3 = o[dt][4 * g + 3] * inv;
            ss += (a0 * a0 + a1 * a1) + (a2 * a2 + a3 * a3);
            u32x2 w; w.x = pk2(a0, a1); w.y = pk2(a2, a3);
            *(u32x2*)(mix + dt * 32 + 8 * g) = w;
        }
    ss = xhalf_sum(ss);
    if (h == 0) ((float*)(p.ws + OFF_HSS))[(tok0 + q0 + r) * 16 + 8 + hd] = ss;
}

DI void sb_item(const Params& p, int bh, int qb32, int lane) {
    asm volatile("" : "+v"(lane));
    const int r = lane & 31, h = lane >> 5, b = bh >> 3, hd = bh & 7, q0 = qb32 * 32;
    const bf16_t* PROJ = (const bf16_t*)(p.ws + OFF_PROJ);
    const bf16_t* VST = (const bf16_t*)(p.ws + OFF_VST);
    const size_t tok0 = (size_t)b * S_;
    bf16x8 qf[4];
#pragma unroll
    for (int ks = 0; ks < 4; ++ks) qf[ks] = *(const bf16x8*)(PROJ + (tok0 + q0 + r) * 2048 + hd * 64 + ks * 16 + h * 8);
    const int pr = 16 * ((r >> 2) & 1) + (r & 3) + 4 * (r >> 3);
    const bf16_t* kbase = PROJ + (tok0 + pr) * 2048 + 512 + hd * 64 + h * 8;
    const bf16_t* vbase = VST + ((size_t)(b * 8 + hd) * 64 + r) * S_ + 16 * h;
    bf16x8 kc[4], kn[4], vf[4];
#pragma unroll
    for (int ks = 0; ks < 4; ++ks) kc[ks] = *(const bf16x8*)(kbase + (size_t)q0 * 2048 + ks * 16);
    f32x16 o0 = zero16(), o1 = zero16();
    float carry = 1.f;
    for (int kb = q0; kb >= 0; kb -= 32) {
#pragma unroll
        for (int dt = 0; dt < 2; ++dt)
#pragma unroll
            for (int s = 0; s < 2; ++s) vf[dt * 2 + s] = *(const bf16x8*)(vbase + (size_t)dt * 32 * S_ + kb + 8 * s);
        if (kb >= 32) {
#pragma unroll
            for (int ks = 0; ks < 4; ++ks) kn[ks] = *(const bf16x8*)(kbase + (size_t)(kb - 32) * 2048 + ks * 16);
        }
        f32x16 z = zero16();
#pragma unroll
        for (int ks = 0; ks < 4; ++ks) z = MFMA32(kc[ks], qf[ks], z);
        const bool diag = (kb == q0);
        f32x16 a;
        float tot = 1.f;
#pragma unroll
        for (int i = 15; i >= 0; --i) {
            const float w = __builtin_amdgcn_exp2f(fminf(z[i], 86.f));
            float be = __builtin_amdgcn_rcpf(1.f + w);
            float om = w * be;
            if (diag) { const bool valid = (16 * h + i < r); be = valid ? be : 0.f; om = valid ? om : 1.f; }
            a[i] = be * tot;
            tot *= om;
        }
        const float other = __shfl_xor(tot, 32);
        const float base = carry * (h == 0 ? other : 1.f);
        carry *= tot * other;
#pragma unroll
        for (int i = 0; i < 16; ++i) a[i] *= base;
        bf16x8 pf[2];
#pragma unroll
        for (int s = 0; s < 2; ++s) {
            u32x4 w; w.x = pk2(a[8 * s + 0], a[8 * s + 1]); w.y = pk2(a[8 * s + 2], a[8 * s + 3]); w.z = pk2(a[8 * s + 4], a[8 * s + 5]); w.w = pk2(a[8 * s + 6], a[8 * s + 7]);
            pf[s] = __builtin_bit_cast(bf16x8, w);
        }
#pragma unroll
        for (int s = 0; s < 2; ++s) { o0 = MFMA32(vf[s], pf[s], o0); o1 = MFMA32(vf[2 + s], pf[s], o1); }
        if (kb >= 32) {
#pragma unroll
            for (int ks = 0; ks < 4; ++ks) kc[ks] = kn[ks];
        }
        if (__all(carry < SB_PTHR)) break;
    }
    bf16_t* mix = (bf16_t*)(p.ws + OFF_MIX) + (tok0 + q0 + r) * 1024 + hd * 64 + 4 * h;
    float ss = 0.f;
#pragma unroll
    for (int g = 0; g < 4; ++g) {
        { const float a0 = o0[4 * g], a1 = o0[4 * g + 1], a2 = o0[4 * g + 2], a3 = o0[4 * g + 3];
          ss += (a0 * a0 + a1 * a1) + (a2 * a2 + a3 * a3); u32x2 w; w.x = pk2(a0, a1); w.y = pk2(a2, a3); *(u32x2*)(mix + 8 * g) = w; }
        { const float a0 = o1[4 * g], a1 = o1[4 * g + 1], a2 = o1[4 * g + 2], a3 = o1[4 * g + 3];
          ss += (a0 * a0 + a1 * a1) + (a2 * a2 + a3 * a3); u32x2 w; w.x = pk2(a0, a1); w.y = pk2(a2, a3); *(u32x2*)(mix + 32 + 8 * g) = w; }
    }
    ss = xhalf_sum(ss);
    if (h == 0) ((float*)(p.ws + OFF_HSS))[(tok0 + q0 + r) * 16 + hd] = ss;
}

constexpr int SB_ROW = 144, SB_KBYTES = 64 * SB_ROW, SB_BUF = 2 * SB_KBYTES  , SB_NB = 7, SB_FLAGS = SB_NB * SB_BUF;
DI void sb_block(const Params& p, LAS unsigned char* lds, int bh, int qb, int tid) {
    asm volatile("" : "+v"(tid));
    const int wu = __builtin_amdgcn_readfirstlane(tid >> 6), lane = tid & 63, r = lane & 31, h = lane >> 5;
    const int b = bh >> 3, hd = bh & 7, q0 = qb * 256 + wu * 32;
    const bf16_t* PROJ = (const bf16_t*)(p.ws + OFF_PROJ);
    const size_t tok0 = (size_t)b * S_;
    bf16x8 qf[4];
#pragma unroll
    for (int ks = 0; ks < 4; ++ks) qf[ks] = *(const bf16x8*)(PROJ + (tok0 + q0 + r) * 2048 + hd * 64 + ks * 16 + h * 8);
    unsigned goff[3];
#pragma unroll
    for (int j = 0; j < 3; ++j) {
        const int pc = wu + 8 * j; goff[j] = 0;
        if (pc < 18) {
            const int c = (pc < 9 ? pc : pc - 9) * 64 + lane, lr = c / 9; int cc = c - lr * 9; if (cc == 8) cc = 0;
            if (pc < 9) { const int k32 = lr & 31, key = (lr & 32) + 16 * ((k32 >> 2) & 1) + (k32 & 3) + 4 * (k32 >> 3);
                goff[j] = (unsigned)OFF_PROJ + ((unsigned)(b * S_ + key) * 2048u + 512 + hd * 64 + cc * 8) * 2u; }
            else goff[j] = (unsigned)OFF_VST + ((unsigned)((b * 8 + hd) * 64 + lr) * (unsigned)S_ + cc * 8) * 2u;
        }
    }
    const char* wsb = uptr((const char*)p.ws);
#define SB_STAGE(KT, BUF) do { _Pragma("unroll") for (int _j = 0; _j < 3; ++_j) { const int _pc = wu + 8 * _j; if (_pc < 18) { \
        const unsigned _inc = goff[_j] >= (unsigned)OFF_VST ? 128u : 262144u; \
        __builtin_amdgcn_global_load_lds((const unsigned*)(wsb + (goff[_j] + (unsigned)(KT) * _inc)), (LAS unsigned*)(lds + (BUF) * SB_BUF + _pc * 1024), 16, 0, 0); } } } while (0)
    f32x16 o0 = zero16(), o1 = zero16();
    float carry = 1.f;
    bool done = false;
    const int ktop = 4 * qb + 3;
    LAS int* flags = (LAS int*)(lds + SB_FLAGS);
    asm volatile("s_waitcnt vmcnt(0)" ::: "memory");
    __syncthreads();
    const int nstaged = ktop + 1 < SB_NB ? ktop + 1 : SB_NB;
    for (int i = 0; i < nstaged; ++i) SB_STAGE(ktop - i, i);
#define SB_WAITV(n) asm volatile("s_waitcnt vmcnt(" #n ") lgkmcnt(0)" ::: "memory")
    int cur = 0, it = 0;
    for (int kt = ktop; ; --kt, ++it) {
        if (lane == 0) flags[(it & 1) * 8 + wu] = done ? 1 : 0;
        if (it >= SB_NB && kt >= 0) SB_STAGE(kt, cur);
        const int ahead = it < nstaged ? nstaged - 1 - it : 0;
        if (wu < 2) { switch (ahead) { case 0: SB_WAITV(0); break; case 1: SB_WAITV(3); break; case 2: SB_WAITV(6); break; case 3: SB_WAITV(9); break; case 4: SB_WAITV(12); break; case 5: SB_WAITV(15); break; default: SB_WAITV(18); break; } }
        else { switch (ahead) { case 0: SB_WAITV(0); break; case 1: SB_WAITV(2); break; case 2: SB_WAITV(4); break; case 3: SB_WAITV(6); break; case 4: SB_WAITV(8); break; case 5: SB_WAITV(10); break; default: SB_WAITV(12); break; } }
        __builtin_amdgcn_s_barrier();
        asm volatile("" ::: "memory");
        {
            const LAS int* f = flags + (it & 1) * 8;
            const int all = f[0] & f[1] & f[2] & f[3] & f[4] & f[5] & f[6] & f[7];
            if (__builtin_amdgcn_readfirstlane(all)) break;
        }
        if (!done && kt * 64 <= q0) {
            const LAS unsigned char* base = lds + cur * SB_BUF;
#pragma unroll
            for (int sub = 1; sub >= 0; --sub) {
                const int kb = kt * 64 + sub * 32;
                if (kb <= q0 && !done) {
                    const LAS unsigned char* kp = base + (sub * 32 + r) * SB_ROW + h * 16;
                    bf16x8 kf[4], vf[4];
#pragma unroll
                    for (int ks = 0; ks < 4; ++ks) kf[ks] = *(const LAS bf16x8*)(kp + ks * 32);
#pragma unroll
                    for (int dt = 0; dt < 2; ++dt)
#pragma unroll
                        for (int s2 = 0; s2 < 2; ++s2) vf[dt * 2 + s2] = *(const LAS bf16x8*)(base + SB_KBYTES + (dt * 32 + r) * SB_ROW + (sub * 32 + 16 * h + 8 * s2) * 2);
                    f32x16 z = zero16();
#pragma unroll
                    for (int ks = 0; ks < 4; ++ks) z = MFMA32(kf[ks], qf[ks], z);
                    const bool diag = (kb == q0);
                    f32x16 a;
                    float tot = 1.f;
#pragma unroll
                    for (int i = 15; i >= 0; --i) {
                        const float w = __builtin_amdgcn_exp2f(fminf(z[i], 86.f));
                        float be = __builtin_amdgcn_rcpf(1.f + w);
                        float om = w * be;
                        if (diag) { const bool valid = (16 * h + i < r); be = valid ? be : 0.f; om = valid ? om : 1.f; }
                        a[i] = be * tot;
                        tot *= om;
                    }
                    const float other = __shfl_xor(tot, 32);
                    const float bs = carry * (h == 0 ? other : 1.f);
                    carry *= tot * other;
#pragma unroll
                    for (int i = 0; i < 16; ++i) a[i] *= bs;
                    bf16x8 pf[2];
#pragma unroll
                    for (int s2 = 0; s2 < 2; ++s2) {
                        u32x4 w; w.x = pk2(a[8 * s2 + 0], a[8 * s2 + 1]); w.y = pk2(a[8 * s2 + 2], a[8 * s2 + 3]); w.z = pk2(a[8 * s2 + 4], a[8 * s2 + 5]); w.w = pk2(a[8 * s2 + 6], a[8 * s2 + 7]);
                        pf[s2] = __builtin_bit_cast(bf16x8, w);
                    }
#pragma unroll
                    for (int s2 = 0; s2 < 2; ++s2) { o0 = MFMA32(vf[s2], pf[s2], o0); o1 = MFMA32(vf[2 + s2], pf[s2], o1); }
                    if (__all(carry < SB_PTHR)) done = true;
                }
            }
            if (kt == 0) done = true;
        }
        cur = cur == SB_NB - 1 ? 0 : cur + 1;
    }
    asm volatile("s_waitcnt vmcnt(0)" ::: "memory");
#undef SB_WAITV
#undef SB_STAGE
    bf16_t* mix = (bf16_t*)(p.ws + OFF_MIX) + (tok0 + q0 + r) * 1024 + hd * 64 + 4 * h;
    float ss = 0.f;
#pragma unroll
    for (int g = 0; g < 4; ++g) {
        { const float a0 = o0[4 * g], a1 = o0[4 * g + 1], a2 = o0[4 * g + 2], a3 = o0[4 * g + 3];
          ss += (a0 * a0 + a1 * a1) + (a2 * a2 + a3 * a3); u32x2 w; w.x = pk2(a0, a1); w.y = pk2(a2, a3); *(u32x2*)(mix + 8 * g) = w; }
        { const float a0 = o1[4 * g], a1 = o1[4 * g + 1], a2 = o1[4 * g + 2], a3 = o1[4 * g + 3];
          ss += (a0 * a0 + a1 * a1) + (a2 * a2 + a3 * a3); u32x2 w; w.x = pk2(a0, a1); w.y = pk2(a2, a3); *(u32x2*)(mix + 32 + 8 * g) = w; }
    }
    ss = xhalf_sum(ss);
    if (h == 0) ((float*)(p.ws + OFF_HSS))[(tok0 + q0 + r) * 16 + hd] = ss;
}

DI void sb_block2(const Params& p, LAS unsigned char* lds, int bh, int qb2, int tid) {
    asm volatile("" : "+v"(tid));
    const int wu = __builtin_amdgcn_readfirstlane(tid >> 6), lane = tid & 63, r = lane & 31, h = lane >> 5;
    const int b = bh >> 3, hd = bh & 7;
    int q0[2]; q0[0] = qb2 * 512 + wu * 32; q0[1] = q0[0] + 256;
    const bf16_t* PROJ = (const bf16_t*)(p.ws + OFF_PROJ);
    const size_t tok0 = (size_t)b * S_;
    bf16x8 qf[2][4];
#pragma unroll
    for (int g = 0; g < 2; ++g)
#pragma unroll
        for (int ks = 0; ks < 4; ++ks) qf[g][ks] = *(const bf16x8*)(PROJ + (tok0 + q0[g] + r) * 2048 + hd * 64 + ks * 16 + h * 8);
    unsigned goff[3];
#pragma unroll
    for (int j = 0; j < 3; ++j) {
        const int pc = wu + 8 * j; goff[j] = 0;
        if (pc < 18) {
            const int c = (pc < 9 ? pc : pc - 9) * 64 + lane, lr = c / 9; int cc = c - lr * 9; if (cc == 8) cc = 0;
            if (pc < 9) { const int k32 = lr & 31, key = (lr & 32) + 16 * ((k32 >> 2) & 1) + (k32 & 3) + 4 * (k32 >> 3);
                goff[j] = (unsigned)OFF_PROJ + ((unsigned)(b * S_ + key) * 2048u + 512 + hd * 64 + cc * 8) * 2u; }
            else goff[j] = (unsigned)OFF_VST + ((unsigned)((b * 8 + hd) * 64 + lr) * (unsigned)S_ + cc * 8) * 2u;
        }
    }
    const char* wsb = uptr((const char*)p.ws);
#define SB_STAGE(KT, BUF) do { _Pragma("unroll") for (int _j = 0; _j < 3; ++_j) { const int _pc = wu + 8 * _j; if (_pc < 18) { \
        const unsigned _inc = goff[_j] >= (unsigned)OFF_VST ? 128u : 262144u; \
        __builtin_amdgcn_global_load_lds((const unsigned*)(wsb + (goff[_j] + (unsigned)(KT) * _inc)), (LAS unsigned*)(lds + (BUF) * SB_BUF + _pc * 1024), 16, 0, 0); } } } while (0)
    f32x16 o0[2], o1[2]; float carry[2]; bool done[2];
#pragma unroll
    for (int g = 0; g < 2; ++g) { o0[g] = zero16(); o1[g] = zero16(); carry[g] = 1.f; done[g] = false; }
    const int ktop = 8 * qb2 + 7;
    LAS int* flags = (LAS int*)(lds + SB_FLAGS);
    asm volatile("s_waitcnt vmcnt(0)" ::: "memory");
    __syncthreads();
    const int nstaged = ktop + 1 < SB_NB ? ktop + 1 : SB_NB;
    for (int i = 0; i < nstaged; ++i) SB_STAGE(ktop - i, i);
#define SB_WAITV(n) asm volatile("s_waitcnt vmcnt(" #n ") lgkmcnt(0)" ::: "memory")
    int cur = 0, it = 0;
    for (int kt = ktop; ; --kt, ++it) {
        if (lane == 0) flags[(it & 1) * 8 + wu] = (done[0] && done[1]) ? 1 : 0;
        int lowest = ktop - (SB_NB - 1) - (it > 0 ? it - 1 : 0); if (lowest < 0) lowest = 0;
        int ahead = kt - lowest; if (ahead < 0) ahead = 0;
        if (wu < 2) { switch (ahead) { case 0: SB_WAITV(0); break; case 1: SB_WAITV(3); break; case 2: SB_WAITV(6); break; case 3: SB_WAITV(9); break; case 4: SB_WAITV(12); break; case 5: SB_WAITV(15); break; default: SB_WAITV(18); break; } }
        else { switch (ahead) { case 0: SB_WAITV(0); break; case 1: SB_WAITV(2); break; case 2: SB_WAITV(4); break; case 3: SB_WAITV(6); break; case 4: SB_WAITV(8); break; case 5: SB_WAITV(10); break; default: SB_WAITV(12); break; } }
        __builtin_amdgcn_s_barrier();
        asm volatile("" ::: "memory");
        {
            const LAS int* f = flags + (it & 1) * 8;
            const int all = f[0] & f[1] & f[2] & f[3] & f[4] & f[5] & f[6] & f[7];
            if (__builtin_amdgcn_readfirstlane(all)) break;
        }
        if (it >= 1 && kt - (SB_NB - 1) >= 0) SB_STAGE(kt - (SB_NB - 1), cur == 0 ? SB_NB - 1 : cur - 1);
        {
            const LAS unsigned char* base = lds + cur * SB_BUF;
#pragma unroll
            for (int sub = 1; sub >= 0; --sub) {
                const int kb = kt * 64 + sub * 32;
                const LAS unsigned char* kp = base + (sub * 32 + r) * SB_ROW + h * 16;
                const bool act0 = !done[0] && kb <= q0[0], act1 = !done[1] && kb <= q0[1];
                if (act0 || act1) {
                    bf16x8 kf[4], vf[4];
#pragma unroll
                    for (int ks = 0; ks < 4; ++ks) kf[ks] = *(const LAS bf16x8*)(kp + ks * 32);
#pragma unroll
                    for (int dt = 0; dt < 2; ++dt)
#pragma unroll
                        for (int s2 = 0; s2 < 2; ++s2) vf[dt * 2 + s2] = *(const LAS bf16x8*)(base + SB_KBYTES + (dt * 32 + r) * SB_ROW + (sub * 32 + 16 * h + 8 * s2) * 2);
                    f32x16 zz[2];
#pragma unroll
                    for (int g = 0; g < 2; ++g) {
                        zz[g] = zero16();
                        if (g == 0 ? act0 : act1) {
#pragma unroll
                            for (int ks = 0; ks < 4; ++ks) zz[g] = MFMA32(kf[ks], qf[g][ks], zz[g]);
                        }
                    }
#pragma unroll
                    for (int g = 0; g < 2; ++g) {
                        if (g == 0 ? act0 : act1) {
                            const f32x16 z = zz[g];
                            const bool diag = (kb == q0[g]);
                            f32x16 a;
                            float tot = 1.f;
#pragma unroll
                            for (int i = 15; i >= 0; --i) {
                                const float w = __builtin_amdgcn_exp2f(fminf(z[i], 86.f));
                                float be = __builtin_amdgcn_rcpf(1.f + w);
                                float om = w * be;
                                if (diag) { const bool valid = (16 * h + i < r); be = valid ? be : 0.f; om = valid ? om : 1.f; }
                                a[i] = be * tot;
                                tot *= om;
                            }
                            float tlo, thi; xhalf(tot, tlo, thi);
                            const float bs = carry[g] * (h == 0 ? thi : 1.f);
                            carry[g] *= tlo * thi;
#pragma unroll
                            for (int i = 0; i < 16; ++i) a[i] *= bs;
                            bf16x8 pf[2];
#pragma unroll
                            for (int s2 = 0; s2 < 2; ++s2) {
                                u32x4 w; w.x = pk2(a[8 * s2 + 0], a[8 * s2 + 1]); w.y = pk2(a[8 * s2 + 2], a[8 * s2 + 3]); w.z = pk2(a[8 * s2 + 4], a[8 * s2 + 5]); w.w = pk2(a[8 * s2 + 6], a[8 * s2 + 7]);
                                pf[s2] = __builtin_bit_cast(bf16x8, w);
                            }
#pragma unroll
                            for (int s2 = 0; s2 < 2; ++s2) { o0[g] = MFMA32(vf[s2], pf[s2], o0[g]); o1[g] = MFMA32(vf[2 + s2], pf[s2], o1[g]); }
                            if (__all(carry[g] < SB_PTHR)) done[g] = true;
                        }
                    }
                }
            }
            if (kt == 0) { done[0] = true; done[1] = true; }
        }
        cur = cur == SB_NB - 1 ? 0 : cur + 1;
    }
    asm volatile("s_waitcnt vmcnt(0)" ::: "memory");
#undef SB_WAITV
#undef SB_STAGE
#pragma unroll
    for (int g = 0; g < 2; ++g) {
        bf16_t* mix = (bf16_t*)(p.ws + OFF_MIX) + (tok0 + q0[g] + r) * 1024 + hd * 64 + 4 * h;
        float ss = 0.f;
#pragma unroll
        for (int gg = 0; gg < 4; ++gg) {
            { const float a0 = o0[g][4 * gg], a1 = o0[g][4 * gg + 1], a2 = o0[g][4 * gg + 2], a3 = o0[g][4 * gg + 3];
              ss += (a0 * a0 + a1 * a1) + (a2 * a2 + a3 * a3); u32x2 w; w.x = pk2(a0, a1); w.y = pk2(a2, a3); *(u32x2*)(mix + 8 * gg) = w; }
            { const float a0 = o1[g][4 * gg], a1 = o1[g][4 * gg + 1], a2 = o1[g][4 * gg + 2], a3 = o1[g][4 * gg + 3];
              ss += (a0 * a0 + a1 * a1) + (a2 * a2 + a3 * a3); u32x2 w; w.x = pk2(a0, a1); w.y = pk2(a2, a3); *(u32x2*)(mix + 32 + 8 * gg) = w; }
        }
        ss = xhalf_sum(ss);
        if (h == 0) ((float*)(p.ws + OFF_HSS))[(tok0 + q0[g] + r) * 16 + hd] = ss;
    }
}

DI void phase_attention(const Params& p, LAS unsigned char* lds, int tid, int which = 3) {
    const int blk = blockIdx.x, G = gridDim.x;
#ifndef NO_MLA
    if (which & 1) for (int it = blk; it < 512; it += G) {
        const int xcd = it & 7, local = (it >> 3) & 63;
        const int bh = xcd * 8 + (local >> 3), pr = local & 7;
        mla_block(p, lds, bh >> 2, bh & 3, pr, tid);
        mla_block(p, lds, bh >> 2, bh & 3, 15 - pr, tid);
    }
#endif
#ifndef NO_SB
    if (which & 2) for (int it = blk; it < 1024; it += G) {
        const int xcd = it & 7, local = (it >> 3) & 127;
        sb_block2(p, lds, xcd * 16 + (local >> 3), local & 7, tid);
    }
#endif
}

DI void phase_final(const Params& p, int tid) {
    const int wid = tid >> 6, lane = tid & 63;
    const float* pf = (const float*)(p.ws + OFF_PF);
    const bf16_t* h2b = (const bf16_t*)(p.ws + OFF_MIX);
    f32x4 ga[2], gb[2];
#pragma unroll
    for (int j = 0; j < 2; ++j) { ga[j] = *(const f32x4*)(p.g_final + j * 512 + lane * 8); gb[j] = *(const f32x4*)(p.g_final + j * 512 + lane * 8 + 4); }
    for (int row = blockIdx.x * 8 + wid; row < T_; row += gridDim.x * 8) {
        const f32x4* pp = (const f32x4*)(pf + (size_t)row * 16);
        u32x4 w[2];
#pragma unroll
        for (int j = 0; j < 2; ++j) w[j] = *(const u32x4*)(h2b + (size_t)row * 1024 + j * 512 + lane * 8);
        const float rs = rsqrtf(((sum4(pp[0]) + sum4(pp[1])) + (sum4(pp[2]) + sum4(pp[3]))) * (1.f / 1024.f) + EPS_);
        float* orow = p.out + (size_t)row * 1024 + lane * 8;
#pragma unroll
        for (int j = 0; j < 2; ++j) { f32x4 a, b; unpack8(w[j], a, b); *(f32x4*)(orow + j * 512) = a * rs * ga[j]; *(f32x4*)(orow + j * 512 + 4) = b * rs * gb[j]; }
    }
}

#define XB_TMO      128
#define XB_XCNT(j)  (256  + 64 * (j))
#define XB_XSUB(j)  (1280 + 64 * (j))
#define XB_XGEN(j)  (2304 + 64 * (j))
#define XB_TOP      3328
#define XB_TOPGEN   3392
#define XCD_BAR_WORDS 3456
#define XB_SPIN_CAP (1u << 18)
DI unsigned xb_ld(unsigned* p)              { return __hip_atomic_load(p, __ATOMIC_RELAXED, __HIP_MEMORY_SCOPE_AGENT); }
DI unsigned xb_add(unsigned* p, unsigned v) { return __hip_atomic_fetch_add(p, v, __ATOMIC_RELAXED, __HIP_MEMORY_SCOPE_AGENT); }
DI unsigned xb_xcc_id() { return (unsigned)__builtin_amdgcn_s_getreg((3 << 11) | 20) & 0xFu; }
#define XB_SPIN(cond, bar) do { unsigned _sp = 0; while (cond) { __builtin_amdgcn_s_sleep(1); \
    if ((++_sp & 255u) == 0u) { if (xb_ld(&(bar)[XB_TMO])) break; if (_sp > XB_SPIN_CAP) { atomicAdd(&(bar)[XB_TMO], 1u); break; } } } } while (0)
struct XcdBarrier { unsigned* bar; unsigned x; volatile LAS unsigned* st; };
DI XcdBarrier xcd_barrier_post(unsigned* bar, volatile LAS unsigned* st) {
    XcdBarrier b; b.bar = bar; b.x = xb_xcc_id(); b.st = st;
    if (threadIdx.x == 0) (void)xb_add(&bar[XB_XCNT(b.x)], 1u);
    return b;
}
DI void xcd_barrier_complete(unsigned* bar, unsigned x, unsigned& nloc, unsigned& nx) {
    const unsigned G = gridDim.x * gridDim.y * gridDim.z;
    unsigned sum, cnt, mine, sp = 0u;
    for (;;) {
        sum = 0u; cnt = 0u; mine = 0u;
#pragma unroll
        for (unsigned j = 0; j < 16; ++j) { const unsigned c = xb_ld(&bar[XB_XCNT(j)]); sum += c; cnt += (c > 0u) ? 1u : 0u; mine = (j == x) ? c : mine; }
        if (sum == G) break;
        __builtin_amdgcn_s_sleep(1);
        if ((++sp & 255u) == 0u) { if (xb_ld(&bar[XB_TMO])) break; if (sp > XB_SPIN_CAP) { atomicAdd(&bar[XB_TMO], 1u); break; } }
    }
    nloc = mine > 0u ? mine : 1u; nx = cnt > 0u ? cnt : 1u;
}
DI void xcd_barrier(const XcdBarrier& b) {
    asm volatile("s_waitcnt vmcnt(0)" ::: "memory");
    __syncthreads();
    if (threadIdx.x == 0) {
        unsigned* bar = b.bar;
        __builtin_amdgcn_s_waitcnt(0);
        unsigned nloc = b.st[0], nx = b.st[1];
        if (nloc == 0u) { xcd_barrier_complete(bar, b.x, nloc, nx); b.st[0] = nloc; b.st[1] = nx; }
        const unsigned old = xb_add(&bar[XB_XSUB(b.x)], 1u);
        const unsigned gen = old / nloc;
        if (old + 1u == (gen + 1u) * nloc) {
            __builtin_amdgcn_fence(__ATOMIC_RELEASE, "agent");
            asm volatile("s_waitcnt vmcnt(0)" ::: "memory");
            const unsigned og = xb_add(&bar[XB_TOP], 1u);
            const unsigned tg = og / nx;
            if (og + 1u == (tg + 1u) * nx) xb_add(&bar[XB_TOPGEN], 1u);
            else XB_SPIN(xb_ld(&bar[XB_TOPGEN]) == tg, bar);
            __builtin_amdgcn_fence(__ATOMIC_ACQUIRE, "agent");
            xb_add(&bar[XB_XGEN(b.x)], 1u);
            asm volatile("s_waitcnt vmcnt(0)" ::: "memory");
        } else {
            XB_SPIN(xb_ld(&bar[XB_XGEN(b.x)]) == gen, bar);
            __builtin_amdgcn_fence(__ATOMIC_ACQUIRE, "agent");
            asm volatile("s_waitcnt vmcnt(0)" ::: "memory");
        }
    }
    __syncthreads();
}

#ifndef PH_MASK
#define PH_MASK 255
#endif
#ifndef DUP_MASK
#define DUP_MASK 0
#endif
#ifndef DUP_WHICH
#define DUP_WHICH 3
#endif
constexpr int LDS_XB = g8::STAGE_BYTES + 8192;
constexpr int LDS_BYTES = g8::STAGE_BYTES + 8192 + 64;

__global__ void __launch_bounds__(512, 2) hymba_fwd(Params p) {
    extern __shared__ __attribute__((aligned(16))) unsigned char lds_raw[];
    LAS unsigned char* lds = (LAS unsigned char*)lds_raw;
    cg::grid_group grid = cg::this_grid();
    const int wid_s = __builtin_amdgcn_readfirstlane((int)threadIdx.x >> 6);
    unsigned char* ws = p.ws;

    volatile LAS unsigned* xst = (volatile LAS unsigned*)(lds + LDS_XB);
    if (threadIdx.x == 0) { xst[0] = 0u; xst[1] = 0u; }
    __syncthreads();
    const XcdBarrier xb = xcd_barrier_post((unsigned*)(ws + OFF_BAR), xst);
    if (p.out == nullptr) grid.sync();
    if (PH_MASK & 1) phase0(p, lds, fresh_tid(wid_s));
    xcd_barrier(xb);
    if (DUP_MASK & 1) { phase0(p, lds, fresh_tid(wid_s)); xcd_barrier(xb); }
    if (PH_MASK & 2) {
        LAS float* tab = (LAS float*)(lds + g8::STAGE_BYTES);
        EpiProj E{tab, (const float*)(ws + OFF_CS), (bf16_t*)(ws + OFF_PROJ), (bf16_t*)(ws + OFF_VST), (float*)(ws + OFF_PQ), (float*)(ws + OFF_PKV)};
        g8::gemm_phase<1, 1>(lds, wid_s, (const bf16_t*)(ws + OFF_XB), 1024, (const bf16_t*)(ws + OFF_WIN), 1024, T_, 2048, 1024, E, TabFill<RowRsx>{tab, wid_s, RowRsx{(const float*)(ws + OFF_RSX)}});
    }
    xcd_barrier(xb);
    if (PH_MASK & 4) {
        LAS float* tab = (LAS float*)(lds + g8::STAGE_BYTES);
        EpiQKV E{tab, (const float*)(ws + OFF_CS), (bf16_t*)(ws + OFF_QN), (bf16_t*)(ws + OFF_QR), (bf16_t*)(ws + OFF_KN), (bf16_t*)(ws + OFF_VMT)};
        g8::gemm_phase<1>(lds, wid_s, (const bf16_t*)(ws + OFF_PROJ) + 1536, 2048, (const bf16_t*)(ws + OFF_WQB), 256, T_, 1792, 256, E, TabFill<RowQKV>{tab, wid_s, RowQKV{(const float*)(ws + OFF_PQ), (const float*)(ws + OFF_PKV)}});
    }
    xcd_barrier(xb);
    if (PH_MASK & 8) phase_attention(p, lds, fresh_tid(wid_s));
    xcd_barrier(xb);
    if (DUP_MASK & 8) { phase_attention(p, lds, fresh_tid(wid_s), DUP_WHICH); xcd_barrier(xb); }
    if (PH_MASK & 16) {
        LAS float* tab = (LAS float*)(lds + g8::STAGE_BYTES);
        EpiOut E{tab, (const bf16_t*)(ws + OFF_XB), (bf16_t*)(ws + OFF_H1B), (float*)(ws + OFF_PH)};
        g8::gemm_phase<2>(lds, wid_s, (const bf16_t*)(ws + OFF_MIX), 1024, (const bf16_t*)(ws + OFF_WO), 1024, T_, 1024, 512, E, TabFill<RowOut>{tab, wid_s, RowOut{(const float*)(ws + OFF_HSS)}});
    }
    xcd_barrier(xb);
    for (int rep = 0; rep < ((DUP_MASK & 32) ? 2 : 1); ++rep) {
    if (rep) xcd_barrier(xb);
    if (PH_MASK & 32) {
        LAS float* rst = (LAS float*)(lds + g8::STAGE_BYTES);
        EpiUp E{rst, (bf16_t*)(ws + OFF_HID)};
        g8::gemm_phase<1>(lds, wid_s, (const bf16_t*)(ws + OFF_H1B), 1024, (const bf16_t*)(ws + OFF_WUP), 1024, T_, 4096, 1024, E, TabFill<RowUp>{rst, wid_s, RowUp{(const float*)(ws + OFF_PH)}});
    }
    }
    xcd_barrier(xb);
    if (PH_MASK & 64) {
        EpiDown E{(const bf16_t*)(ws + OFF_H1B), (bf16_t*)(ws + OFF_MIX), (float*)(ws + OFF_PF)};
        g8::gemm_phase<1, 2>(lds, wid_s, (const bf16_t*)(ws + OFF_HID), 4096, (const bf16_t*)(ws + OFF_WDN), 4096, T_, 1024, 4096, E);
    }
    xcd_barrier(xb);
    if (PH_MASK & 128) phase_final(p, fresh_tid(wid_s));
}

extern "C" void kernel_launch(void* const* d_in, const int* in_sizes, int n_in, void* d_out, int out_size, void* d_ws, size_t ws_size, hipStream_t stream) {
    static int grid_blocks = 0;
    if (grid_blocks == 0) {
        if (n_in != 15 || in_sizes[0] != T_ * 1024 || out_size != T_ * 1024 || ws_size < WS_END) {
            fprintf(stderr, "kernel_launch: unexpected shapes (n_in %d, in0 %d, out %d, ws %zu < %zu)\n", n_in, n_in > 0 ? in_sizes[0] : -1, out_size, ws_size, (size_t)WS_END);
            grid_blocks = -1; return;
        }
        int dev = 0, cus = 0, per_cu = 0;
        hipGetDevice(&dev);
        hipDeviceGetAttribute(&cus, hipDeviceAttributeMultiprocessorCount, dev);
        if (hipFuncSetAttribute((const void*)hymba_fwd, hipFuncAttributeMaxDynamicSharedMemorySize, LDS_BYTES) != hipSuccess) fprintf(stderr, "kernel_launch: hipFuncSetAttribute failed\n");
        if (hipOccupancyMaxActiveBlocksPerMultiprocessor(&per_cu, (const void*)hymba_fwd, 512, LDS_BYTES) != hipSuccess || per_cu < 1) { fprintf(stderr, "kernel_launch: occupancy query gave %d\n", per_cu); per_cu = 1; }
        (void)hipGetLastError();
        grid_blocks = cus;
        if (grid_blocks != 256) fprintf(stderr, "kernel_launch: note: %d CUs (work maps assume 256)\n", grid_blocks);
    }
    if (grid_blocks < 0) return;
    Params p{};
    p.x = (const float*)d_in[0]; p.pos = (const int*)d_in[1]; p.g_attn = (const float*)d_in[2]; p.w_in = (const float*)d_in[3];
    p.g_qa = (const float*)d_in[4]; p.w_qb = (const float*)d_in[5]; p.g_kva = (const float*)d_in[6]; p.w_kvb = (const float*)d_in[7];
    p.g_sbo = (const float*)d_in[8]; p.g_mlao = (const float*)d_in[9]; p.w_o = (const float*)d_in[10]; p.g_mlp = (const float*)d_in[11];
    p.w_up = (const float*)d_in[12]; p.w_down = (const float*)d_in[13]; p.g_final = (const float*)d_in[14];
    p.out = (float*)d_out; p.ws = (unsigned char*)d_ws;
    (void)hipMemsetAsync((unsigned char*)d_ws + OFF_BAR, 0, XCD_BAR_WORDS * 4, stream);
    void* args[] = {&p};
    hipError_t e = hipLaunchCooperativeKernel((const void*)hymba_fwd, dim3(grid_blocks), dim3(512), args, LDS_BYTES, stream);
    if (e != hipSuccess) fprintf(stderr, "kernel_launch: cooperative launch failed: %s (grid %d)\n", hipGetErrorString(e), grid_blocks);
}
```

```cpp
#include <hip/hip_runtime.h>
#include <hip/hip_cooperative_groups.h>
#include <cstdio>
namespace cg = cooperative_groups;

#define LAS __attribute__((address_space(3)))
#define DI __device__ __forceinline__
typedef unsigned short bf16_t;
typedef short bf16x8 __attribute__((ext_vector_type(8)));
typedef float f32x2 __attribute__((ext_vector_type(2)));
typedef float f32x4 __attribute__((ext_vector_type(4)));
typedef float f32x16 __attribute__((ext_vector_type(16)));
typedef unsigned u32x4 __attribute__((ext_vector_type(4)));
typedef unsigned u32x2 __attribute__((ext_vector_type(2)));
typedef __bf16 bf2_t __attribute__((ext_vector_type(2)));

constexpr int T_ = 65536, S_ = 4096;
constexpr float EPS_ = 1e-6f;
constexpr float LOG2E = 1.4426950408889634f, LN2 = 0.6931471805599453f;
constexpr float MLA_QSCALE = 0.07216878364870322f * 1.4426950408889634f;
constexpr float SB_PTHR = 1e-37f;

constexpr size_t SZ_T = (size_t)T_;
constexpr size_t OFF_PROJ = 0;
constexpr size_t OFF_VST  = OFF_PROJ + SZ_T * 2048 * 2;
constexpr size_t OFF_QN   = OFF_VST + SZ_T * 512 * 2;
constexpr size_t OFF_QR   = OFF_QN + SZ_T * 512 * 2;
constexpr size_t OFF_KN   = OFF_QR + SZ_T * 256 * 2;
constexpr size_t OFF_VMT  = OFF_KN + SZ_T * 512 * 2;
constexpr size_t OFF_REGA_END = OFF_VMT + SZ_T * 512 * 2;
constexpr size_t OFF_HID  = 0;
constexpr size_t OFF_XB   = OFF_REGA_END;
constexpr size_t OFF_MIX  = OFF_XB + SZ_T * 1024 * 2;
constexpr size_t OFF_H1B  = OFF_MIX + SZ_T * 1024 * 2;
constexpr size_t OFF_WIN  = OFF_H1B + SZ_T * 1024 * 2;
constexpr size_t OFF_WQB  = OFF_WIN + (size_t)2048 * 1024 * 2;
constexpr size_t OFF_WKVB = OFF_WQB + (size_t)768 * 256 * 2;
constexpr size_t OFF_WO   = OFF_WKVB + (size_t)1024 * 256 * 2;
constexpr size_t OFF_WUP  = OFF_WO + (size_t)1024 * 1024 * 2;
constexpr size_t OFF_WDN  = OFF_WUP + (size_t)4096 * 1024 * 2;
constexpr size_t OFF_CS   = OFF_WDN + (size_t)4096 * 1024 * 2;
constexpr size_t OFF_RSX  = OFF_CS + SZ_T * 32 * 8;
constexpr size_t OFF_PQ   = OFF_RSX + SZ_T * 4;
constexpr size_t OFF_PKV  = OFF_PQ + SZ_T * 16;
constexpr size_t OFF_HSS  = OFF_PKV + SZ_T * 16;
constexpr size_t OFF_PH   = OFF_HSS + SZ_T * 64;
constexpr size_t OFF_PF   = OFF_PH + SZ_T * 64;
constexpr size_t OFF_BAR  = OFF_PF + SZ_T * 64;
constexpr size_t WS_END   = OFF_BAR + 16384;

struct Params {
    const float* x; const int* pos; const float* g_attn; const float* w_in; const float* g_qa; const float* w_qb;
    const float* g_kva; const float* w_kvb; const float* g_sbo; const float* g_mlao; const float* w_o; const float* g_mlp;
    const float* w_up; const float* w_down; const float* g_final;
    float* out; unsigned char* ws;
};

__device__ const float INV_FREQ[32] = {
    1.000000000e+00f, 7.498942018e-01f, 5.623413324e-01f, 4.216965139e-01f, 3.162277639e-01f, 2.371373773e-01f, 1.778279394e-01f, 1.333521456e-01f,
    1.000000015e-01f, 7.498942316e-02f, 5.623413250e-02f, 4.216964915e-02f, 3.162277490e-02f, 2.371373773e-02f, 1.778279431e-02f, 1.333521400e-02f,
    9.999999776e-03f, 7.498942316e-03f, 5.623413250e-03f, 4.216964822e-03f, 3.162277630e-03f, 2.371373819e-03f, 1.778279431e-03f, 1.333521446e-03f,
    1.000000047e-03f, 7.498941850e-04f, 5.623413017e-04f, 4.216965172e-04f, 3.162277571e-04f, 2.371373703e-04f, 1.778279402e-04f, 1.333521504e-04f};

DI unsigned pk2(float lo, float hi) { f32x2 v = {lo, hi}; bf2_t r = __builtin_convertvector(v, bf2_t); return __builtin_bit_cast(unsigned, r); }
DI u32x4 pack8(f32x4 a, f32x4 b) { u32x4 o; o.x = pk2(a.x, a.y); o.y = pk2(a.z, a.w); o.z = pk2(b.x, b.y); o.w = pk2(b.z, b.w); return o; }
DI void unpack8(u32x4 w, f32x4& a, f32x4& b) {
    a.x = __uint_as_float(w.x << 16); a.y = __uint_as_float(w.x & 0xffff0000u); a.z = __uint_as_float(w.y << 16); a.w = __uint_as_float(w.y & 0xffff0000u);
    b.x = __uint_as_float(w.z << 16); b.y = __uint_as_float(w.z & 0xffff0000u); b.z = __uint_as_float(w.w << 16); b.w = __uint_as_float(w.w & 0xffff0000u);
}
DI float sum4(f32x4 v) { return (v.x + v.y) + (v.z + v.w); }
DI float sq4(f32x4 v) { return (v.x * v.x + v.y * v.y) + (v.z * v.z + v.w * v.w); }
DI float wave_sum(float v) {
#pragma unroll
    for (int o = 1; o < 64; o <<= 1) v += __shfl_xor(v, o);
    return v;
}
DI f32x16 zero16() { f32x16 z; for (int i = 0; i < 16; ++i) z[i] = 0.f; return z; }
DI const char* uptr(const char* p) {
    const unsigned long long u = (unsigned long long)p;
    const unsigned lo = __builtin_amdgcn_readfirstlane((unsigned)u), hi = __builtin_amdgcn_readfirstlane((unsigned)(u >> 32));
    return (const char*)(((unsigned long long)hi << 32) | lo);
}
DI int fresh_tid(int wid_s) {
    int l; asm volatile("v_mbcnt_lo_u32_b32 %0, -1, 0\n\tv_mbcnt_hi_u32_b32 %0, -1, %0" : "=v"(l));
    return wid_s * 64 + l;
}
typedef unsigned u32x2p __attribute__((ext_vector_type(2)));
DI void xhalf(float x, float& lo, float& hi) { const u32x2p r = __builtin_amdgcn_permlane32_swap(__float_as_uint(x), __float_as_uint(x), false, false); lo = __uint_as_float(r.x); hi = __uint_as_float(r.y); }
DI float xhalf_max(float x) { float lo, hi; xhalf(x, lo, hi); return fmaxf(lo, hi); }
DI float xhalf_sum(float x) { float lo, hi; xhalf(x, lo, hi); return lo + hi; }
#define MFMA32(a, b, c) __builtin_amdgcn_mfma_f32_32x32x16_bf16((a), (b), (c), 0, 0, 0)

DI void p0_weight_item(const Params& p, LAS float* scr, int mid, int t, int lane) {
    const float* W; int K, N, Kpad; bf16_t* out;
    switch (mid) {
        case 0:  W = p.w_in;   K = 1024; N = 1984; Kpad = 1024; out = (bf16_t*)(p.ws + OFF_WIN); break;
        case 1:  W = p.w_qb;   K = 256;  N = 768;  Kpad = 256;  out = (bf16_t*)(p.ws + OFF_WQB); break;
        case 2:  W = p.w_kvb;  K = 128;  N = 1024; Kpad = 256;  out = (bf16_t*)(p.ws + OFF_WKVB); break;
        case 3:  W = p.w_o;    K = 1024; N = 1024; Kpad = 1024; out = (bf16_t*)(p.ws + OFF_WO); break;
        case 4:  W = p.w_up;   K = 1024; N = 4096; Kpad = 1024; out = (bf16_t*)(p.ws + OFF_WUP); break;
        default: W = p.w_down; K = 4096; N = 1024; Kpad = 4096; out = (bf16_t*)(p.ws + OFF_WDN); break;
    }
    const int nkt = Kpad / 64, k0 = (t % nkt) * 64, n0 = (t / nkt) * 32;
    const int nn = lane & 31, no = n0 + nn;
    int src = no; float sc = 1.f;
    if (mid == 0) {
        if (no < 512) sc = -0.125f * LOG2E;
        else if (no >= 1920) { if (no < 1984) { const int pp = no - 1920; src = 1920 + ((pp >> 2) & 1) * 32 + 4 * (pp >> 3) + (pp & 3); } else src = -1; }
    } else if (mid == 1) {
        sc = MLA_QSCALE;
        if (no < 512) src = (no >> 7) * 192 + (no & 127);
        else { const int q = no - 512, hd = q >> 6, pp = q & 63; src = hd * 192 + 128 + ((pp >> 2) & 1) * 32 + 4 * (pp >> 3) + (pp & 3); }
    }
#pragma unroll 8
    for (int i = 0; i < 32; ++i) {
        const int kk = 2 * i + (lane >> 5), k = k0 + kk;
        float gv = 1.f; bool ok = src >= 0;
        if (mid == 0) gv = p.g_attn[k];
        else if (mid == 1) gv = p.g_qa[k];
        else if (mid == 2) { if (k >= K) ok = false; else gv = p.g_kva[k]; }
        else if (mid == 3) gv = (k < 512) ? p.g_sbo[k] : p.g_mlao[k - 512];
        else if (mid == 4) gv = p.g_mlp[k];
        float val = 0.f;
        if (ok) val = W[(size_t)k * N + src] * gv * sc;
        scr[kk * 33 + nn] = val;
    }
    asm volatile("s_waitcnt lgkmcnt(0)" ::: "memory");
    {
        const int c = lane & 7;
#pragma unroll
        for (int j = 0; j < 4; ++j) {
            const int n = (lane >> 3) + 8 * j; const LAS float* sp = scr + (8 * c) * 33 + n;
            u32x4 o; o.x = pk2(sp[0], sp[33]); o.y = pk2(sp[2 * 33], sp[3 * 33]); o.z = pk2(sp[4 * 33], sp[5 * 33]); o.w = pk2(sp[6 * 33], sp[7 * 33]);
            *(u32x4*)(out + (size_t)(n0 + n) * Kpad + k0 + 8 * c) = o;
        }
    }
    asm volatile("s_waitcnt lgkmcnt(0)" ::: "memory");
}

DI void phase0(const Params& p, LAS unsigned char* lds, int tid) {
    const int G = gridDim.x, blk = blockIdx.x;
    const int wid = tid >> 6, lane = tid & 63;
    {
        LAS float* scr = (LAS float*)(lds + wid * 8448);
        constexpr int C0 = 1024, C1 = C0 + 96, C2 = C1 + 128, C3 = C2 + 512, C4 = C3 + 2048, C5 = C4 + 2048;
        for (int it = blk * 8 + wid; it < C5; it += G * 8) {
            if (it < C0) p0_weight_item(p, scr, 0, it, lane);
            else if (it < C1) p0_weight_item(p, scr, 1, it - C0, lane);
            else if (it < C2) p0_weight_item(p, scr, 2, it - C1, lane);
            else if (it < C3) p0_weight_item(p, scr, 3, it - C2, lane);
            else if (it < C4) p0_weight_item(p, scr, 4, it - C3, lane);
            else p0_weight_item(p, scr, 5, it - C4, lane);
        }
    }
    float* rsx = (float*)(p.ws + OFF_RSX);
    bf16_t* xb = (bf16_t*)(p.ws + OFF_XB);
    f32x2* cs = (f32x2*)(p.ws + OFF_CS);
    int cidx = blk * 512 + tid;
    int posv = p.pos[cidx >> 5];
    for (int row = blk * 8 + wid; row < T_; row += G * 8) {
        const f32x4* xr = (const f32x4*)(p.x + (size_t)row * 1024) + lane;
        f32x4 v[4]; float s = 0.f;
#pragma unroll
        for (int j = 0; j < 4; ++j) v[j] = __builtin_nontemporal_load(xr + 64 * j);
        f32x2 cv; const bool docs = cidx < T_ * 32;
        if (docs) {
            const int i = cidx & 31;
            const float ang = (float)posv * INV_FREQ[i];
            const double rev = (double)ang * 0.15915494309189535;
            const float fr = (float)(rev - __builtin_rint(rev));
            cv.x = __builtin_amdgcn_cosf(fr); cv.y = __builtin_amdgcn_sinf(fr);
        }
#pragma unroll
        for (int j = 0; j < 4; ++j) s += sq4(v[j]);
        s = wave_sum(s);
        if (lane == 0) rsx[row] = rsqrtf(s * (1.f / 1024.f) + EPS_);
        u32x2* o = (u32x2*)(xb + (size_t)row * 1024) + lane;
#pragma unroll
        for (int j = 0; j < 4; ++j) { u32x2 w; w.x = pk2(v[j].x, v[j].y); w.y = pk2(v[j].z, v[j].w); o[64 * j] = w; }
        if (docs) { cs[cidx] = cv; cidx += G * 512; if (cidx < T_ * 32) posv = p.pos[cidx >> 5]; }
    }
    for (; cidx < T_ * 32; cidx += G * 512) {
        const int t = cidx >> 5, i = cidx & 31;
        const float ang = (float)p.pos[t] * INV_FREQ[i];
        const double rev = (double)ang * 0.15915494309189535;
        const float fr = (float)(rev - __builtin_rint(rev));
        f32x2 v; v.x = __builtin_amdgcn_cosf(fr); v.y = __builtin_amdgcn_sinf(fr);
        cs[cidx] = v;
    }
}

namespace g8 {
constexpr int BM = 256, BK = 64, HALF = 128, HTB = HALF * BK * 2, STAGE_BYTES = 8 * HTB, NXCD = 8, WGM = 8;
DI int lds_byte(int r, int c) { const int st = (r >> 4) * 2 + (c >> 5), rr = r & 15, cc = c & 31, ob = rr * 64 + cc * 2; return st * 1024 + (ob ^ (((ob >> 9) & 1) << 5)); }
DI void stage_rc(int b, int& R, int& C) { const int st = b / 1024, sb = b % 1024, swz = sb ^ (((sb >> 9) & 1) << 5); R = (st >> 1) * 16 + swz / 64; C = (st & 1) * 32 + (swz % 64) / 2; }
DI int perm32(int rho) { const int n = rho >> 4, i = rho & 15; return 8 * (i >> 2) + 4 * n + (i & 3); }
struct Unit { int pm, pn, kh; };

template <int NKH, int ROT = 0>
DI bool next_unit(int i, int nM, int nN, Unit& u) {
    int ti = i / NKH; u.kh = i % NKH;
    const int nwg = nM * nN;
    if ((long)ti * gridDim.x + blockIdx.x >= nwg) return false;
    if (ROT == 2) ti = (nwg + (int)gridDim.x - 1) / (int)gridDim.x - 1 - ti;
    const long L = (long)ti * gridDim.x + blockIdx.x; if (L >= nwg) return false;
    int wgid = (int)L; { const int q = nwg / NXCD, r = nwg % NXCD, xcd = wgid % NXCD, off = wgid / NXCD; wgid = (xcd < r ? xcd * (q + 1) : r * (q + 1) + (xcd - r) * q) + off; }
    const int nig = WGM * nN, gid = wgid / nig, fm = gid * WGM, gsz = (nM - fm) < WGM ? (nM - fm) : WGM;
    u.pm = fm + ((wgid % nig) % gsz); u.pn = (wgid % nig) / gsz;
    if (ROT == 1) u.pn = (u.pn & 4) | ((u.pn + (ti >> 1)) & 3);
    return true;
}

struct NoPre { DI void operator()() const {} };
template <int NKH, int ROT = 0, class Epi, class Pre = NoPre>
DI void gemm_phase(LAS unsigned char* lds, int wid_s, const bf16_t* A, int lda, const bf16_t* Bt, int ldb, int M, int N, int Kc, const Epi& E, const Pre& pre = Pre()) {
    const int tid = fresh_tid(wid_s);
    const int wid = __builtin_amdgcn_readfirstlane(tid >> 6), lane = tid & 63, wr = wid >> 2, wc = wid & 3, fr = lane & 15, fq = lane >> 4;
    const int nt = Kc / BK, nM = M / BM, nN = N / BM;
    unsigned voffA[2], voffB[2];
#pragma unroll
    for (int i = 0; i < 2; ++i) { int R, C; stage_rc(tid * 16 + i * 8192, R, C); const int Rb = (R & ~31) + perm32(R & 31);
        voffA[i] = (unsigned)(R * lda + C) * 2u; voffB[i] = (unsigned)(Rb * ldb + C) * 2u; }
    const size_t kstep = (size_t)(BK * 2);
    const size_t hstepA = (size_t)HALF * lda * 2, hstepB = (size_t)HALF * ldb * 2;
    const size_t tstepA = 2 * hstepA, tstepB = 2 * hstepB, kchunk = (size_t)Kc * 2;
    const unsigned ldsw = (unsigned)wid * 1024u;
    const int aoff = lds_byte(wr * 64 + fr, fq * 8), boff = lds_byte(wc * 32 + fr, fq * 8);
#define G8_SA(b, h) (((b) * 2 + (h)) * HTB)
#define G8_SB(b, h) ((4 + (b) * 2 + (h)) * HTB)
#define G8_STAGE(bufoff, gbase, voff) do { const char* _gb = uptr((const char*)(gbase)); _Pragma("unroll") for (int _i = 0; _i < 2; ++_i) \
        __builtin_amdgcn_global_load_lds((const unsigned*)(_gb + (voff)[_i]), (LAS unsigned*)(lds + (bufoff) + ldsw + _i * 8192), 16, 0, 0); } while (0)
#define G8_LDA(dst, b, h) do { _Pragma("unroll") for (int m = 0; m < 4; ++m) _Pragma("unroll") for (int k = 0; k < 2; ++k) dst[m][k] = *(const LAS bf16x8*)(lds + G8_SA(b, h) + aoff + m * 2048 + k * 1024); } while (0)
#define G8_LDB(dst, b, h) do { _Pragma("unroll") for (int n = 0; n < 2; ++n) _Pragma("unroll") for (int k = 0; k < 2; ++k) dst[n][k] = *(const LAS bf16x8*)(lds + G8_SB(b, h) + boff + n * 2048 + k * 1024); } while (0)
#define G8_MMA(ai, bj, At, Bt_) do { __builtin_amdgcn_s_setprio(1); _Pragma("unroll") for (int m = 0; m < 4; ++m) _Pragma("unroll") for (int n = 0; n < 2; ++n) _Pragma("unroll") for (int k = 0; k < 2; ++k) \
        acc[ai][bj][m][n] = __builtin_amdgcn_mfma_f32_16x16x32_bf16(Bt_[n][k], At[m][k], acc[ai][bj][m][n], 0, 0, 0); __builtin_amdgcn_s_setprio(0); } while (0)
#define G8_WAIT_V(n) asm volatile("s_waitcnt vmcnt(" #n ")" ::: "memory")
#define G8_WAIT_L(n) asm volatile("s_waitcnt lgkmcnt(" #n ")" ::: "memory")
#define G8_BAR __builtin_amdgcn_s_barrier()
#define G8_SCHED __builtin_amdgcn_sched_barrier(0)
    Unit cur, nxt; int ui = 0;
    if (!next_unit<NKH, ROT>(0, nM, nN, cur)) return;
    f32x4 acc[2][2][4][2];
#pragma unroll
    for (int a = 0; a < 2; ++a)
#pragma unroll
        for (int b = 0; b < 2; ++b)
#pragma unroll
            for (int m = 0; m < 4; ++m)
#pragma unroll
                for (int n = 0; n < 2; ++n) acc[a][b][m][n] = (f32x4){0.f, 0.f, 0.f, 0.f};
    bf16x8 At[4][2], B0[2][2], B1[2][2];
    const char* cA = uptr((const char*)A + (size_t)cur.pm * tstepA + (size_t)cur.kh * kchunk + E.a_off(cur.pn));
    const char* cB = uptr((const char*)Bt + (size_t)cur.pn * tstepB + (size_t)cur.kh * kchunk);
    G8_STAGE(G8_SB(0, 0), cB, voffB); G8_STAGE(G8_SA(0, 0), cA, voffA); G8_STAGE(G8_SB(0, 1), cB + hstepB, voffB); G8_STAGE(G8_SA(0, 1), cA + hstepA, voffA);
    pre();
    if (wr == 1) G8_BAR;
    G8_WAIT_V(4); G8_BAR;
    G8_STAGE(G8_SB(1, 0), cB + kstep, voffB); G8_STAGE(G8_SA(1, 0), cA + kstep, voffA); G8_STAGE(G8_SB(1, 1), cB + hstepB + kstep, voffB);
    G8_WAIT_V(6); G8_BAR;
    for (;;) {
        const bool has_next = next_unit<NKH, ROT>(ui + 1, nM, nN, nxt);
        const char* nA = uptr(has_next ? (const char*)A + (size_t)nxt.pm * tstepA + (size_t)nxt.kh * kchunk + E.a_off(nxt.pn) : cA);
        const char* nB = uptr(has_next ? (const char*)Bt + (size_t)nxt.pn * tstepB + (size_t)nxt.kh * kchunk : cB);
        for (int t = 0; t < nt; t += 2) {
            const bool last = (t == nt - 2);
            const char* a1 = cA + (size_t)(t + 1) * kstep;
            const char* a2 = last ? nA : cA + (size_t)(t + 2) * kstep; const char* b2 = last ? nB : cB + (size_t)(t + 2) * kstep;
            const char* a3 = a2 + kstep; const char* b3 = b2 + kstep;
            G8_LDB(B0, 0, 0); G8_SCHED; G8_LDA(At, 0, 0); G8_STAGE(G8_SA(1, 1), a1 + hstepA, voffA);
            G8_WAIT_L(8); G8_BAR; G8_WAIT_L(0); G8_MMA(0, 0, At, B0); G8_BAR; G8_SCHED;
            G8_LDB(B1, 0, 1); G8_STAGE(G8_SB(0, 0), b2, voffB);
            G8_BAR; G8_WAIT_L(0); G8_MMA(0, 1, At, B1); G8_BAR;
            G8_LDA(At, 0, 1); G8_STAGE(G8_SA(0, 0), a2, voffA);
            G8_BAR; G8_WAIT_L(0); G8_MMA(1, 0, At, B0); G8_BAR; G8_SCHED;
            G8_STAGE(G8_SB(0, 1), b2 + hstepB, voffB);
            G8_WAIT_V(6); G8_BAR; G8_MMA(1, 1, At, B1); G8_BAR;
            G8_LDB(B0, 1, 0); G8_SCHED; G8_LDA(At, 1, 0); G8_STAGE(G8_SA(0, 1), a2 + hstepA, voffA);
            G8_WAIT_L(8); G8_BAR; G8_WAIT_L(0); G8_MMA(0, 0, At, B0); G8_BAR; G8_SCHED;
            G8_LDB(B1, 1, 1); G8_STAGE(G8_SB(1, 0), b3, voffB);
            G8_BAR; G8_WAIT_L(0); G8_MMA(0, 1, At, B1); G8_BAR;
            G8_LDA(At, 1, 1); G8_STAGE(G8_SA(1, 0), a3, voffA);
            G8_BAR; G8_WAIT_L(0); G8_MMA(1, 0, At, B0); G8_BAR; G8_SCHED;
            G8_STAGE(G8_SB(1, 1), b3 + hstepB, voffB);
            G8_WAIT_V(6); G8_BAR; G8_MMA(1, 1, At, B1); G8_BAR;
        }
        { int l2 = lane; asm volatile("" : "+v"(l2)); E(acc, cur, wr, wc, l2 & 15, l2 >> 4); }
        if (!has_next) break;
        if (cur.kh == NKH - 1) {
#pragma unroll
            for (int a = 0; a < 2; ++a)
#pragma unroll
                for (int b = 0; b < 2; ++b)
#pragma unroll
                    for (int m = 0; m < 4; ++m)
#pragma unroll
                        for (int n = 0; n < 2; ++n) acc[a][b][m][n] = (f32x4){0.f, 0.f, 0.f, 0.f};
        }
        cur = nxt; cA = nA; cB = nB; ++ui;
    }
    G8_WAIT_V(0);
    if (wr == 0) G8_BAR;
    G8_BAR;
#undef G8_SA
#undef G8_SB
#undef G8_STAGE
#undef G8_LDA
#undef G8_LDB
#undef G8_MMA
#undef G8_WAIT_V
#undef G8_WAIT_L
#undef G8_BAR
#undef G8_SCHED
}
}
using g8::Unit;
typedef f32x4 AccT[2][2][4][2];

DI void rope8(f32x4& v0, f32x4& v1, const f32x4 ca, const f32x4 cb) {
    f32x4 o1, o2;
    o1.x = v0.x * ca.x - v1.x * ca.y; o2.x = v1.x * ca.x + v0.x * ca.y;
    o1.y = v0.y * ca.z - v1.y * ca.w; o2.y = v1.y * ca.z + v0.y * ca.w;
    o1.z = v0.z * cb.x - v1.z * cb.y; o2.z = v1.z * cb.x + v0.z * cb.y;
    o1.w = v0.w * cb.z - v1.w * cb.w; o2.w = v1.w * cb.z + v0.w * cb.w;
    v0 = o1; v1 = o2;
}
DI void store_tr8(bf16_t* base, f32x4 v0, f32x4 v1) {
    base[0 * S_] = (bf16_t)pk2(v0.x, 0.f); base[1 * S_] = (bf16_t)pk2(v0.y, 0.f); base[2 * S_] = (bf16_t)pk2(v0.z, 0.f); base[3 * S_] = (bf16_t)pk2(v0.w, 0.f);
    base[4 * S_] = (bf16_t)pk2(v1.x, 0.f); base[5 * S_] = (bf16_t)pk2(v1.y, 0.f); base[6 * S_] = (bf16_t)pk2(v1.z, 0.f); base[7 * S_] = (bf16_t)pk2(v1.w, 0.f);
}

template <class F>
DI void fill_row_tables(LAS float* tab, int wid_s, const F& f) {
    const int t2 = fresh_tid(wid_s), bx = blockIdx.x & 7, bj8 = (blockIdx.x >> 3) & 7;
    for (int idx = t2; idx < 1024; idx += 512) {
        const int row = (8 * (4 * bx + (idx >> 8)) + bj8) * 256 + (idx & 255);
        const f32x2 v = f(row); tab[idx] = v.x; tab[1024 + idx] = v.y;
    }
    __syncthreads();
}
template <class F> struct TabFill {
    LAS float* tab; int wid_s; F f;
    DI void operator()() const {
        const int t2 = fresh_tid(wid_s), bx = blockIdx.x & 7, bj8 = (blockIdx.x >> 3) & 7;
        for (int idx = t2; idx < 1024; idx += 512) {
            const int row = (8 * (4 * bx + (idx >> 8)) + bj8) * 256 + (idx & 255);
            const f32x2 v = f(row); tab[idx] = v.x; tab[1024 + idx] = v.y;
        }
    }
};
struct RowRsx { const float* rsx; DI f32x2 operator()(int row) const { f32x2 v; v.x = rsx[row]; v.y = 0.f; return v; } };
struct RowQKV { const float* pq; const float* pkv; DI f32x2 operator()(int row) const { f32x2 v;
    v.x = rsqrtf(sum4(*(const f32x4*)(pq + (size_t)row * 4)) * (1.f / 256.f) + EPS_); v.y = rsqrtf(sum4(*(const f32x4*)(pkv + (size_t)row * 4)) * (1.f / 128.f) + EPS_); return v; } };
struct RowOut { const float* hss; DI f32x2 operator()(int row) const { const float* hp = hss + (size_t)row * 16; f32x2 v;
    const float rml = rsqrtf(sum4(*(const f32x4*)(hp + 8)) * (1.f / 512.f) + EPS_), rsb = rsqrtf((sum4(*(const f32x4*)hp) + sum4(*(const f32x4*)(hp + 4))) * (1.f / 512.f) + EPS_);
    v.x = rsb / rml; v.y = rml; return v; } };
struct RowUp { const float* ph; DI f32x2 operator()(int row) const { const f32x4* pp = (const f32x4*)(ph + (size_t)row * 16); f32x2 v;
    v.x = rsqrtf(((sum4(pp[0]) + sum4(pp[1])) + (sum4(pp[2]) + sum4(pp[3]))) * (1.f / 1024.f) + EPS_); v.y = 0.f; return v; } };
#define EPI_TAB(tab, which, i) ((tab)[(which) * 1024 + ((u.pm >> 3) & 3) * 256 + wr * 64 + fr + ((i) >> 2) * 128 + ((i) & 3) * 16])
#define EPI_ROW(ai, m) (u.pm * 256 + (ai) * 128 + wr * 64 + (m) * 16 + fr)
struct EpiProj {
    DI int a_off(int) const { return 0; }
    const LAS float* tab; const float* cs; bf16_t* proj; bf16_t* vst; float* pq; float* pkv;
    DI void operator()(AccT& acc, const Unit& u, int wr, int wc, int fr, int fq) const {
        const int pn = u.pn;
        float rsv[8];
#pragma unroll
        for (int i = 0; i < 8; ++i) rsv[i] = EPI_TAB(tab, 0, i);
        const bool do_rope = (pn == 7 && wc < 2);
        f32x4 rca[8], rcb[8];
        if (do_rope) {
#pragma unroll
            for (int i = 0; i < 8; ++i) { const float* cr = cs + (size_t)EPI_ROW(i >> 2, i & 3) * 64 + 2 * (16 * wc + 4 * fq); rca[i] = *(const f32x4*)cr; rcb[i] = *(const f32x4*)(cr + 4); }
        }
#pragma unroll
        for (int ai = 0; ai < 2; ++ai)
#pragma unroll
            for (int m = 0; m < 4; ++m) {
                const int row = EPI_ROW(ai, m);
                const float rs = rsv[ai * 4 + m]; float ss = 0.f;
#pragma unroll
                for (int bj = 0; bj < 2; ++bj) {
                    f32x4 v0 = acc[ai][bj][m][0] * rs, v1 = acc[ai][bj][m][1] * rs;
                    const int cl = bj * 128 + wc * 32 + fq * 8;
                    if (do_rope && bj == 1) rope8(v0, v1, rca[ai * 4 + m], rcb[ai * 4 + m]);
                    if (pn == 6 || (pn == 7 && bj == 0)) ss += sq4(v0) + sq4(v1);
                    if (pn == 4 || pn == 5) {
                        const int dg = (pn - 4) * 256 + cl, hd = dg >> 6, d = dg & 63, b = row >> 12, s = row & 4095;
                        store_tr8(vst + ((size_t)(b * 8 + hd) * 64 + d) * S_ + s, v0, v1);
                    } else {
                        *(u32x4*)(proj + (size_t)row * 2048 + pn * 256 + cl) = pack8(v0, v1);
                    }
                }
                if (pn >= 6) { ss += __shfl_xor(ss, 16); ss = xhalf_sum(ss); if (fq == 0) (pn == 6 ? pq : pkv)[(size_t)row * 4 + wc] = ss; }
            }
    }
};
struct EpiQKV {
    const LAS float* tab; const float* cs; bf16_t* qn; bf16_t* qr; bf16_t* kn; bf16_t* vmt;
    DI int a_off(int pn) const { return pn >= 3 ? 512 : 0; }
    DI void operator()(AccT& acc, const Unit& u, int wr, int wc, int fr, int fq) const {
        const int pn = u.pn;
        const int wh = pn < 3 ? 0 : 1;
        float rsv[8];
#pragma unroll
        for (int i = 0; i < 8; ++i) rsv[i] = EPI_TAB(tab, wh, i);
        f32x4 rca[8], rcb[8];
        if (pn == 2) {
#pragma unroll
            for (int i = 0; i < 8; ++i) { const float* cr = cs + (size_t)EPI_ROW(i >> 2, i & 3) * 64 + 2 * (4 * ((((wc & 1) * 32 + fq * 8)) >> 3)); rca[i] = *(const f32x4*)cr; rcb[i] = *(const f32x4*)(cr + 4); }
        }
#pragma unroll
        for (int ai = 0; ai < 2; ++ai)
#pragma unroll
            for (int m = 0; m < 4; ++m) {
                const int row = EPI_ROW(ai, m);
                const float rs = rsv[ai * 4 + m];
                if (pn < 3) {
#pragma unroll
                    for (int bj = 0; bj < 2; ++bj) {
                        f32x4 v0 = acc[ai][bj][m][0] * rs, v1 = acc[ai][bj][m][1] * rs;
                        const int cl = bj * 128 + wc * 32 + fq * 8;
                        if (pn < 2) *(u32x4*)(qn + (size_t)row * 512 + pn * 256 + cl) = pack8(v0, v1);
                        else { rope8(v0, v1, rca[ai * 4 + m], rcb[ai * 4 + m]); *(u32x4*)(qr + (size_t)row * 256 + cl) = pack8(v0, v1); }
                    }
                } else {
                    const int hd = pn - 3;
                    const int cl = wc * 32 + fq * 8, b = row >> 12, s = row & 4095;
                    { f32x4 v0 = acc[ai][0][m][0] * rs, v1 = acc[ai][0][m][1] * rs; *(u32x4*)(kn + (size_t)row * 512 + hd * 128 + cl) = pack8(v0, v1); }
                    { f32x4 v0 = acc[ai][1][m][0] * rs, v1 = acc[ai][1][m][1] * rs; store_tr8(vmt + ((size_t)(b * 4 + hd) * 128 + cl) * S_ + s, v0, v1); }
                }
            }
    }
};
struct EpiOut {
    DI int a_off(int) const { return 0; }
    const LAS float* tab; const bf16_t* xb; bf16_t* h1b; float* ph;
    DI void operator()(AccT& acc, const Unit& u, int wr, int wc, int fr, int fq) const {
        float rsv[8];
        const int wh = u.kh == 0 ? 0 : 1;
#pragma unroll
        for (int i = 0; i < 8; ++i) rsv[i] = EPI_TAB(tab, wh, i);
        if (u.kh == 0) {
#pragma unroll
            for (int ai = 0; ai < 2; ++ai)
#pragma unroll
                for (int m = 0; m < 4; ++m)
#pragma unroll
                    for (int bj = 0; bj < 2; ++bj) { acc[ai][bj][m][0] *= rsv[ai * 4 + m]; acc[ai][bj][m][1] *= rsv[ai * 4 + m]; }
            return;
        }
        u32x4 res[8][2];
#pragma unroll
        for (int i = 0; i < 8; ++i)
#pragma unroll
            for (int bj = 0; bj < 2; ++bj) res[i][bj] = *(const u32x4*)(xb + (size_t)EPI_ROW(i >> 2, i & 3) * 1024 + u.pn * 256 + bj * 128 + wc * 32 + fq * 8);
#pragma unroll
        for (int ai = 0; ai < 2; ++ai)
#pragma unroll
            for (int m = 0; m < 4; ++m) {
                const int row = EPI_ROW(ai, m);
                const float rml = rsv[ai * 4 + m];
                float ss = 0.f;
#pragma unroll
                for (int bj = 0; bj < 2; ++bj) {
                    const size_t off = (size_t)row * 1024 + u.pn * 256 + bj * 128 + wc * 32 + fq * 8;
                    f32x4 r0, r1; unpack8(res[ai * 4 + m][bj], r0, r1);
                    const f32x4 v0 = acc[ai][bj][m][0] * rml + r0, v1 = acc[ai][bj][m][1] * rml + r1;
                    *(u32x4*)(h1b + off) = pack8(v0, v1);
                    ss += sq4(v0) + sq4(v1);
                }
                ss += __shfl_xor(ss, 16); ss = xhalf_sum(ss);
                if (fq == 0) ph[(size_t)row * 16 + u.pn * 4 + wc] = ss;
            }
    }
};
struct EpiUp {
    DI int a_off(int) const { return 0; }
    bf16_t* hid;
    DI void operator()(AccT& acc, const Unit& u, int wr, int wc, int fr, int fq) const {
#pragma unroll
        for (int ai = 0; ai < 2; ++ai)
#pragma unroll
            for (int m = 0; m < 4; ++m) {
                const int row = EPI_ROW(ai, m);
#pragma unroll
                for (int bj = 0; bj < 2; ++bj) {
                    f32x4 v0, v1;
#pragma unroll
                    for (int e = 0; e < 4; ++e) { const float a = fmaxf(acc[ai][bj][m][0][e], 0.f), b = fmaxf(acc[ai][bj][m][1][e], 0.f); v0[e] = a * a; v1[e] = b * b; }
                    *(u32x4*)(hid + (size_t)row * 4096 + u.pn * 256 + bj * 128 + wc * 32 + fq * 8) = pack8(v0, v1);
                }
            }
    }
};
struct EpiDown {
    DI int a_off(int) const { return 0; }
    const LAS float* tab; const bf16_t* h1b; bf16_t* h2b; float* pf;
    DI void operator()(AccT& acc, const Unit& u, int wr, int wc, int fr, int fq) const {
        float rsv[8];
#pragma unroll
        for (int i = 0; i < 8; ++i) { const float t = EPI_TAB(tab, 0, i); rsv[i] = t * t; }
        u32x4 res[8][2];
#pragma unroll
        for (int i = 0; i < 8; ++i)
#pragma unroll
            for (int bj = 0; bj < 2; ++bj) res[i][bj] = *(const u32x4*)(h1b + (size_t)EPI_ROW(i >> 2, i & 3) * 1024 + u.pn * 256 + bj * 128 + wc * 32 + fq * 8);
#pragma unroll
        for (int ai = 0; ai < 2; ++ai)
#pragma unroll
            for (int m = 0; m < 4; ++m) {
                const int row = EPI_ROW(ai, m);
                float ss = 0.f;
#pragma unroll
                for (int bj = 0; bj < 2; ++bj) {
                    const size_t off = (size_t)row * 1024 + u.pn * 256 + bj * 128 + wc * 32 + fq * 8;
                    f32x4 r0, r1; unpack8(res[ai * 4 + m][bj], r0, r1);
                    const f32x4 v0 = acc[ai][bj][m][0] * rsv[ai * 4 + m] + r0, v1 = acc[ai][bj][m][1] * rsv[ai * 4 + m] + r1;
                    *(u32x4*)(h2b + off) = pack8(v0, v1);
                    ss += sq4(v0) + sq4(v1);
                }
                ss += __shfl_xor(ss, 16); ss = xhalf_sum(ss);
                if (fq == 0) pf[(size_t)row * 16 + u.pn * 4 + wc] = ss;
            }
    }
};

constexpr int MLA_KROW = 400, MLA_VROW = 144, MLA_KBYTES = 64 * MLA_KROW, MLA_BUF = MLA_KBYTES + 128 * MLA_VROW;

DI void mla_s_softmax(const LAS unsigned char* base, int r, int h, bool is_diag, int lim, const bf16x8 (&qf)[12], f32x16 (&o)[4], float& m_run, float& l_run,
                      bf16x8 (&pf0)[2], bf16x8 (&pf1)[2]) {
    f32x16 s0 = zero16(), s1 = zero16();
    const LAS unsigned char* kp = base + r * MLA_KROW + h * 16;
#pragma unroll
    for (int g = 0; g < 3; ++g) {
        bf16x8 fa[4], fb[4];
#pragma unroll
        for (int j = 0; j < 4; ++j) { fa[j] = *(const LAS bf16x8*)(kp + (4 * g + j) * 32); fb[j] = *(const LAS bf16x8*)(kp + 32 * MLA_KROW + (4 * g + j) * 32); }
        __builtin_amdgcn_sched_barrier(0);
#pragma unroll
        for (int j = 0; j < 4; ++j) { s0 = MFMA32(fa[j], qf[4 * g + j], s0); s1 = MFMA32(fb[j], qf[4 * g + j], s1); }
        __builtin_amdgcn_sched_barrier(0);
    }
    if (is_diag) {
#pragma unroll
        for (int i = 0; i < 16; ++i) { if (16 * h + i > lim) s0[i] = -1e30f; if (32 + 16 * h + i > lim) s1[i] = -1e30f; }
    }
    float mx = fmaxf(s0[0], s1[0]);
#pragma unroll
    for (int i = 1; i < 16; ++i) mx = fmaxf(mx, fmaxf(s0[i], s1[i]));
    mx = xhalf_max(mx);
    const float mnew = fmaxf(m_run, mx);
    if (__builtin_amdgcn_ballot_w64(mnew > m_run + 8.0f) != 0ull) {
        const float alpha = __builtin_amdgcn_exp2f(m_run - mnew);
        l_run *= alpha;
#pragma unroll
        for (int dt = 0; dt < 4; ++dt) o[dt] *= alpha;
        m_run = mnew;
    }
    float ls = 0.f;
#pragma unroll
    for (int i = 0; i < 16; ++i) { s0[i] = __builtin_amdgcn_exp2f(s0[i] - m_run); s1[i] = __builtin_amdgcn_exp2f(s1[i] - m_run); ls += s0[i] + s1[i]; }
    l_run += ls;
#pragma unroll
    for (int s = 0; s < 2; ++s) {
        u32x4 a, c;
        a.x = pk2(s0[8 * s + 0], s0[8 * s + 1]); a.y = pk2(s0[8 * s + 2], s0[8 * s + 3]); a.z = pk2(s0[8 * s + 4], s0[8 * s + 5]); a.w = pk2(s0[8 * s + 6], s0[8 * s + 7]);
        c.x = pk2(s1[8 * s + 0], s1[8 * s + 1]); c.y = pk2(s1[8 * s + 2], s1[8 * s + 3]); c.z = pk2(s1[8 * s + 4], s1[8 * s + 5]); c.w = pk2(s1[8 * s + 6], s1[8 * s + 7]);
        pf0[s] = __builtin_bit_cast(bf16x8, a); pf1[s] = __builtin_bit_cast(bf16x8, c);
    }
}
DI void mla_pv(const LAS unsigned char* base, int r, int h, const bf16x8 (&pf0)[2], const bf16x8 (&pf1)[2], f32x16 (&o)[4]) {
    const LAS unsigned char* vp = base + MLA_KBYTES + r * MLA_VROW + h * 32;
#pragma unroll
    for (int s = 0; s < 2; ++s) {
        bf16x8 va[4], vb[4];
#pragma unroll
        for (int dt = 0; dt < 4; ++dt) { va[dt] = *(const LAS bf16x8*)(vp + dt * 32 * MLA_VROW + s * 16); vb[dt] = *(const LAS bf16x8*)(vp + dt * 32 * MLA_VROW + 64 + s * 16); }
        __builtin_amdgcn_sched_barrier(0);
#pragma unroll
        for (int dt = 0; dt < 4; ++dt) o[dt] = MFMA32(va[dt], pf0[s], o[dt]);
#pragma unroll
        for (int dt = 0; dt < 4; ++dt) o[dt] = MFMA32(vb[dt], pf1[s], o[dt]);
        __builtin_amdgcn_sched_barrier(0);
    }
}

DI void mla_block(const Params& p, LAS unsigned char* lds, int b, int hd, int qb, int tid) {
    asm volatile("" : "+v"(tid));
    const int wu = __builtin_amdgcn_readfirstlane(tid >> 6), lane = tid & 63, r = lane & 31, h = lane >> 5;
    const int q0 = qb * 256 + wu * 32;
    const bf16_t* QN = (const bf16_t*)(p.ws + OFF_QN); const bf16_t* QR = (const bf16_t*)(p.ws + OFF_QR);
    const size_t tok0 = (size_t)b * S_;
    bf16x8 qf[12];
    {
        const size_t qrow = tok0 + q0 + r;
#pragma unroll
        for (int ks = 0; ks < 8; ++ks) qf[ks] = *(const bf16x8*)(QN + qrow * 512 + hd * 128 + ks * 16 + h * 8);
#pragma unroll
        for (int ks = 0; ks < 4; ++ks) qf[8 + ks] = *(const bf16x8*)(QR + qrow * 256 + hd * 64 + ks * 16 + h * 8);
    }
    unsigned goff[6];
#pragma unroll
    for (int j = 0; j < 6; ++j) {
        const int pc = wu + 8 * j; goff[j] = 0;
        if (pc < 25) {
            const int c = pc * 64 + lane, lr = c / 25; int cc = c - lr * 25; if (cc == 24) cc = 0;
            const int k32 = lr & 31, key = (lr & 32) + 16 * ((k32 >> 2) & 1) + (k32 & 3) + 4 * (k32 >> 3);
            const unsigned tok = (unsigned)(b * S_ + key);
            goff[j] = (cc < 16) ? (unsigned)OFF_KN + (tok * 512u + hd * 128 + cc * 8) * 2u : (unsigned)OFF_PROJ + (tok * 2048u + 1920 + (cc - 16) * 8) * 2u;
        } else if (pc < 43) {
            const int c = (pc - 25) * 64 + lane, d = c / 9; int cc = c - d * 9; if (cc == 8) cc = 0;
            goff[j] = (unsigned)OFF_VMT + ((unsigned)((b * 4 + hd) * 128 + d) * (unsigned)S_ + cc * 8) * 2u;
        }
    }
    const char* wsb = uptr((const char*)p.ws);
#define MLA_STAGE(KT, BUF) do { _Pragma("unroll") for (int _j = 0; _j < 6; ++_j) { const int _pc = wu + 8 * _j; if (_pc < 43) { \
        const unsigned _inc = goff[_j] >= (unsigned)OFF_VMT ? 128u : (goff[_j] < (unsigned)OFF_VST ? 262144u : 65536u); \
        __builtin_amdgcn_global_load_lds((const unsigned*)(wsb + (goff[_j] + (unsigned)(KT) * _inc)), (LAS unsigned*)(lds + (BUF) * MLA_BUF + _pc * 1024), 16, 0, 0); } } } while (0)
    f32x16 o[4]; for (int dt = 0; dt < 4; ++dt) o[dt] = zero16();
    float m_run = -1e30f, l_run = 0.f;
    const int ntiles = 4 * qb + 4, wlast = q0 >> 6;
    __syncthreads();
    MLA_STAGE(0, 0);
    const bool late = wu >= 4;
    bf16x8 pf0[2], pf1[2];
    int bcur = 0;
    for (int kt = 0; kt < ntiles; ++kt) {
        asm volatile("s_waitcnt vmcnt(0)" ::: "memory");
        __builtin_amdgcn_s_barrier();
        asm volatile("" ::: "memory");
        const int bprev = bcur == 0 ? 2 : bcur - 1, bnext = bcur == 2 ? 0 : bcur + 1;
        if (kt + 1 < ntiles) MLA_STAGE(kt + 1, bnext);
        if (late && kt >= 1 && kt - 1 <= wlast) mla_pv(lds + bprev * MLA_BUF, r, h, pf0, pf1, o);
        if (kt <= wlast) {
            mla_s_softmax(lds + bcur * MLA_BUF, r, h, kt == wlast, q0 + r - kt * 64, qf, o, m_run, l_run, pf0, pf1);
            if (!late) mla_pv(lds + bcur * MLA_BUF, r, h, pf0, pf1, o);
        }
        bcur = bnext;
    }
    if (late && wlast == ntiles - 1) { const int bprev = bcur == 0 ? 2 : bcur - 1; mla_pv(lds + bprev * MLA_BUF, r, h, pf0, pf1, o); }
#undef MLA_STAGE
    const float lt = xhalf_sum(l_run), inv = 1.f / lt;
    bf16_t* mix = (bf16_t*)(p.ws + OFF_MIX) + (tok0 + q0 + r) * 1024 + 512 + hd * 128 + 4 * h;
    float ss = 0.f;
#pragma unroll
    for (int dt = 0; dt < 4; ++dt)
#pragma unroll
        for (int g = 0; g < 4; ++g) {
            const float a0 = o[dt][4 * g] * inv, a1 = o[dt][4 * g + 1] * inv, a2 = o[dt][4 * g + 2] * inv, a3 = o[dt][4 * g + 3] * inv;
            ss += (a0 * a0 + a1 * a1) + (a2 * a2 + a3 * a3);
            u32x2 w; w.x = pk2(a0, a1); w.y = pk2(a2, a3);
            *(u32x2*)(mix + dt * 32 + 8 * g) = w;
        }
    ss = xhalf_sum(ss);
    if (h == 0) ((float*)(p.ws + OFF_HSS))[(tok0 + q0 + r) * 16 + 8 + hd] = ss;
}

DI void sb_item(const Params& p, int bh, int qb32, int lane) {
    asm volatile("" : "+v"(lane));
    const int r = lane & 31, h = lane >> 5, b = bh >> 3, hd = bh & 7, q0 = qb32 * 32;
    const bf16_t* PROJ = (const bf16_t*)(p.ws + OFF_PROJ);
    const bf16_t* VST = (const bf16_t*)(p.ws + OFF_VST);
    const size_t tok0 = (size_t)b * S_;
    bf16x8 qf[4];
#pragma unroll
    for (int ks = 0; ks < 4; ++ks) qf[ks] = *(const bf16x8*)(PROJ + (tok0 + q0 + r) * 2048 + hd * 64 + ks * 16 + h * 8);
    const int pr = 16 * ((r >> 2) & 1) + (r & 3) + 4 * (r >> 3);
    const bf16_t* kbase = PROJ + (tok0 + pr) * 2048 + 512 + hd * 64 + h * 8;
    const bf16_t* vbase = VST + ((size_t)(b * 8 + hd) * 64 + r) * S_ + 16 * h;
    bf16x8 kc[4], kn[4], vf[4];
#pragma unroll
    for (int ks = 0; ks < 4; ++ks) kc[ks] = *(const bf16x8*)(kbase + (size_t)q0 * 2048 + ks * 16);
    f32x16 o0 = zero16(), o1 = zero16();
    float carry = 1.f;
    for (int kb = q0; kb >= 0; kb -= 32) {
#pragma unroll
        for (int dt = 0; dt < 2; ++dt)
#pragma unroll
            for (int s = 0; s < 2; ++s) vf[dt * 2 + s] = *(const bf16x8*)(vbase + (size_t)dt * 32 * S_ + kb + 8 * s);
        if (kb >= 32) {
#pragma unroll
            for (int ks = 0; ks < 4; ++ks) kn[ks] = *(const bf16x8*)(kbase + (size_t)(kb - 32) * 2048 + ks * 16);
        }
        f32x16 z = zero16();
#pragma unroll
        for (int ks = 0; ks < 4; ++ks) z = MFMA32(kc[ks], qf[ks], z);
        const bool diag = (kb == q0);
        f32x16 a;
        float tot = 1.f;
#pragma unroll
        for (int i = 15; i >= 0; --i) {
            const float w = __builtin_amdgcn_exp2f(fminf(z[i], 86.f));
            float be = __builtin_amdgcn_rcpf(1.f + w);
            float om = w * be;
            if (diag) { const bool valid = (16 * h + i < r); be = valid ? be : 0.f; om = valid ? om : 1.f; }
            a[i] = be * tot;
            tot *= om;
        }
        const float other = __shfl_xor(tot, 32);
        const float base = carry * (h == 0 ? other : 1.f);
        carry *= tot * other;
#pragma unroll
        for (int i = 0; i < 16; ++i) a[i] *= base;
        bf16x8 pf[2];
#pragma unroll
        for (int s = 0; s < 2; ++s) {
            u32x4 w; w.x = pk2(a[8 * s + 0], a[8 * s + 1]); w.y = pk2(a[8 * s + 2], a[8 * s + 3]); w.z = pk2(a[8 * s + 4], a[8 * s + 5]); w.w = pk2(a[8 * s + 6], a[8 * s + 7]);
            pf[s] = __builtin_bit_cast(bf16x8, w);
        }
#pragma unroll
        for (int s = 0; s < 2; ++s) { o0 = MFMA32(vf[s], pf[s], o0); o1 = MFMA32(vf[2 + s], pf[s], o1); }
        if (kb >= 32) {
#pragma unroll
            for (int ks = 0; ks < 4; ++ks) kc[ks] = kn[ks];
        }
        if (__all(carry < SB_PTHR)) break;
    }
    bf16_t* mix = (bf16_t*)(p.ws + OFF_MIX) + (tok0 + q0 + r) * 1024 + hd * 64 + 4 * h;
    float ss = 0.f;
#pragma unroll
    for (int g = 0; g < 4; ++g) {
        { const float a0 = o0[4 * g], a1 = o0[4 * g + 1], a2 = o0[4 * g + 2], a3 = o0[4 * g + 3];
          ss += (a0 * a0 + a1 * a1) + (a2 * a2 + a3 * a3); u32x2 w; w.x = pk2(a0, a1); w.y = pk2(a2, a3); *(u32x2*)(mix + 8 * g) = w; }
        { const float a0 = o1[4 * g], a1 = o1[4 * g + 1], a2 = o1[4 * g + 2], a3 = o1[4 * g + 3];
          ss += (a0 * a0 + a1 * a1) + (a2 * a2 + a3 * a3); u32x2 w; w.x = pk2(a0, a1); w.y = pk2(a2, a3); *(u32x2*)(mix + 32 + 8 * g) = w; }
    }
    ss = xhalf_sum(ss);
    if (h == 0) ((float*)(p.ws + OFF_HSS))[(tok0 + q0 + r) * 16 + hd] = ss;
}

constexpr int SB_ROW = 144, SB_KBYTES = 64 * SB_ROW, SB_BUF = 2 * SB_KBYTES  , SB_NB = 7, SB_FLAGS = SB_NB * SB_BUF;
DI void sb_block(const Params& p, LAS unsigned char* lds, int bh, int qb, int tid) {
    asm volatile("" : "+v"(tid));
    const int wu = __builtin_amdgcn_readfirstlane(tid >> 6), lane = tid & 63, r = lane & 31, h = lane >> 5;
    const int b = bh >> 3, hd = bh & 7, q0 = qb * 256 + wu * 32;
    const bf16_t* PROJ = (const bf16_t*)(p.ws + OFF_PROJ);
    const size_t tok0 = (size_t)b * S_;
    bf16x8 qf[4];
#pragma unroll
    for (int ks = 0; ks < 4; ++ks) qf[ks] = *(const bf16x8*)(PROJ + (tok0 + q0 + r) * 2048 + hd * 64 + ks * 16 + h * 8);
    unsigned goff[3];
#pragma unroll
    for (int j = 0; j < 3; ++j) {
        const int pc = wu + 8 * j; goff[j] = 0;
        if (pc < 18) {
            const int c = (pc < 9 ? pc : pc - 9) * 64 + lane, lr = c / 9; int cc = c - lr * 9; if (cc == 8) cc = 0;
            if (pc < 9) { const int k32 = lr & 31, key = (lr & 32) + 16 * ((k32 >> 2) & 1) + (k32 & 3) + 4 * (k32 >> 3);
                goff[j] = (unsigned)OFF_PROJ + ((unsigned)(b * S_ + key) * 2048u + 512 + hd * 64 + cc * 8) * 2u; }
            else goff[j] = (unsigned)OFF_VST + ((unsigned)((b * 8 + hd) * 64 + lr) * (unsigned)S_ + cc * 8) * 2u;
        }
    }
    const char* wsb = uptr((const char*)p.ws);
#define SB_STAGE(KT, BUF) do { _Pragma("unroll") for (int _j = 0; _j < 3; ++_j) { const int _pc = wu + 8 * _j; if (_pc < 18) { \
        const unsigned _inc = goff[_j] >= (unsigned)OFF_VST ? 128u : 262144u; \
        __builtin_amdgcn_global_load_lds((const unsigned*)(wsb + (goff[_j] + (unsigned)(KT) * _inc)), (LAS unsigned*)(lds + (BUF) * SB_BUF + _pc * 1024), 16, 0, 0); } } } while (0)
    f32x16 o0 = zero16(), o1 = zero16();
    float carry = 1.f;
    bool done = false;
    const int ktop = 4 * qb + 3;
    LAS int* flags = (LAS int*)(lds + SB_FLAGS);
    asm volatile("s_waitcnt vmcnt(0)" ::: "memory");
    __syncthreads();
    const int nstaged = ktop + 1 < SB_NB ? ktop + 1 : SB_NB;
    for (int i = 0; i < nstaged; ++i) SB_STAGE(ktop - i, i);
#define SB_WAITV(n) asm volatile("s_waitcnt vmcnt(" #n ") lgkmcnt(0)" ::: "memory")
    int cur = 0, it = 0;
    for (int kt = ktop; ; --kt, ++it) {
        if (lane == 0) flags[(it & 1) * 8 + wu] = done ? 1 : 0;
        if (it >= SB_NB && kt >= 0) SB_STAGE(kt, cur);
        const int ahead = it < nstaged ? nstaged - 1 - it : 0;
        if (wu < 2) { switch (ahead) { case 0: SB_WAITV(0); break; case 1: SB_WAITV(3); break; case 2: SB_WAITV(6); break; case 3: SB_WAITV(9); break; case 4: SB_WAITV(12); break; case 5: SB_WAITV(15); break; default: SB_WAITV(18); break; } }
        else { switch (ahead) { case 0: SB_WAITV(0); break; case 1: SB_WAITV(2); break; case 2: SB_WAITV(4); break; case 3: SB_WAITV(6); break; case 4: SB_WAITV(8); break; case 5: SB_WAITV(10); break; default: SB_WAITV(12); break; } }
        __builtin_amdgcn_s_barrier();
        asm volatile("" ::: "memory");
        {
            const LAS int* f = flags + (it & 1) * 8;
            const int all = f[0] & f[1] & f[2] & f[3] & f[4] & f[5] & f[6] & f[7];
            if (__builtin_amdgcn_readfirstlane(all)) break;
        }
        if (!done && kt * 64 <= q0) {
            const LAS unsigned char* base = lds + cur * SB_BUF;
#pragma unroll
            for (int sub = 1; sub >= 0; --sub) {
                const int kb = kt * 64 + sub * 32;
                if (kb <= q0 && !done) {
                    const LAS unsigned char* kp = base + (sub * 32 + r) * SB_ROW + h * 16;
                    bf16x8 kf[4], vf[4];
#pragma unroll
                    for (int ks = 0; ks < 4; ++ks) kf[ks] = *(const LAS bf16x8*)(kp + ks * 32);
#pragma unroll
                    for (int dt = 0; dt < 2; ++dt)
#pragma unroll
                        for (int s2 = 0; s2 < 2; ++s2) vf[dt * 2 + s2] = *(const LAS bf16x8*)(base + SB_KBYTES + (dt * 32 + r) * SB_ROW + (sub * 32 + 16 * h + 8 * s2) * 2);
                    f32x16 z = zero16();
#pragma unroll
                    for (int ks = 0; ks < 4; ++ks) z = MFMA32(kf[ks], qf[ks], z);
                    const bool diag = (kb == q0);
                    f32x16 a;
                    float tot = 1.f;
#pragma unroll
                    for (int i = 15; i >= 0; --i) {
                        const float w = __builtin_amdgcn_exp2f(fminf(z[i], 86.f));
                        float be = __builtin_amdgcn_rcpf(1.f + w);
                        float om = w * be;
                        if (diag) { const bool valid = (16 * h + i < r); be = valid ? be : 0.f; om = valid ? om : 1.f; }
                        a[i] = be * tot;
                        tot *= om;
                    }
                    const float other = __shfl_xor(tot, 32);
                    const float bs = carry * (h == 0 ? other : 1.f);
                    carry *= tot * other;
#pragma unroll
                    for (int i = 0; i < 16; ++i) a[i] *= bs;
                    bf16x8 pf[2];
#pragma unroll
                    for (int s2 = 0; s2 < 2; ++s2) {
                        u32x4 w; w.x = pk2(a[8 * s2 + 0], a[8 * s2 + 1]); w.y = pk2(a[8 * s2 + 2], a[8 * s2 + 3]); w.z = pk2(a[8 * s2 + 4], a[8 * s2 + 5]); w.w = pk2(a[8 * s2 + 6], a[8 * s2 + 7]);
                        pf[s2] = __builtin_bit_cast(bf16x8, w);
                    }
#pragma unroll
                    for (int s2 = 0; s2 < 2; ++s2) { o0 = MFMA32(vf[s2], pf[s2], o0); o1 = MFMA32(vf[2 + s2], pf[s2], o1); }
                    if (__all(carry < SB_PTHR)) done = true;
                }
            }
            if (kt == 0) done = true;
        }
        cur = cur == SB_NB - 1 ? 0 : cur + 1;
    }
    asm volatile("s_waitcnt vmcnt(0)" ::: "memory");
#undef SB_WAITV
#undef SB_STAGE
    bf16_t* mix = (bf16_t*)(p.ws + OFF_MIX) + (tok0 + q0 + r) * 1024 + hd * 64 + 4 * h;
    float ss = 0.f;
#pragma unroll
    for (int g = 0; g < 4; ++g) {
        { const float a0 = o0[4 * g], a1 = o0[4 * g + 1], a2 = o0[4 * g + 2], a3 = o0[4 * g + 3];
          ss += (a0 * a0 + a1 * a1) + (a2 * a2 + a3 * a3); u32x2 w; w.x = pk2(a0, a1); w.y = pk2(a2, a3); *(u32x2*)(mix + 8 * g) = w; }
        { const float a0 = o1[4 * g], a1 = o1[4 * g + 1], a2 = o1[4 * g + 2], a3 = o1[4 * g + 3];
          ss += (a0 * a0 + a1 * a1) + (a2 * a2 + a3 * a3); u32x2 w; w.x = pk2(a0, a1); w.y = pk2(a2, a3); *(u32x2*)(mix + 32 + 8 * g) = w; }
    }
    ss = xhalf_sum(ss);
    if (h == 0) ((float*)(p.ws + OFF_HSS))[(tok0 + q0 + r) * 16 + hd] = ss;
}

DI void sb_block2(const Params& p, LAS unsigned char* lds, int bh, int qb2, int tid) {
    asm volatile("" : "+v"(tid));
    const int wu = __builtin_amdgcn_readfirstlane(tid >> 6), lane = tid & 63, r = lane & 31, h = lane >> 5;
    const int b = bh >> 3, hd = bh & 7;
    int q0[2]; q0[0] = qb2 * 512 + wu * 32; q0[1] = q0[0] + 256;
    const bf16_t* PROJ = (const bf16_t*)(p.ws + OFF_PROJ);
    const size_t tok0 = (size_t)b * S_;
    bf16x8 qf[2][4];
#pragma unroll
    for (int g = 0; g < 2; ++g)
#pragma unroll
        for (int ks = 0; ks < 4; ++ks) qf[g][ks] = *(const bf16x8*)(PROJ + (tok0 + q0[g] + r) * 2048 + hd * 64 + ks * 16 + h * 8);
    unsigned goff[3];
#pragma unroll
    for (int j = 0; j < 3; ++j) {
        const int pc = wu + 8 * j; goff[j] = 0;
        if (pc < 18) {
            const int c = (pc < 9 ? pc : pc - 9) * 64 + lane, lr = c / 9; int cc = c - lr * 9; if (cc == 8) cc = 0;
            if (pc < 9) { const int k32 = lr & 31, key = (lr & 32) + 16 * ((k32 >> 2) & 1) + (k32 & 3) + 4 * (k32 >> 3);
                goff[j] = (unsigned)OFF_PROJ + ((unsigned)(b * S_ + key) * 2048u + 512 + hd * 64 + cc * 8) * 2u; }
            else goff[j] = (unsigned)OFF_VST + ((unsigned)((b * 8 + hd) * 64 + lr) * (unsigned)S_ + cc * 8) * 2u;
        }
    }
    const char* wsb = uptr((const char*)p.ws);
#define SB_STAGE(KT, BUF) do { _Pragma("unroll") for (int _j = 0; _j < 3; ++_j) { const int _pc = wu + 8 * _j; if (_pc < 18) { \
        const unsigned _inc = goff[_j] >= (unsigned)OFF_VST ? 128u : 262144u; \
        __builtin_amdgcn_global_load_lds((const unsigned*)(wsb + (goff[_j] + (unsigned)(KT) * _inc)), (LAS unsigned*)(lds + (BUF) * SB_BUF + _pc * 1024), 16, 0, 0); } } } while (0)
    f32x16 o0[2], o1[2]; float carry[2]; bool done[2];
#pragma unroll
    for (int g = 0; g < 2; ++g) { o0[g] = zero16(); o1[g] = zero16(); carry[g] = 1.f; done[g] = false; }
    const int ktop = 8 * qb2 + 7;
    LAS int* flags = (LAS int*)(lds + SB_FLAGS);
    asm volatile("s_waitcnt vmcnt(0)" ::: "memory");
    __syncthreads();
    const int nstaged = ktop + 1 < SB_NB ? ktop + 1 : SB_NB;
    for (int i = 0; i < nstaged; ++i) SB_STAGE(ktop - i, i);
#define SB_WAITV(n) asm volatile("s_waitcnt vmcnt(" #n ") lgkmcnt(0)" ::: "memory")
    int cur = 0, it = 0;
    for (int kt = ktop; ; --kt, ++it) {
        if (lane == 0) flags[(it & 1) * 8 + wu] = (done[0] && done[1]) ? 1 : 0;
        int lowest = ktop - (SB_NB - 1) - (it > 0 ? it - 1 : 0); if (lowest < 0) lowest = 0;
        int ahead = kt - lowest; if (ahead < 0) ahead = 0;
        if (wu < 2) { switch (ahead) { case 0: SB_WAITV(0); break; case 1: SB_WAITV(3); break; case 2: SB_WAITV(6); break; case 3: SB_WAITV(9); break; case 4: SB_WAITV(12); break; case 5: SB_WAITV(15); break; default: SB_WAITV(18); break; } }
        else { switch (ahead) { case 0: SB_WAITV(0); break; case 1: SB_WAITV(2); break; case 2: SB_WAITV(4); break; case 3: SB_WAITV(6); break; case 4: SB_WAITV(8); break; case 5: SB_WAITV(10); break; default: SB_WAITV(12); break; } }
        __builtin_amdgcn_s_barrier();
        asm volatile("" ::: "memory");
        {
            const LAS int* f = flags + (it & 1) * 8;
            const int all = f[0] & f[1] & f[2] & f[3] & f[4] & f[5] & f[6] & f[7];
            if (__builtin_amdgcn_readfirstlane(all)) break;
        }
        if (it >= 1 && kt - (SB_NB - 1) >= 0) SB_STAGE(kt - (SB_NB - 1), cur == 0 ? SB_NB - 1 : cur - 1);
        {
            const LAS unsigned char* base = lds + cur * SB_BUF;
#pragma unroll
            for (int sub = 1; sub >= 0; --sub) {
                const int kb = kt * 64 + sub * 32;
                const LAS unsigned char* kp = base + (sub * 32 + r) * SB_ROW + h * 16;
                const bool act0 = !done[0] && kb <= q0[0], act1 = !done[1] && kb <= q0[1];
                if (act0 || act1) {
                    bf16x8 kf[4], vf[4];
#pragma unroll
                    for (int ks = 0; ks < 4; ++ks) kf[ks] = *(const LAS bf16x8*)(kp + ks * 32);
#pragma unroll
                    for (int dt = 0; dt < 2; ++dt)
#pragma unroll
                        for (int s2 = 0; s2 < 2; ++s2) vf[dt * 2 + s2] = *(const LAS bf16x8*)(base + SB_KBYTES + (dt * 32 + r) * SB_ROW + (sub * 32 + 16 * h + 8 * s2) * 2);
                    f32x16 zz[2];
#pragma unroll
                    for (int g = 0; g < 2; ++g) {
                        zz[g] = zero16();
                        if (g == 0 ? act0 : act1) {
#pragma unroll
                            for (int ks = 0; ks < 4; ++ks) zz[g] = MFMA32(kf[ks], qf[g][ks], zz[g]);
                        }
                    }
#pragma unroll
                    for (int g = 0; g < 2; ++g) {
                        if (g == 0 ? act0 : act1) {
                            const f32x16 z = zz[g];
                            const bool diag = (kb == q0[g]);
                            f32x16 a;
                            float tot = 1.f;
#pragma unroll
                            for (int i = 15; i >= 0; --i) {
                                const float w = __builtin_amdgcn_exp2f(fminf(z[i], 86.f));
                                float be = __builtin_amdgcn_rcpf(1.f + w);
                                float om = w * be;
                                if (diag) { const bool valid = (16 * h + i < r); be = valid ? be : 0.f; om = valid ? om : 1.f; }
                                a[i] = be * tot;
                                tot *= om;
                            }
                            float tlo, thi; xhalf(tot, tlo, thi);
                            const float bs = carry[g] * (h == 0 ? thi : 1.f);
                            carry[g] *= tlo * thi;
#pragma unroll
                            for (int i = 0; i < 16; ++i) a[i] *= bs;
                            bf16x8 pf[2];
#pragma unroll
                            for (int s2 = 0; s2 < 2; ++s2) {
                                u32x4 w; w.x = pk2(a[8 * s2 + 0], a[8 * s2 + 1]); w.y = pk2(a[8 * s2 + 2], a[8 * s2 + 3]); w.z = pk2(a[8 * s2 + 4], a[8 * s2 + 5]); w.w = pk2(a[8 * s2 + 6], a[8 * s2 + 7]);
                                pf[s2] = __builtin_bit_cast(bf16x8, w);
                            }
#pragma unroll
                            for (int s2 = 0; s2 < 2; ++s2) { o0[g] = MFMA32(vf[s2], pf[s2], o0[g]); o1[g] = MFMA32(vf[2 + s2], pf[s2], o1[g]); }
                            if (__all(carry[g] < SB_PTHR)) done[g] = true;
                        }
                    }
                }
            }
            if (kt == 0) { done[0] = true; done[1] = true; }
        }
        cur = cur == SB_NB - 1 ? 0 : cur + 1;
    }
    asm volatile("s_waitcnt vmcnt(0)" ::: "memory");
#undef SB_WAITV
#undef SB_STAGE
#pragma unroll
    for (int g = 0; g < 2; ++g) {
        bf16_t* mix = (bf16_t*)(p.ws + OFF_MIX) + (tok0 + q0[g] + r) * 1024 + hd * 64 + 4 * h;
        float ss = 0.f;
#pragma unroll
        for (int gg = 0; gg < 4; ++gg) {
            { const float a0 = o0[g][4 * gg], a1 = o0[g][4 * gg + 1], a2 = o0[g][4 * gg + 2], a3 = o0[g][4 * gg + 3];
              ss += (a0 * a0 + a1 * a1) + (a2 * a2 + a3 * a3); u32x2 w; w.x = pk2(a0, a1); w.y = pk2(a2, a3); *(u32x2*)(mix + 8 * gg) = w; }
            { const float a0 = o1[g][4 * gg], a1 = o1[g][4 * gg + 1], a2 = o1[g][4 * gg + 2], a3 = o1[g][4 * gg + 3];
              ss += (a0 * a0 + a1 * a1) + (a2 * a2 + a3 * a3); u32x2 w; w.x = pk2(a0, a1); w.y = pk2(a2, a3); *(u32x2*)(mix + 32 + 8 * gg) = w; }
        }
        ss = xhalf_sum(ss);
        if (h == 0) ((float*)(p.ws + OFF_HSS))[(tok0 + q0[g] + r) * 16 + hd] = ss;
    }
}

DI void phase_attention(const Params& p, LAS unsigned char* lds, int tid, int which = 3) {
    const int blk = blockIdx.x, G = gridDim.x;
#ifndef NO_MLA
    if (which & 1) for (int it = blk; it < 512; it += G) {
        const int xcd = it & 7, local = (it >> 3) & 63;
        const int bh = xcd * 8 + (local >> 3), pr = local & 7;
        mla_block(p, lds, bh >> 2, bh & 3, pr, tid);
        mla_block(p, lds, bh >> 2, bh & 3, 15 - pr, tid);
    }
#endif
#ifndef NO_SB
    if (which & 2) for (int it = blk; it < 1024; it += G) {
        const int xcd = it & 7, local = (it >> 3) & 127;
        sb_block2(p, lds, xcd * 16 + (local >> 3), local & 7, tid);
    }
#endif
}

DI void phase_final(const Params& p, int tid) {
    const int wid = tid >> 6, lane = tid & 63;
    const float* pf = (const float*)(p.ws + OFF_PF);
    const bf16_t* h2b = (const bf16_t*)(p.ws + OFF_MIX);
    f32x4 ga[2], gb[2];
#pragma unroll
    for (int j = 0; j < 2; ++j) { ga[j] = *(const f32x4*)(p.g_final + j * 512 + lane * 8); gb[j] = *(const f32x4*)(p.g_final + j * 512 + lane * 8 + 4); }
    for (int row = blockIdx.x * 8 + wid; row < T_; row += gridDim.x * 8) {
        const f32x4* pp = (const f32x4*)(pf + (size_t)row * 16);
        u32x4 w[2];
#pragma unroll
        for (int j = 0; j < 2; ++j) w[j] = *(const u32x4*)(h2b + (size_t)row * 1024 + j * 512 + lane * 8);
        const float rs = rsqrtf(((sum4(pp[0]) + sum4(pp[1])) + (sum4(pp[2]) + sum4(pp[3]))) * (1.f / 1024.f) + EPS_);
        float* orow = p.out + (size_t)row * 1024 + lane * 8;
#pragma unroll
        for (int j = 0; j < 2; ++j) { f32x4 a, b; unpack8(w[j], a, b); *(f32x4*)(orow + j * 512) = a * rs * ga[j]; *(f32x4*)(orow + j * 512 + 4) = b * rs * gb[j]; }
    }
}

#define XB_TMO      128
#define XB_XCNT(j)  (256  + 64 * (j))
#define XB_XSUB(j)  (1280 + 64 * (j))
#define XB_XGEN(j)  (2304 + 64 * (j))
#define XB_TOP      3328
#define XB_TOPGEN   3392
#define XCD_BAR_WORDS 3456
#define XB_SPIN_CAP (1u << 18)
DI unsigned xb_ld(unsigned* p)              { return __hip_atomic_load(p, __ATOMIC_RELAXED, __HIP_MEMORY_SCOPE_AGENT); }
DI unsigned xb_add(unsigned* p, unsigned v) { return __hip_atomic_fetch_add(p, v, __ATOMIC_RELAXED, __HIP_MEMORY_SCOPE_AGENT); }
DI unsigned xb_xcc_id() { return (unsigned)__builtin_amdgcn_s_getreg((3 << 11) | 20) & 0xFu; }
#define XB_SPIN(cond, bar) do { unsigned _sp = 0; while (cond) { __builtin_amdgcn_s_sleep(1); \
    if ((++_sp & 255u) == 0u) { if (xb_ld(&(bar)[XB_TMO])) break; if (_sp > XB_SPIN_CAP) { atomicAdd(&(bar)[XB_TMO], 1u); break; } } } } while (0)
struct XcdBarrier { unsigned* bar; unsigned x; volatile LAS unsigned* st; };
DI XcdBarrier xcd_barrier_post(unsigned* bar, volatile LAS unsigned* st) {
    XcdBarrier b; b.bar = bar; b.x = xb_xcc_id(); b.st = st;
    if (threadIdx.x == 0) (void)xb_add(&bar[XB_XCNT(b.x)], 1u);
    return b;
}
DI void xcd_barrier_complete(unsigned* bar, unsigned x, unsigned& nloc, unsigned& nx) {
    const unsigned G = gridDim.x * gridDim.y * gridDim.z;
    unsigned sum, cnt, mine, sp = 0u;
    for (;;) {
        sum = 0u; cnt = 0u; mine = 0u;
#pragma unroll
        for (unsigned j = 0; j < 16; ++j) { const unsigned c = xb_ld(&bar[XB_XCNT(j)]); sum += c; cnt += (c > 0u) ? 1u : 0u; mine = (j == x) ? c : mine; }
        if (sum == G) break;
        __builtin_amdgcn_s_sleep(1);
        if ((++sp & 255u) == 0u) { if (xb_ld(&bar[XB_TMO])) break; if (sp > XB_SPIN_CAP) { atomicAdd(&bar[XB_TMO], 1u); break; } }
    }
    nloc = mine > 0u ? mine : 1u; nx = cnt > 0u ? cnt : 1u;
}
DI void xcd_barrier(const XcdBarrier& b) {
    asm volatile("s_waitcnt vmcnt(0)" ::: "memory");
    __syncthreads();
    if (threadIdx.x == 0) {
        unsigned* bar = b.bar;
        __builtin_amdgcn_s_waitcnt(0);
        unsigned nloc = b.st[0], nx = b.st[1];
        if (nloc == 0u) { xcd_barrier_complete(bar, b.x, nloc, nx); b.st[0] = nloc; b.st[1] = nx; }
        const unsigned old = xb_add(&bar[XB_XSUB(b.x)], 1u);
        const unsigned gen = old / nloc;
        if (old + 1u == (gen + 1u) * nloc) {
            __builtin_amdgcn_fence(__ATOMIC_RELEASE, "agent");
            asm volatile("s_waitcnt vmcnt(0)" ::: "memory");
            const unsigned og = xb_add(&bar[XB_TOP], 1u);
            const unsigned tg = og / nx;
            if (og + 1u == (tg + 1u) * nx) xb_add(&bar[XB_TOPGEN], 1u);
            else XB_SPIN(xb_ld(&bar[XB_TOPGEN]) == tg, bar);
            __builtin_amdgcn_fence(__ATOMIC_ACQUIRE, "agent");
            xb_add(&bar[XB_XGEN(b.x)], 1u);
            asm volatile("s_waitcnt vmcnt(0)" ::: "memory");
        } else {
            XB_SPIN(xb_ld(&bar[XB_XGEN(b.x)]) == gen, bar);
            __builtin_amdgcn_fence(__ATOMIC_ACQUIRE, "agent");
            asm volatile("s_waitcnt vmcnt(0)" ::: "memory");
        }
    }
    __syncthreads();
}

#ifndef PH_MASK
#define PH_MASK 255
#endif
#ifndef DUP_MASK
#define DUP_MASK 0
#endif
#ifndef DUP_WHICH
#define DUP_WHICH 3
#endif
constexpr int LDS_XB = g8::STAGE_BYTES + 8192;
constexpr int LDS_BYTES = g8::STAGE_BYTES + 8192 + 64;

__global__ void __launch_bounds__(512, 2) hymba_fwd(Params p) {
    extern __shared__ __attribute__((aligned(16))) unsigned char lds_raw[];
    LAS unsigned char* lds = (LAS unsigned char*)lds_raw;
    cg::grid_group grid = cg::this_grid();
    const int wid_s = __builtin_amdgcn_readfirstlane((int)threadIdx.x >> 6);
    unsigned char* ws = p.ws;

    volatile LAS unsigned* xst = (volatile LAS unsigned*)(lds + LDS_XB);
    if (threadIdx.x == 0) { xst[0] = 0u; xst[1] = 0u; }
    __syncthreads();
    const XcdBarrier xb = xcd_barrier_post((unsigned*)(ws + OFF_BAR), xst);
    if (p.out == nullptr) grid.sync();
    if (PH_MASK & 1) phase0(p, lds, fresh_tid(wid_s));
    xcd_barrier(xb);
    if (DUP_MASK & 1) { phase0(p, lds, fresh_tid(wid_s)); xcd_barrier(xb); }
    if (PH_MASK & 2) {
        LAS float* tab = (LAS float*)(lds + g8::STAGE_BYTES);
        EpiProj E{tab, (const float*)(ws + OFF_CS), (bf16_t*)(ws + OFF_PROJ), (bf16_t*)(ws + OFF_VST), (float*)(ws + OFF_PQ), (float*)(ws + OFF_PKV)};
        g8::gemm_phase<1, 1>(lds, wid_s, (const bf16_t*)(ws + OFF_XB), 1024, (const bf16_t*)(ws + OFF_WIN), 1024, T_, 2048, 1024, E, TabFill<RowRsx>{tab, wid_s, RowRsx{(const float*)(ws + OFF_RSX)}});
    }
    xcd_barrier(xb);
    if (PH_MASK & 4) {
        LAS float* tab = (LAS float*)(lds + g8::STAGE_BYTES);
        EpiQKV E{tab, (const float*)(ws + OFF_CS), (bf16_t*)(ws + OFF_QN), (bf16_t*)(ws + OFF_QR), (bf16_t*)(ws + OFF_KN), (bf16_t*)(ws + OFF_VMT)};
        g8::gemm_phase<1>(lds, wid_s, (const bf16_t*)(ws + OFF_PROJ) + 1536, 2048, (const bf16_t*)(ws + OFF_WQB), 256, T_, 1792, 256, E, TabFill<RowQKV>{tab, wid_s, RowQKV{(const float*)(ws + OFF_PQ), (const float*)(ws + OFF_PKV)}});
    }
    xcd_barrier(xb);
    if (PH_MASK & 8) phase_attention(p, lds, fresh_tid(wid_s));
    xcd_barrier(xb);
    if (DUP_MASK & 8) { phase_attention(p, lds, fresh_tid(wid_s), DUP_WHICH); xcd_barrier(xb); }
    if (PH_MASK & 16) {
        LAS float* tab = (LAS float*)(lds + g8::STAGE_BYTES);
        EpiOut E{tab, (const bf16_t*)(ws + OFF_XB), (bf16_t*)(ws + OFF_H1B), (float*)(ws + OFF_PH)};
        g8::gemm_phase<2>(lds, wid_s, (const bf16_t*)(ws + OFF_MIX), 1024, (const bf16_t*)(ws + OFF_WO), 1024, T_, 1024, 512, E, TabFill<RowOut>{tab, wid_s, RowOut{(const float*)(ws + OFF_HSS)}});
    }
    xcd_barrier(xb);
    for (int rep = 0; rep < ((DUP_MASK & 32) ? 2 : 1); ++rep) {
    if (rep) xcd_barrier(xb);
    if (PH_MASK & 32) {
        LAS float* rst = (LAS float*)(lds + g8::STAGE_BYTES);
        EpiUp E{(bf16_t*)(ws + OFF_HID)};
        g8::gemm_phase<1>(lds, wid_s, (const bf16_t*)(ws + OFF_H1B), 1024, (const bf16_t*)(ws + OFF_WUP), 1024, T_, 4096, 1024, E);
    }
    }
    xcd_barrier(xb);
    if (PH_MASK & 64) {
        LAS float* tab = (LAS float*)(lds + g8::STAGE_BYTES);
        EpiDown E{tab, (const bf16_t*)(ws + OFF_H1B), (bf16_t*)(ws + OFF_MIX), (float*)(ws + OFF_PF)};
        g8::gemm_phase<1, 2>(lds, wid_s, (const bf16_t*)(ws + OFF_HID), 4096, (const bf16_t*)(ws + OFF_WDN), 4096, T_, 1024, 4096, E, TabFill<RowUp>{tab, wid_s, RowUp{(const float*)(ws + OFF_PH)}});
    }
    xcd_barrier(xb);
    if (PH_MASK & 128) phase_final(p, fresh_tid(wid_s));
}

extern "C" void kernel_launch(void* const* d_in, const int* in_sizes, int n_in, void* d_out, int out_size, void* d_ws, size_t ws_size, hipStream_t stream) {
    static int grid_blocks = 0;
    if (grid_blocks == 0) {
        if (n_in != 15 || in_sizes[0] != T_ * 1024 || out_size != T_ * 1024 || ws_size < WS_END) {
            fprintf(stderr, "kernel_launch: unexpected shapes (n_in %d, in0 %d, out %d, ws %zu < %zu)\n", n_in, n_in > 0 ? in_sizes[0] : -1, out_size, ws_size, (size_t)WS_END);
            grid_blocks = -1; return;
        }
        int dev = 0, cus = 0, per_cu = 0;
        hipGetDevice(&dev);
        hipDeviceGetAttribute(&cus, hipDeviceAttributeMultiprocessorCount, dev);
        if (hipFuncSetAttribute((const void*)hymba_fwd, hipFuncAttributeMaxDynamicSharedMemorySize, LDS_BYTES) != hipSuccess) fprintf(stderr, "kernel_launch: hipFuncSetAttribute failed\n");
        if (hipOccupancyMaxActiveBlocksPerMultiprocessor(&per_cu, (const void*)hymba_fwd, 512, LDS_BYTES) != hipSuccess || per_cu < 1) { fprintf(stderr, "kernel_launch: occupancy query gave %d\n", per_cu); per_cu = 1; }
        (void)hipGetLastError();
        grid_blocks = cus;
        if (grid_blocks != 256) fprintf(stderr, "kernel_launch: note: %d CUs (work maps assume 256)\n", grid_blocks);
    }
    if (grid_blocks < 0) return;
    Params p{};
    p.x = (const float*)d_in[0]; p.pos = (const int*)d_in[1]; p.g_attn = (const float*)d_in[2]; p.w_in = (const float*)d_in[3];
    p.g_qa = (const float*)d_in[4]; p.w_qb = (const float*)d_in[5]; p.g_kva = (const float*)d_in[6]; p.w_kvb = (const float*)d_in[7];
    p.g_sbo = (const float*)d_in[8]; p.g_mlao = (const float*)d_in[9]; p.w_o = (const float*)d_in[10]; p.g_mlp = (const float*)d_in[11];
    p.w_up = (const float*)d_in[12]; p.w_down = (const float*)d_in[13]; p.g_final = (const float*)d_in[14];
    p.out = (float*)d_out; p.ws = (unsigned char*)d_ws;
    (void)hipMemsetAsync((unsigned char*)d_ws + OFF_BAR, 0, XCD_BAR_WORDS * 4, stream);
    void* args[] = {&p};
    hipError_t e = hipLaunchCooperativeKernel((const void*)hymba_fwd, dim3(grid_blocks), dim3(512), args, LDS_BYTES, stream);
    if (e != hipSuccess) fprintf(stderr, "kernel_launch: cooperative launch failed: %s (grid %d)\n", hipGetErrorString(e), grid_blocks);
}
```
